# Optimizing an MI355X kernel written in HIP

```python
import math
import jax, jax.numpy as jnp
from jax import lax
import numpy as np

D_MODEL = 1024
BATCH = 16
SEQ = 2048
DEPTH = 2

HEAD_DIM = 64
A_HEADS = 4
A_QK = 2 * HEAD_DIM
A_V = 2 * HEAD_DIM
A_W = A_HEADS * A_V
B_GROUPS = ((128, 1), (512, 4), (2048, 16))
B_HEADS = 6
B_QW = len(B_GROUPS) * B_HEADS * HEAD_DIM
B_W = B_HEADS * HEAD_DIM
C_HEADS = 6
C_W = C_HEADS * HEAD_DIM
N_BRANCH = 3
BLOCK = 128
N_BUCKETS = 32
REL_MAX_DIST = 2048
N_BIAS_HEADS = 2 * A_HEADS + len(B_GROUPS) * B_HEADS
D_FF = 2816
N_EXPERTS = 8
TOP_K = 2
D_FF_EXPERT = 3584
N_DENSE = (DEPTH + 1) // 2
N_MOE = DEPTH // 2
EPS = 1e-6
IN_SIZES = (A_HEADS * A_QK, A_HEADS * A_QK, A_W, B_QW, B_QW, B_QW, C_W, C_W, C_W, C_HEADS, N_BRANCH * D_MODEL)
N_IN = sum(IN_SIZES)

kernel_name = 'hybrid_diff_dilated_fox_moe_block'


def rms_norm(x, g):
    xf = x.astype(jnp.float32)
    y = xf * lax.rsqrt(jnp.mean(xf * xf, axis=-1, keepdims=True) + EPS)
    return (y * g.astype(jnp.float32)).astype(x.dtype)


def t5_bucket(dist):
    n = jnp.maximum(dist, 0)
    max_exact = N_BUCKETS // 2
    nf = jnp.maximum(n, 1).astype(jnp.float32)
    large = max_exact + (jnp.log(nf / max_exact) / math.log(REL_MAX_DIST / max_exact)
                         * (N_BUCKETS - max_exact)).astype(jnp.int32)
    large = jnp.minimum(large, N_BUCKETS - 1)
    return jnp.where(n < max_exact, n, large)


def diff_attention(q, k, v, lam, bias_tab):
    S = q.shape[1]
    H = q.shape[2]
    scale = HEAD_DIM ** -0.5
    outs = []
    for i in range(S // BLOCK):
        q0 = i * BLOCK
        L = q0 + BLOCK
        s = jnp.einsum('bqhmd,bkhmd->bhmqk', q[:, q0:L], k[:, :L]).astype(jnp.float32) * scale
        dist = (q0 + jnp.arange(BLOCK))[:, None] - jnp.arange(L)[None, :]
        bias = bias_tab[t5_bucket(dist)].reshape(BLOCK, L, H, 2).transpose(2, 3, 0, 1)
        s = jnp.where(dist >= 0, s + bias.astype(jnp.float32), -jnp.inf)
        p = jax.nn.softmax(s, axis=-1)
        w = p[:, :, 0] - lam * p[:, :, 1]
        outs.append(jnp.einsum('bhqk,bkhe->bqhe', w.astype(v.dtype), v[:, :L]))
    return jnp.concatenate(outs, axis=1)


def forgetting_attention(q, k, v, log_f):
    S = q.shape[1]
    scale = HEAD_DIM ** -0.5
    F = jnp.moveaxis(jnp.cumsum(log_f, axis=1), 1, 2)
    outs = []
    for i in range(S // BLOCK):
        q0 = i * BLOCK
        L = q0 + BLOCK
        s = jnp.einsum('bqhd,bkhd->bhqk', q[:, q0:L], k[:, :L]).astype(jnp.float32) * scale
        decay = F[:, :, q0:L, None] - F[:, :, None, :L]
        causal = (q0 + jnp.arange(BLOCK))[:, None] >= jnp.arange(L)[None, :]
        s = jnp.where(causal, s + decay, -jnp.inf)
        p = jax.nn.softmax(s, axis=-1)
        outs.append(jnp.einsum('bhqk,bkhd->bqhd', p.astype(v.dtype), v[:, :L]))
    return jnp.concatenate(outs, axis=1)


def dilated_attention(q, k, v, bias_tab):
    B_, S = q.shape[0], q.shape[1]
    scale = HEAD_DIM ** -0.5
    outs, lses = [], []
    for g, (window, dil) in enumerate(B_GROUPS):
        n_back = window // dil
        M = S // dil
        nblk = -(-M // BLOCK)
        Mp = nblk * BLOCK

        def strided(t):
            return jnp.moveaxis(t.reshape(B_, M, dil, B_HEADS, HEAD_DIM), 2, 1)

        def blk(t):
            return t.reshape(B_, dil, nblk, BLOCK, B_HEADS, HEAD_DIM)

        qg, kg, vg = strided(q[:, :, g]), strided(k[:, :, g]), strided(v[:, :, g])
        qblk = blk(jnp.pad(qg, ((0, 0), (0, 0), (0, Mp - M), (0, 0), (0, 0))))
        kp = jnp.pad(kg, ((0, 0), (0, 0), (BLOCK, Mp - M), (0, 0), (0, 0)))
        vp = jnp.pad(vg, ((0, 0), (0, 0), (BLOCK, Mp - M), (0, 0), (0, 0)))
        kblk = jnp.concatenate([blk(kp[:, :, :Mp]), blk(kp[:, :, BLOCK:])], axis=3)
        vblk = jnp.concatenate([blk(vp[:, :, :Mp]), blk(vp[:, :, BLOCK:])], axis=3)
        s = jnp.einsum('brnqhd,brnkhd->brnhqk', qblk, kblk).astype(jnp.float32) * scale
        qi = jnp.arange(BLOCK)[:, None]
        kj = jnp.arange(2 * BLOCK)[None, :]
        dm = qi + BLOCK - kj
        key_m = (jnp.arange(nblk)[:, None, None] - 1) * BLOCK + kj[None]
        valid = (dm >= 0) & (dm <= n_back) & (key_m >= 0)
        bias = bias_tab[:, g * B_HEADS:(g + 1) * B_HEADS][t5_bucket(dm * dil)]
        bias = jnp.moveaxis(bias, -1, 0).astype(jnp.float32)
        s = jnp.where(valid[None, None, :, None], s + bias, -jnp.inf)
        m = jnp.max(s, axis=-1, keepdims=True)
        e = jnp.exp(s - m)
        den = jnp.sum(e, axis=-1)
        o = jnp.einsum('brnhqk,brnkhd->brnqhd', e.astype(v.dtype), vblk).astype(jnp.float32)
        o = o / jnp.moveaxis(den, -1, -2)[..., None]
        lse = jnp.moveaxis(m[..., 0] + jnp.log(den), -1, -2)

        def unstrided(t):
            t = t.reshape(B_, dil, Mp, *t.shape[4:])[:, :, :M]
            return jnp.moveaxis(t, 1, 2).reshape(B_, S, *t.shape[3:])

        outs.append(unstrided(o))
        lses.append(unstrided(lse))
    alpha = jax.nn.softmax(jnp.stack(lses), axis=0)
    return jnp.sum(alpha[..., None] * jnp.stack(outs), axis=0)


def hybrid_mixer(h, w_in, b_f, lq1, lk1, lq2, lk2, subln_g, lam_init, rel_bias,
                 w_br_a, w_br_b, w_br_c, w_out):
    B_, S, _ = h.shape
    proj = h @ w_in
    offsets = np.cumsum(IN_SIZES)[:-1].tolist()
    qa, ka, va, qb, kb, vb, qc, kc, vc, f_logit, gate_logit = jnp.split(proj, offsets, axis=-1)
    lam = (jnp.exp(jnp.sum((lq1 * lk1).astype(jnp.float32)))
           - jnp.exp(jnp.sum((lq2 * lk2).astype(jnp.float32))) + lam_init)
    oa = diff_attention(qa.reshape(B_, S, A_HEADS, 2, HEAD_DIM), ka.reshape(B_, S, A_HEADS, 2, HEAD_DIM),
                        va.reshape(B_, S, A_HEADS, A_V), lam, rel_bias[:, :2 * A_HEADS])
    oa = (rms_norm(oa, subln_g) * (1.0 - lam_init)).reshape(B_, S, A_W)
    G = len(B_GROUPS)
    ob = dilated_attention(qb.reshape(B_, S, G, B_HEADS, HEAD_DIM), kb.reshape(B_, S, G, B_HEADS, HEAD_DIM),
                           vb.reshape(B_, S, G, B_HEADS, HEAD_DIM), rel_bias[:, 2 * A_HEADS:])
    ob = ob.astype(h.dtype).reshape(B_, S, B_W)
    log_f = jax.nn.log_sigmoid(f_logit.astype(jnp.float32) + b_f.astype(jnp.float32))
    oc = forgetting_attention(qc.reshape(B_, S, C_HEADS, HEAD_DIM), kc.reshape(B_, S, C_HEADS, HEAD_DIM),
                              vc.reshape(B_, S, C_HEADS, HEAD_DIM), log_f).reshape(B_, S, C_W)
    gates = jax.nn.sigmoid(gate_logit).reshape(B_, S, N_BRANCH, D_MODEL)
    merged = (gates[:, :, 0] * (oa @ w_br_a) + gates[:, :, 1] * (ob @ w_br_b)
              + gates[:, :, 2] * (oc @ w_br_c))
    return merged @ w_out


def swiglu(h, wg, wu, wd):
    return (jax.nn.silu(h @ wg) * (h @ wu)) @ wd


def moe_swiglu(h, w_router, wg, wu, wd):
    logits = (h @ w_router).astype(jnp.float32)
    top_val, top_idx = lax.top_k(logits, TOP_K)
    top_w = jax.nn.softmax(top_val, axis=-1)
    gate = jnp.sum(jax.nn.one_hot(top_idx, N_EXPERTS, dtype=jnp.float32) * top_w[..., None], axis=-2)
    out = jnp.zeros_like(h)
    for e in range(N_EXPERTS):
        out = out + gate[..., e:e + 1].astype(h.dtype) * swiglu(h, wg[e], wu[e], wd[e])
    return out


def setup_inputs(seed: int = 0) -> dict:
    key = jax.random.key(seed)
    ks = jax.random.split(key, 26)

    def nrm(k, shape, s):
        return jax.random.normal(k, shape, jnp.float32) * s

    D = D_MODEL
    return {
        'x': nrm(ks[0], (BATCH, SEQ, D), 1.0),
        'c': nrm(ks[1], (BATCH, D), 1.0),
        'norm_mix_g': 1.0 + nrm(ks[2], (DEPTH, D), 0.02),
        'norm_ffn_g': 1.0 + nrm(ks[3], (DEPTH, D), 0.02),
        'w_mod': nrm(ks[4], (DEPTH, D, 6 * D), 0.5 * D ** -0.5),
        'b_mod': nrm(ks[5], (DEPTH, 6 * D), 0.02),
        'w_in': nrm(ks[6], (DEPTH, D, N_IN), D ** -0.5),
        'b_forget': 2.0 + nrm(ks[7], (DEPTH, C_HEADS), 0.5),
        'lam_q1': nrm(ks[8], (DEPTH, HEAD_DIM), 0.1),
        'lam_k1': nrm(ks[9], (DEPTH, HEAD_DIM), 0.1),
        'lam_q2': nrm(ks[10], (DEPTH, HEAD_DIM), 0.1),
        'lam_k2': nrm(ks[11], (DEPTH, HEAD_DIM), 0.1),
        'subln_g': 1.0 + nrm(ks[12], (DEPTH, A_V), 0.02),
        'rel_bias': nrm(ks[13], (N_BUCKETS, N_BIAS_HEADS), 0.5),
        'w_br_a': nrm(ks[14], (DEPTH, A_W, D), A_W ** -0.5),
        'w_br_b': nrm(ks[15], (DEPTH, B_W, D), B_W ** -0.5),
        'w_br_c': nrm(ks[16], (DEPTH, C_W, D), C_W ** -0.5),
        'w_out': nrm(ks[17], (DEPTH, D, D), D ** -0.5),
        'w_ff_gate': nrm(ks[18], (N_DENSE, D, D_FF), D ** -0.5),
        'w_ff_up': nrm(ks[19], (N_DENSE, D, D_FF), D ** -0.5),
        'w_ff_down': nrm(ks[20], (N_DENSE, D_FF, D), D_FF ** -0.5),
        'w_router': nrm(ks[21], (N_MOE, D, N_EXPERTS), D ** -0.5),
        'w_exp_gate': nrm(ks[22], (N_MOE, N_EXPERTS, D, D_FF_EXPERT), D ** -0.5),
        'w_exp_up': nrm(ks[23], (N_MOE, N_EXPERTS, D, D_FF_EXPERT), D ** -0.5),
        'w_exp_down': nrm(ks[24], (N_MOE, N_EXPERTS, D_FF_EXPERT, D), D_FF_EXPERT ** -0.5),
        'final_norm_g': 1.0 + nrm(ks[25], (D,), 0.02),
    }


def reference(x, c, norm_mix_g, norm_ffn_g, w_mod, b_mod, w_in, b_forget, lam_q1, lam_k1, lam_q2,
              lam_k2, subln_g, rel_bias, w_br_a, w_br_b, w_br_c, w_out, w_ff_gate, w_ff_up, w_ff_down,
              w_router, w_exp_gate, w_exp_up, w_exp_down, final_norm_g):
    for l in range(DEPTH):
        lam_init = 0.8 - 0.6 * math.exp(-0.3 * l)
        mod = jax.nn.silu(c) @ w_mod[l] + b_mod[l]
        sh1, sc1, g1, sh2, sc2, g2 = jnp.split(mod[:, None, :], 6, axis=-1)
        h = rms_norm(x, norm_mix_g[l]) * (1.0 + sc1) + sh1
        x = x + g1 * hybrid_mixer(h, w_in[l], b_forget[l], lam_q1[l], lam_k1[l], lam_q2[l], lam_k2[l],
                                  subln_g[l], lam_init, rel_bias, w_br_a[l], w_br_b[l], w_br_c[l], w_out[l])
        h = rms_norm(x, norm_ffn_g[l]) * (1.0 + sc2) + sh2
        if l % 2 == 0:
            f = swiglu(h, w_ff_gate[l // 2], w_ff_up[l // 2], w_ff_down[l // 2])
        else:
            f = moe_swiglu(h, w_router[l // 2], w_exp_gate[l // 2], w_exp_up[l // 2], w_exp_down[l // 2])
        x = x + g2 * f
    return rms_norm(x, final_norm_g)
```

```cpp
#include <hip/hip_runtime.h>
#include <cstdint>
#include <cstdio>

namespace nv {
constexpr int D = 1024, NB = 16, S = 2048, T = NB * S, NIN = 9222;
constexpr int OFF_QA = 0, OFF_KA = 512, OFF_VA = 1024, OFF_QB = 1536, OFF_KB = 2688, OFF_VB = 3840, OFF_QC = 4992, OFF_KC = 5376, OFF_VC = 5760, OFF_F = 6144, OFF_G = 6150;
constexpr int DFF = 2816, NE = 8, DFE = 3584;
constexpr float EPS = 1e-6f;

__device__ __forceinline__ float wsum(float v) {
#pragma unroll
    for (int o = 1; o < 64; o <<= 1) v += __shfl_xor(v, o);
    return v;
}
__device__ __forceinline__ float wmax(float v) {
#pragma unroll
    for (int o = 1; o < 64; o <<= 1) v = fmaxf(v, __shfl_xor(v, o));
    return v;
}
__device__ __forceinline__ int t5_bucket(int n) {
    if (n < 16) return n < 0 ? 0 : n;
    const int th[15] = {22, 30, 40, 54, 73, 99, 134, 182, 246, 332, 450, 609, 825, 1117, 1513};
    int b = 16;
#pragma unroll
    for (int i = 0; i < 15; ++i) b += (n >= th[i]) ? 1 : 0;
    return b;
}
__device__ __forceinline__ float sigmoidf_(float z) { return 1.f / (1.f + expf(-z)); }
__device__ __forceinline__ float siluf_(float z) { return z / (1.f + expf(-z)); }

__global__ void k_mod(const float* c, const float* w_mod, const float* b_mod, float* mod) {
    const int j = blockIdx.x * 256 + threadIdx.x, b = blockIdx.y, l = blockIdx.z;
    __shared__ float sc[D];
    for (int k = threadIdx.x; k < D; k += 256) sc[k] = siluf_(c[b * D + k]);
    __syncthreads();
    const float* w = w_mod + (size_t)l * D * 6 * D + j;
    float acc = 0.f;
    for (int k = 0; k < D; ++k) acc += sc[k] * w[(size_t)k * 6 * D];
    mod[((size_t)l * NB + b) * 6 * D + j] = acc + b_mod[l * 6 * D + j];
}
__global__ void k_lam(const float* q1, const float* k1, const float* q2, const float* k2, float* lam) {
    const int l = blockIdx.x, lane = threadIdx.x;
    const float a = wsum(q1[l * 64 + lane] * k1[l * 64 + lane]), b = wsum(q2[l * 64 + lane] * k2[l * 64 + lane]);
    const float lam_init = 0.8f - 0.6f * expf(-0.3f * (float)l);
    if (lane == 0) { lam[l] = expf(a) - expf(b) + lam_init; lam[8 + l] = lam_init; }
}
__global__ void k_norm_mod(const float* x, const float* g, const float* sc, const float* sh, float* h) {
    const int t = blockIdx.x * 4 + (threadIdx.x >> 6), lane = threadIdx.x & 63, b = t / S;
    const float* xr = x + (size_t)t * D;
    float v[16]; float ss = 0.f;
#pragma unroll
    for (int i = 0; i < 16; ++i) { v[i] = xr[lane + 64 * i]; ss += v[i] * v[i]; }
    const float r = rsqrtf(wsum(ss) * (1.f / D) + EPS);
#pragma unroll
    for (int i = 0; i < 16; ++i) { const int d = lane + 64 * i; h[(size_t)t * D + d] = v[i] * r * g[d] * (1.f + sc[(size_t)b * 6 * D + d]) + sh[(size_t)b * 6 * D + d]; }
}
__global__ void k_final_norm(float* x, const float* g) {
    const int t = blockIdx.x * 4 + (threadIdx.x >> 6), lane = threadIdx.x & 63;
    float* xr = x + (size_t)t * D;
    float v[16]; float ss = 0.f;
#pragma unroll
    for (int i = 0; i < 16; ++i) { v[i] = xr[lane + 64 * i]; ss += v[i] * v[i]; }
    const float r = rsqrtf(wsum(ss) * (1.f / D) + EPS);
#pragma unroll
    for (int i = 0; i < 16; ++i) { const int d = lane + 64 * i; xr[d] = v[i] * r * g[d]; }
}

struct GemmArgs {
    const float* A; const int* rowidx; const int* mcount; const float* B1; const float* B2;
    int lda, M, m0, ldb, N, K;
};
template <bool DUAL, class Epi>
__global__ void __launch_bounds__(256) k_gemm(GemmArgs g, Epi epi) {
    __shared__ float As[16][64 + 4];
    __shared__ float B1s[16][64 + 4];
    __shared__ float B2s[DUAL ? 16 : 1][64 + 4];
    int Mv = g.M; if (g.mcount) { const int c = *g.mcount - g.m0; Mv = c < Mv ? c : Mv; }
    const int mt = blockIdx.y * 64, nt = blockIdx.x * 64;
    if (mt >= Mv) return;
    const int tid = threadIdx.x, ty = tid >> 4, tx = tid & 15;
    const int ar = tid >> 2, ak = (tid & 3) * 4;
    int arow = -1;
    if (mt + ar < Mv) arow = g.rowidx ? g.rowidx[g.m0 + mt + ar] : (mt + ar);
    float acc1[4][4] = {}, acc2[4][4] = {};
    for (int k0 = 0; k0 < g.K; k0 += 16) {
        float4 av = make_float4(0.f, 0.f, 0.f, 0.f);
        if (arow >= 0) av = *(const float4*)(g.A + (size_t)arow * g.lda + k0 + ak);
        As[ak + 0][ar] = av.x; As[ak + 1][ar] = av.y; As[ak + 2][ar] = av.z; As[ak + 3][ar] = av.w;
#pragma unroll
        for (int i = 0; i < 4; ++i) { const int kk = (tid >> 6) + 4 * i, n = nt + (tid & 63);
            B1s[kk][tid & 63] = n < g.N ? g.B1[(size_t)(k0 + kk) * g.ldb + n] : 0.f;
            if (DUAL) B2s[kk][tid & 63] = n < g.N ? g.B2[(size_t)(k0 + kk) * g.ldb + n] : 0.f; }
        __syncthreads();
#pragma unroll
        for (int kk = 0; kk < 16; ++kk) {
            float a[4], b1[4], b2[4];
#pragma unroll
            for (int i = 0; i < 4; ++i) { a[i] = As[kk][ty * 4 + i]; b1[i] = B1s[kk][tx * 4 + i]; if (DUAL) b2[i] = B2s[kk][tx * 4 + i]; }
#pragma unroll
            for (int i = 0; i < 4; ++i)
#pragma unroll
                for (int j = 0; j < 4; ++j) { acc1[i][j] += a[i] * b1[j]; if (DUAL) acc2[i][j] += a[i] * b2[j]; }
        }
        __syncthreads();
    }
#pragma unroll
    for (int i = 0; i < 4; ++i)
#pragma unroll
        for (int j = 0; j < 4; ++j) { const int m = mt + ty * 4 + i, n = nt + tx * 4 + j; if (m < Mv && n < g.N) epi(m, g.m0 + m, n, acc1[i][j], acc2[i][j]); }
}
struct EpiStore { float* C; int ldc, pad; __device__ void operator()(int m, int, int n, float a, float) const { C[(size_t)m * ldc + n] = a; } };
struct EpiMerge { float* Mg; const float* proj; int br, pad; __device__ void operator()(int m, int, int n, float a, float) const {
    const float gate = sigmoidf_(proj[(size_t)m * NIN + OFF_G + br * D + n]); float* p = Mg + (size_t)m * D + n; *p = (br == 0 ? 0.f : *p) + gate * a; } };
struct EpiResid { float* x; const float* gvec; __device__ void operator()(int m, int, int n, float a, float) const { x[(size_t)m * D + n] += gvec[n] * a; } };
struct EpiSwiglu { float* act; int ldc, pad; __device__ void operator()(int m, int, int n, float a, float b) const { act[(size_t)m * ldc + n] = siluf_(a) * b; } };
struct EpiMoeDown { float* x; const float* mod_g2; const int* list; const float* listw;
    __device__ void operator()(int, int ml, int n, float a, float) const { const int t = list[ml]; const int b = t / S; x[(size_t)t * D + n] += mod_g2[(size_t)b * 6 * D + n] * listw[ml] * a; } };

__global__ void __launch_bounds__(64) k_logf_cumsum(const float* proj, const float* b_f, float* F) {
    const int hh = blockIdx.x, lane = threadIdx.x;
    float run = 0.f; float loc[32];
#pragma unroll
    for (int i = 0; i < 32; ++i) { const int t = lane * 32 + i; const float z = proj[(size_t)t * NIN + OFF_F + hh] + b_f[hh];
        const float ls = fminf(z, 0.f) - log1pf(expf(-fabsf(z))); run += ls; loc[i] = run; }
    float incl = run;
#pragma unroll
    for (int o = 1; o < 64; o <<= 1) { const float u = __shfl_up(incl, o); if (lane >= o) incl += u; }
    const float excl = incl - run;
#pragma unroll
    for (int i = 0; i < 32; ++i) F[(size_t)(lane * 32 + i) * 6 + hh] = excl + loc[i];
}
__global__ void __launch_bounds__(64) k_attn_a(const float* proj, const float* rel_bias, const float* lam_p, const float* subln_g, float* oa) {
    const int t = blockIdx.x, h = blockIdx.y, lane = threadIdx.x;
    __shared__ float s1[S], s2[S], q1[64], q2[64];
    const float* P = proj + (size_t)t * NIN;
    q1[lane] = P[OFF_QA + h * 128 + lane]; q2[lane] = P[OFF_QA + h * 128 + 64 + lane];
    __syncthreads();
    float m1 = -INFINITY, m2 = -INFINITY;
    for (int j = lane; j <= t; j += 64) {
        const float* K = proj + (size_t)j * NIN + OFF_KA + h * 128;
        float d1 = 0.f, d2 = 0.f;
#pragma unroll 8
        for (int d = 0; d < 64; ++d) { d1 += q1[d] * K[d]; d2 += q2[d] * K[64 + d]; }
        const int bk = t5_bucket(t - j);
        d1 = d1 * 0.125f + rel_bias[bk * 26 + 2 * h]; d2 = d2 * 0.125f + rel_bias[bk * 26 + 2 * h + 1];
        s1[j] = d1; s2[j] = d2; m1 = fmaxf(m1, d1); m2 = fmaxf(m2, d2);
    }
    m1 = wmax(m1); m2 = wmax(m2);
    float l1 = 0.f, l2 = 0.f;
    for (int j = lane; j <= t; j += 64) { const float e1 = expf(s1[j] - m1), e2 = expf(s2[j] - m2); s1[j] = e1; s2[j] = e2; l1 += e1; l2 += e2; }
    l1 = wsum(l1); l2 = wsum(l2);
    const float lam = lam_p[0], lam_init = lam_p[8];
    for (int j = lane; j <= t; j += 64) s1[j] = s1[j] / l1 - lam * (s2[j] / l2);
    __syncthreads();
    float o0 = 0.f, o1 = 0.f;
    for (int j = 0; j <= t; ++j) { const float* V = proj + (size_t)j * NIN + OFF_VA + h * 128; const float w = s1[j]; o0 += w * V[lane]; o1 += w * V[64 + lane]; }
    const float ss = wsum(o0 * o0 + o1 * o1);
    const float r = rsqrtf(ss * (1.f / 128.f) + EPS) * (1.f - lam_init);
    oa[(size_t)t * 512 + h * 128 + lane] = o0 * r * subln_g[lane]; oa[(size_t)t * 512 + h * 128 + 64 + lane] = o1 * r * subln_g[64 + lane];
}
__global__ void __launch_bounds__(64) k_attn_c(const float* proj, const float* F, float* oc) {
    const int t = blockIdx.x, h = blockIdx.y, lane = threadIdx.x;
    __shared__ float s1[S], q1[64];
    q1[lane] = proj[(size_t)t * NIN + OFF_QC + h * 64 + lane];
    __syncthreads();
    const float Ft = F[(size_t)t * 6 + h];
    float m1 = -INFINITY;
    for (int j = lane; j <= t; j += 64) {
        const float* K = proj + (size_t)j * NIN + OFF_KC + h * 64;
        float d1 = 0.f;
#pragma unroll 8
        for (int d = 0; d < 64; ++d) d1 += q1[d] * K[d];
        d1 = d1 * 0.125f + (Ft - F[(size_t)j * 6 + h]);
        s1[j] = d1; m1 = fmaxf(m1, d1);
    }
    m1 = wmax(m1);
    float l1 = 0.f;
    for (int j = lane; j <= t; j += 64) { const float e1 = expf(s1[j] - m1); s1[j] = e1; l1 += e1; }
    l1 = wsum(l1);
    __syncthreads();
    float o0 = 0.f;
    for (int j = 0; j <= t; ++j) o0 += s1[j] * proj[(size_t)j * NIN + OFF_VC + h * 64 + lane];
    oc[(size_t)t * 384 + h * 64 + lane] = o0 / l1;
}
__global__ void __launch_bounds__(64) k_attn_b(const float* proj, const float* rel_bias, float* ob) {
    const int t = blockIdx.x, h = blockIdx.y, lane = threadIdx.x;
    __shared__ float sc[3][132], q[3][64];
    for (int g = 0; g < 3; ++g) q[g][lane] = proj[(size_t)t * NIN + OFF_QB + g * 384 + h * 64 + lane];
    __syncthreads();
    float mx = -INFINITY;
    for (int g = 0; g < 3; ++g) { const int dil = g == 0 ? 1 : (g == 1 ? 4 : 16); const int nmax = min(128, t / dil);
        for (int i = lane; i <= nmax; i += 64) { const int j = t - i * dil; const float* K = proj + (size_t)j * NIN + OFF_KB + g * 384 + h * 64;
            float d1 = 0.f;
#pragma unroll 8
            for (int d = 0; d < 64; ++d) d1 += q[g][d] * K[d];
            d1 = d1 * 0.125f + rel_bias[t5_bucket(i * dil) * 26 + 8 + g * 6 + h]; sc[g][i] = d1; mx = fmaxf(mx, d1); } }
    mx = wmax(mx);
    float l = 0.f;
    for (int g = 0; g < 3; ++g) { const int dil = g == 0 ? 1 : (g == 1 ? 4 : 16); const int nmax = min(128, t / dil);
        for (int i = lane; i <= nmax; i += 64) { const float e = expf(sc[g][i] - mx); sc[g][i] = e; l += e; } }
    l = wsum(l);
    __syncthreads();
    float o0 = 0.f;
    for (int g = 0; g < 3; ++g) { const int dil = g == 0 ? 1 : (g == 1 ? 4 : 16); const int nmax = min(128, t / dil);
        for (int i = 0; i <= nmax; ++i) o0 += sc[g][i] * proj[(size_t)(t - i * dil) * NIN + OFF_VB + g * 384 + h * 64 + lane]; }
    ob[(size_t)t * 384 + h * 64 + lane] = o0 / l;
}
__global__ void k_route(const float* h, const float* w_router, int* cnt, int* list, float* listw) {
    const int t = blockIdx.x * 4 + (threadIdx.x >> 6), lane = threadIdx.x & 63;
    float lg[NE];
#pragma unroll
    for (int e = 0; e < NE; ++e) lg[e] = 0.f;
    for (int i = 0; i < 16; ++i) { const int d = lane + 64 * i; const float hv = h[(size_t)t * D + d];
#pragma unroll
        for (int e = 0; e < NE; ++e) lg[e] += hv * w_router[d * NE + e]; }
#pragma unroll
    for (int e = 0; e < NE; ++e) lg[e] = wsum(lg[e]);
    if (lane == 0) {
        int e0 = 0; for (int e = 1; e < NE; ++e) if (lg[e] > lg[e0]) e0 = e;
        int e1 = (e0 == 0) ? 1 : 0; for (int e = 0; e < NE; ++e) if (e != e0 && lg[e] > lg[e1]) e1 = e;
        const float w1 = 1.f / (1.f + expf(lg[e0] - lg[e1])), w0 = 1.f - w1;
        int p = atomicAdd(&cnt[e0], 1); list[e0 * T + p] = t; listw[e0 * T + p] = w0;
        p = atomicAdd(&cnt[e1], 1); list[e1 * T + p] = t; listw[e1 * T + p] = w1;
    }
}
}

extern "C" void kernel_launch(void* const* d_in, const int* in_sizes, int n_in, void* d_out, int out_size, void* d_ws, size_t ws_size, hipStream_t stream) {
    using namespace nv;
    const float* x_in = (const float*)d_in[0]; const float* c = (const float*)d_in[1];
    const float* norm_mix_g = (const float*)d_in[2]; const float* norm_ffn_g = (const float*)d_in[3];
    const float* w_mod = (const float*)d_in[4]; const float* b_mod = (const float*)d_in[5]; const float* w_in = (const float*)d_in[6];
    const float* b_forget = (const float*)d_in[7];
    const float* subln_g = (const float*)d_in[12]; const float* rel_bias = (const float*)d_in[13];
    const float* w_br[3] = {(const float*)d_in[14], (const float*)d_in[15], (const float*)d_in[16]};
    const float* w_out = (const float*)d_in[17]; const float* w_ff_gate = (const float*)d_in[18]; const float* w_ff_up = (const float*)d_in[19]; const float* w_ff_down = (const float*)d_in[20];
    const float* w_router = (const float*)d_in[21]; const float* w_exp_gate = (const float*)d_in[22]; const float* w_exp_up = (const float*)d_in[23]; const float* w_exp_down = (const float*)d_in[24];
    const float* final_g = (const float*)d_in[25];
    float* x = (float*)d_out;
    float* ws = (float*)d_ws; size_t off = 0;
    auto take = [&](size_t n) { float* p = ws + off; off += (n + 63) / 64 * 64; return p; };
    float* mod = take((size_t)2 * NB * 6 * D); float* lam = take(64);
    float* h = take((size_t)T * D); float* proj = take((size_t)S * NIN); float* F = take((size_t)S * 6);
    float* oa = take((size_t)S * 512); float* ob = take((size_t)S * 384); float* oc = take((size_t)S * 384); float* mg = take((size_t)S * D);
    float* act = take((size_t)4096 * DFE);
    int* cnt = (int*)take(64); int* list = (int*)take((size_t)NE * T); float* listw = take((size_t)NE * T);
    (void)ws_size; (void)in_sizes; (void)n_in; (void)out_size;

    (void)hipMemcpyAsync(x, x_in, (size_t)T * D * 4, hipMemcpyDeviceToDevice, stream);
    k_mod<<<dim3(6 * D / 256, NB, 2), 256, 0, stream>>>(c, w_mod, b_mod, mod);
    k_lam<<<2, 64, 0, stream>>>((const float*)d_in[8], (const float*)d_in[9], (const float*)d_in[10], (const float*)d_in[11], lam);
    for (int l = 0; l < 2; ++l) {
        const float* modl = mod + (size_t)l * NB * 6 * D;
        k_norm_mod<<<T / 4, 256, 0, stream>>>(x, norm_mix_g + l * D, modl + D, modl, h);
        for (int b = 0; b < NB; ++b) {
            GemmArgs g{}; g.A = h + (size_t)b * S * D; g.lda = D; g.M = S; g.B1 = w_in + (size_t)l * D * NIN; g.ldb = NIN; g.N = NIN; g.K = D;
            k_gemm<false, EpiStore><<<dim3((NIN + 63) / 64, S / 64), 256, 0, stream>>>(g, EpiStore{proj, NIN, 0});
            k_logf_cumsum<<<6, 64, 0, stream>>>(proj, b_forget + l * 6, F);
            k_attn_a<<<dim3(S, 4), 64, 0, stream>>>(proj, rel_bias, lam + l, subln_g + l * 128, oa);
            k_attn_b<<<dim3(S, 6), 64, 0, stream>>>(proj, rel_bias, ob);
            k_attn_c<<<dim3(S, 6), 64, 0, stream>>>(proj, F, oc);
            const float* ob3[3] = {oa, ob, oc}; const int kb[3] = {512, 384, 384};
            for (int br = 0; br < 3; ++br) {
                GemmArgs m{}; m.A = ob3[br]; m.lda = kb[br]; m.M = S; m.B1 = w_br[br] + (size_t)l * kb[br] * D; m.ldb = D; m.N = D; m.K = kb[br];
                k_gemm<false, EpiMerge><<<dim3(D / 64, S / 64), 256, 0, stream>>>(m, EpiMerge{mg, proj, br, 0});
            }
            GemmArgs o{}; o.A = mg; o.lda = D; o.M = S; o.B1 = w_out + (size_t)l * D * D; o.ldb = D; o.N = D; o.K = D;
            k_gemm<false, EpiResid><<<dim3(D / 64, S / 64), 256, 0, stream>>>(o, EpiResid{x + (size_t)b * S * D, modl + (size_t)b * 6 * D + 2 * D});
        }
        k_norm_mod<<<T / 4, 256, 0, stream>>>(x, norm_ffn_g + l * D, modl + 4 * D, modl + 3 * D, h);
        if (l == 0) {
            for (int b = 0; b < NB; ++b) {
                GemmArgs g{}; g.A = h + (size_t)b * S * D; g.lda = D; g.M = S; g.B1 = w_ff_gate; g.B2 = w_ff_up; g.ldb = DFF; g.N = DFF; g.K = D;
                k_gemm<true, EpiSwiglu><<<dim3(DFF / 64, S / 64), 256, 0, stream>>>(g, EpiSwiglu{act, DFF, 0});
                GemmArgs d{}; d.A = act; d.lda = DFF; d.M = S; d.B1 = w_ff_down; d.ldb = D; d.N = D; d.K = DFF;
                k_gemm<false, EpiResid><<<dim3(D / 64, S / 64), 256, 0, stream>>>(d, EpiResid{x + (size_t)b * S * D, modl + (size_t)b * 6 * D + 5 * D});
            }
        } else {
            (void)hipMemsetAsync(cnt, 0, 64 * 4, stream);
            k_route<<<T / 4, 256, 0, stream>>>(h, w_router, cnt, list, listw);
            for (int e = 0; e < NE; ++e)
                for (int r0 = 0; r0 < T; r0 += 4096) {
                    GemmArgs g{}; g.A = h; g.lda = D; g.rowidx = list + (size_t)e * T; g.mcount = cnt + e; g.M = 4096; g.m0 = r0;
                    g.B1 = w_exp_gate + (size_t)e * D * DFE; g.B2 = w_exp_up + (size_t)e * D * DFE; g.ldb = DFE; g.N = DFE; g.K = D;
                    k_gemm<true, EpiSwiglu><<<dim3(DFE / 64, 4096 / 64), 256, 0, stream>>>(g, EpiSwiglu{act, DFE, 0});
                    GemmArgs d{}; d.A = act; d.lda = DFE; d.mcount = cnt + e; d.M = 4096; d.m0 = r0;
                    d.B1 = w_exp_down + (size_t)e * DFE * D; d.ldb = D; d.N = D; d.K = DFE;
                    k_gemm<false, EpiMoeDown><<<dim3(D / 64, 4096 / 64), 256, 0, stream>>>(d, EpiMoeDown{x, modl + 5 * D, list + (size_t)e * T, listw + (size_t)e * T});
                }
        }
    }
    k_final_norm<<<T / 4, 256, 0, stream>>>(x, final_g);
}
```

```cpp
#include <hip/hip_runtime.h>
#include <cstdint>
#include <cstdio>

namespace pg8 {
#define PG8_LAS __attribute__((address_space(3)))
typedef unsigned short bf16_t;
typedef short bf16x8 __attribute__((ext_vector_type(8)));
typedef float f32x4 __attribute__((ext_vector_type(4)));
typedef unsigned u32x4 __attribute__((ext_vector_type(4)));
constexpr int BM = 256, BK = 64, HALF = 128, HTB = HALF * BK * 2  , STAGE_BYTES = 8 * HTB, NXCD = 8, WGM = 8;

__host__ __device__ __forceinline__ int lds_byte(int r, int c) { const int st = (r >> 4) * 2 + (c >> 5), rr = r & 15, cc = c & 31, ob = rr * 64 + cc * 2; return st * 1024 + (ob ^ (((ob >> 9) & 1) << 5)); }
__host__ __device__ __forceinline__ void stage_rc(int b, int& R, int& C) { const int st = b / 1024, sb = b % 1024, swz = sb ^ (((sb >> 9) & 1) << 5); R = (st >> 1) * 16 + swz / 64; C = (st & 1) * 32 + (swz % 64) / 2; }
__host__ __device__ __forceinline__ int perm32(int rho) { const int n = rho >> 4, i = rho & 15; return 8 * (i >> 2) + 4 * n + (i & 3); }

struct Unit { int pm, pn, e, aux; };
struct Gemm { const bf16_t* A; const bf16_t* Bt; int M, N, K, lda; };

struct StaticOrder {
    int nM, nN, nwg, G, c;
    __host__ __device__ void init(int M, int N, int G_, int c_) { nM = M / BM; nN = N / BM; nwg = nM * nN; G = G_; c = c_; }
    __host__ __device__ bool next(int i, Unit& u) const {
        const long L = (long)i * G + c; if (L >= nwg) return false;
        int wgid = (int)L; { const int q = nwg / NXCD, r = nwg % NXCD, xcd = wgid % NXCD, off = wgid / NXCD; wgid = (xcd < r ? xcd * (q + 1) : r * (q + 1) + (xcd - r) * q) + off; }
        const int nig = WGM * nN, gid = wgid / nig, fm = gid * WGM, gsz = (nM - fm) < WGM ? (nM - fm) : WGM;
        u.pm = fm + ((wgid % nig) % gsz); u.pn = (wgid % nig) / gsz; u.e = 0; u.aux = 0; return true;
    }
    __device__ __forceinline__ const char* a_ptr(const Gemm& g, const Unit& u) const { return (const char*)g.A + (size_t)u.pm * (size_t)(BM * 2) * g.lda; }
    __device__ __forceinline__ const char* b_ptr(const Gemm& g, const Unit& u) const { return (const char*)g.Bt + (size_t)u.pn * (size_t)(BM * 2) * g.K; }
    __device__ __forceinline__ void a_ready(const Unit&) const {}
    __device__ __forceinline__ void done(const Unit&) const {}
};

__device__ __forceinline__ unsigned cvt_pk_bf16(float lo, float hi) { unsigned r; asm volatile("v_cvt_pk_bf16_f32 %0, %1, %2" : "=v"(r) : "v"(lo), "v"(hi)); return r; }
typedef float f32x2 __attribute__((ext_vector_type(2)));
__device__ __forceinline__ float silu_f(float z) { return z * __builtin_amdgcn_rcpf(1.0f + __builtin_amdgcn_exp2f(-1.4426950408889634f * z)); }
__device__ __forceinline__ float sigm_f(float z) { return __builtin_amdgcn_rcpf(1.0f + __builtin_amdgcn_exp2f(-1.4426950408889634f * z)); }
struct EpiSwiglu {
    static constexpr bool PERM = true, AFTER_DRAIN = false;
    bf16_t* O; int ldc; int pm_off;
    __device__ __forceinline__ void operator()(const f32x4 (&acc)[2][2][4][2], const Unit& u, int wr, int wc, int fr, int fq) const {
        const int row0 = (u.pm - pm_off) * BM + wr * 64 + fr, col0 = u.pn * HALF + wc * 32 + 8 * fq;
#pragma unroll
        for (int ai = 0; ai < 2; ++ai)
#pragma unroll
            for (int m = 0; m < 4; ++m) { bf16_t* rowp = O + (size_t)(row0 + ai * HALF + m * 16) * ldc + col0;
                const f32x4 g0 = acc[ai][0][m][0], g1 = acc[ai][0][m][1], u0 = acc[ai][1][m][0], u1 = acc[ai][1][m][1];
                u32x4 w; w.x = cvt_pk_bf16(silu_f(g0[0]) * u0[0], silu_f(g0[1]) * u0[1]); w.y = cvt_pk_bf16(silu_f(g0[2]) * u0[2], silu_f(g0[3]) * u0[3]);
                w.z = cvt_pk_bf16(silu_f(g1[0]) * u1[0], silu_f(g1[1]) * u1[1]); w.w = cvt_pk_bf16(silu_f(g1[2]) * u1[2], silu_f(g1[3]) * u1[3]);
                *(u32x4*)rowp = w; }
    }
};
struct EpiResid {
    static constexpr bool PERM = false, AFTER_DRAIN = false;
    const float* src; float* dst; const float* gv; int row_off;
    __device__ __forceinline__ void operator()(const f32x4 (&acc)[2][2][4][2], const Unit& u, int wr, int wc, int fr, int fq) const {
        const int rowt = row_off + u.pm * BM, row0 = rowt + wr * 64 + fr, col0 = u.pn * BM + wc * 32 + 4 * fq;
        const float* gp = gv + (size_t)(rowt >> 11) * 6144 + col0;
        f32x4 gg[2][2];
#pragma unroll
        for (int bj = 0; bj < 2; ++bj)
#pragma unroll
            for (int n = 0; n < 2; ++n) gg[bj][n] = *(const f32x4*)(gp + bj * HALF + n * 16);
#pragma unroll
        for (int ai = 0; ai < 2; ++ai) {
            f32x4 sv[4][2][2];
#pragma unroll
            for (int m = 0; m < 4; ++m) { const size_t off = (size_t)(row0 + ai * HALF + m * 16) * 1024 + col0;
#pragma unroll
                for (int bj = 0; bj < 2; ++bj)
#pragma unroll
                    for (int n = 0; n < 2; ++n) sv[m][bj][n] = *(const f32x4*)(src + off + bj * HALF + n * 16); }
            asm volatile("" ::: "memory");
#pragma unroll
            for (int m = 0; m < 4; ++m) { const size_t off = (size_t)(row0 + ai * HALF + m * 16) * 1024 + col0;
#pragma unroll
                for (int bj = 0; bj < 2; ++bj)
#pragma unroll
                    for (int n = 0; n < 2; ++n) *(f32x4*)(dst + off + bj * HALF + n * 16) = sv[m][bj][n] + gg[bj][n] * acc[ai][bj][m][n]; }
            asm volatile("" ::: "memory");
        }
    }
};
struct EpiMoeDown {
    static constexpr bool PERM = true, AFTER_DRAIN = false;
    bf16_t* O; const float* row_w;
    __device__ __forceinline__ void operator()(const f32x4 (&acc)[2][2][4][2], const Unit& u, int wr, int wc, int fr, int fq) const {
        const int row0 = u.pm * BM + wr * 64 + fr, col0 = u.pn * BM + wc * 32 + 8 * fq;
        float w[2][4];
#pragma unroll
        for (int ai = 0; ai < 2; ++ai)
#pragma unroll
            for (int m = 0; m < 4; ++m) w[ai][m] = row_w[row0 + ai * HALF + m * 16];
#pragma unroll
        for (int ai = 0; ai < 2; ++ai)
#pragma unroll
            for (int m = 0; m < 4; ++m) { bf16_t* rowp = O + (size_t)(row0 + ai * HALF + m * 16) * 1024 + col0; const float ww = w[ai][m];
#pragma unroll
                for (int bj = 0; bj < 2; ++bj) { const f32x4 v0 = acc[ai][bj][m][0] * ww, v1 = acc[ai][bj][m][1] * ww;
                    u32x4 o; o.x = cvt_pk_bf16(v0[0], v0[1]); o.y = cvt_pk_bf16(v0[2], v0[3]); o.z = cvt_pk_bf16(v1[0], v1[1]); o.w = cvt_pk_bf16(v1[2], v1[3]);
                    *(u32x4*)(rowp + bj * HALF) = o; } }
    }
};
struct EpiInProj {
    static constexpr bool PERM = true, AFTER_DRAIN = false;
    bf16_t* O; int ldc;
    __device__ __forceinline__ void operator()(const f32x4 (&acc)[2][2][4][2], const Unit& u, int wr, int wc, int fr, int fq) const {
        const int rowl0 = u.pm * BM + wr * 64 + fr;
        constexpr float C2 = 0.125f * 1.4426950408889634f;
#pragma unroll
        for (int bj = 0; bj < 2; ++bj) {
            const int hh = 2 * u.pn + bj; float sc = 1.0f; int s = 0; const bool sig = hh >= 48;
            if (hh < 4) sc = C2; else if (hh >= 12 && hh < 39) { s = 2 * (((hh - 12) % 9) / 3); if (hh < 21) sc = C2; } else if (hh >= 39 && hh < 42) sc = C2;
            const int col = 128 * hh + 32 * wc + 8 * fq;
#pragma unroll
            for (int ai = 0; ai < 2; ++ai)
#pragma unroll
                for (int m = 0; m < 4; ++m) { const int r = rowl0 + ai * HALF + m * 16, t = r & 2047, tp = ((t & ((1 << s) - 1)) << (11 - s)) | (t >> s), ro = (r & ~2047) | tp;
                    f32x4 v0 = acc[ai][bj][m][0], v1 = acc[ai][bj][m][1];
                    if (sig) { v0[0] = sigm_f(v0[0]); v0[1] = sigm_f(v0[1]); v0[2] = sigm_f(v0[2]); v0[3] = sigm_f(v0[3]); v1[0] = sigm_f(v1[0]); v1[1] = sigm_f(v1[1]); v1[2] = sigm_f(v1[2]); v1[3] = sigm_f(v1[3]); }
                    else { v0 = v0 * sc; v1 = v1 * sc; }
                    u32x4 w; w.x = cvt_pk_bf16(v0[0], v0[1]); w.y = cvt_pk_bf16(v0[2], v0[3]); w.z = cvt_pk_bf16(v1[0], v1[1]); w.w = cvt_pk_bf16(v1[2], v1[3]);
                    *(u32x4*)(O + (size_t)ro * ldc + col) = w; }
        }
    }
};
__device__ __forceinline__ float bf_lo(unsigned u) { return __builtin_bit_cast(float, u << 16); }
__device__ __forceinline__ float bf_hi(unsigned u) { return __builtin_bit_cast(float, u & 0xffff0000u); }
template <int BR> struct EpiMerge {
    static constexpr bool PERM = true, AFTER_DRAIN = false;
    const bf16_t* proj; bf16_t* mg; int ldp;
    __device__ __forceinline__ void operator()(const f32x4 (&acc)[2][2][4][2], const Unit& u, int wr, int wc, int fr, int fq) const {
        const int row0 = u.pm * BM + wr * 64 + fr, col0 = u.pn * BM + wc * 32 + 8 * fq;
#pragma unroll
        for (int ai = 0; ai < 2; ++ai)
#pragma unroll
        for (int mp = 0; mp < 4; ++mp) {
            u32x4 gt[1][2], od[1][2];
#pragma unroll
            for (int mm = 0; mm < 1; ++mm)
#pragma unroll
                for (int bj = 0; bj < 2; ++bj) { const size_t r = (size_t)(row0 + ai * HALF + (mp + mm) * 16);
                    gt[mm][bj] = *(const u32x4*)(proj + r * ldp + 6144 + 1024 * BR + col0 + bj * HALF);
                    if (BR) od[mm][bj] = *(const u32x4*)(mg + r * 1024 + col0 + bj * HALF); else od[mm][bj] = (u32x4){0u, 0u, 0u, 0u}; }
            asm volatile("" ::: "memory");
#pragma unroll
            for (int mm = 0; mm < 1; ++mm)
#pragma unroll
                for (int bj = 0; bj < 2; ++bj) { const int m = mp + mm; const size_t r = (size_t)(row0 + ai * HALF + m * 16); const u32x4 g = gt[mm][bj], o = od[mm][bj]; const f32x4 v0 = acc[ai][bj][m][0], v1 = acc[ai][bj][m][1];
                    u32x4 w; w.x = cvt_pk_bf16(bf_lo(o.x) + bf_lo(g.x) * v0[0], bf_hi(o.x) + bf_hi(g.x) * v0[1]); w.y = cvt_pk_bf16(bf_lo(o.y) + bf_lo(g.y) * v0[2], bf_hi(o.y) + bf_hi(g.y) * v0[3]);
                    w.z = cvt_pk_bf16(bf_lo(o.z) + bf_lo(g.z) * v1[0], bf_hi(o.z) + bf_hi(g.z) * v1[1]); w.w = cvt_pk_bf16(bf_lo(o.w) + bf_lo(g.w) * v1[2], bf_hi(o.w) + bf_hi(g.w) * v1[3]);
                    *(u32x4*)(mg + r * 1024 + col0 + bj * HALF) = w; }
            asm volatile("" ::: "memory");
        }
    }
};
template <class Epi, class Sched, bool ALIGN_EPI = false, bool SP2 = false>
__device__ __forceinline__ void gemm_phase(PG8_LAS unsigned char* lds, const Gemm g, const Sched& S, const Epi& E) {
    int tid = threadIdx.x; asm volatile("" : "+v"(tid));
    const int wid = __builtin_amdgcn_readfirstlane(tid >> 6), lane = tid & 63, wr = wid >> 2, wc = wid & 3, fr = lane & 15, fq = lane >> 4;
    const int K = g.K, nt = K / BK;
    unsigned voffA[2], voffB[2];
#pragma unroll
    for (int i = 0; i < 2; ++i) { int R, C; stage_rc(tid * 16 + i * 8192, R, C); const int Rb = Epi::PERM ? ((R & ~31) + perm32(R & 31)) : R;
        voffA[i] = (unsigned)(R * g.lda + C) * 2u; voffB[i] = (unsigned)(Rb * K + C) * 2u; }
    const size_t kstep = (size_t)(BK * 2);
    const size_t hstepA = (size_t)HALF * g.lda * 2, hstepB = (size_t)HALF * K * 2;
    const unsigned ldsw = (unsigned)wid * 1024u;
    const int aoff = lds_byte(wr * 64 + fr, fq * 8), boff = lds_byte(wc * 32 + fr, fq * 8);
#define PG8_SA(b, h) (((b) * 2 + (h)) * HTB)
#define PG8_SB(b, h) ((4 + (b) * 2 + (h)) * HTB)
#define PG8_STAGE(bufoff, gbase, voff) do { _Pragma("unroll") for (int _i = 0; _i < 2; ++_i) \
        __builtin_amdgcn_global_load_lds((const unsigned*)((const char*)(gbase) + (voff)[_i]), (PG8_LAS unsigned*)(lds + (bufoff) + ldsw + _i * 8192), 16, 0, 0); } while (0)
#define PG8_LDA(dst, b, h) do { _Pragma("unroll") for (int m = 0; m < 4; ++m) _Pragma("unroll") for (int k = 0; k < 2; ++k) dst[m][k] = *(const PG8_LAS bf16x8*)(lds + PG8_SA(b, h) + aoff + m * 2048 + k * 1024); } while (0)
#define PG8_LDB(dst, b, h) do { _Pragma("unroll") for (int n = 0; n < 2; ++n) _Pragma("unroll") for (int k = 0; k < 2; ++k) dst[n][k] = *(const PG8_LAS bf16x8*)(lds + PG8_SB(b, h) + boff + n * 2048 + k * 1024); } while (0)
#define PG8_MMA(ai, bj, At, Bt) do { __builtin_amdgcn_s_setprio(1); _Pragma("unroll") for (int m = 0; m < 4; ++m) _Pragma("unroll") for (int n = 0; n < 2; ++n) _Pragma("unroll") for (int k = 0; k < 2; ++k) \
        acc[ai][bj][m][n] = __builtin_amdgcn_mfma_f32_16x16x32_bf16(Bt[n][k], At[m][k], acc[ai][bj][m][n], 0, 0, 0); __builtin_amdgcn_s_setprio(0); } while (0)
#define PG8_WAIT_V(n) asm volatile("s_waitcnt vmcnt(" #n ")" ::: "memory")
#define PG8_WAIT_L(n) asm volatile("s_waitcnt lgkmcnt(" #n ")" ::: "memory")
#define PG8_BAR __builtin_amdgcn_s_barrier()
#define PG8_SCHED __builtin_amdgcn_sched_barrier(0)
    Unit cur, nxt; int ui = 0;
    if (!S.next(0, cur)) return;
    f32x4 acc[2][2][4][2];
#pragma unroll
    for (int a = 0; a < 2; ++a)
#pragma unroll
        for (int b = 0; b < 2; ++b)
#pragma unroll
            for (int m = 0; m < 4; ++m)
#pragma unroll
                for (int n = 0; n < 2; ++n) acc[a][b][m][n] = (f32x4){0.f, 0.f, 0.f, 0.f};
    bf16x8 At[4][2], B0[2][2], B1[2][2];
    const char* cA = S.a_ptr(g, cur); const char* cB = S.b_ptr(g, cur);
    S.a_ready(cur);
    if constexpr (SP2) {
        PG8_STAGE(PG8_SB(0, 0), cB, voffB); PG8_STAGE(PG8_SB(0, 1), cB + hstepB, voffB); PG8_STAGE(PG8_SA(0, 0), cA, voffA); PG8_STAGE(PG8_SA(0, 1), cA + hstepA, voffA);
        if (wr == 1) PG8_BAR;
        PG8_WAIT_V(2); PG8_BAR;
        PG8_STAGE(PG8_SB(1, 0), cB + kstep, voffB); PG8_STAGE(PG8_SA(1, 0), cA + kstep, voffA); PG8_STAGE(PG8_SB(1, 1), cB + hstepB + kstep, voffB);
        PG8_WAIT_V(6); PG8_BAR;
    } else {
        PG8_STAGE(PG8_SB(0, 0), cB, voffB); PG8_STAGE(PG8_SA(0, 0), cA, voffA); PG8_STAGE(PG8_SB(0, 1), cB + hstepB, voffB); PG8_STAGE(PG8_SA(0, 1), cA + hstepA, voffA);
        if (wr == 1) PG8_BAR;
        PG8_WAIT_V(4); PG8_BAR;
        PG8_STAGE(PG8_SB(1, 0), cB + kstep, voffB); PG8_STAGE(PG8_SA(1, 0), cA + kstep, voffA); PG8_STAGE(PG8_SB(1, 1), cB + hstepB + kstep, voffB);
        PG8_WAIT_V(6); PG8_BAR;
    }
    for (;;) {
        const bool has_next = S.next(ui + 1, nxt);
        const char* nA = has_next ? S.a_ptr(g, nxt) : cA; const char* nB = has_next ? S.b_ptr(g, nxt) : cB;
        for (int t = 0; t < nt; t += 2) {
            const bool last = (t == nt - 2);
            const char* a1 = cA + (size_t)(t + 1) * kstep;
            const char* a2 = last ? nA : cA + (size_t)(t + 2) * kstep; const char* b2 = last ? nB : cB + (size_t)(t + 2) * kstep;
            const char* a3 = a2 + kstep; const char* b3 = b2 + kstep;
            if (last && has_next) S.a_ready(nxt);
            if constexpr (SP2) {
            PG8_LDB(B0, 0, 0); PG8_LDB(B1, 0, 1); PG8_SCHED; PG8_LDA(At, 0, 0); PG8_STAGE(PG8_SA(1, 1), a1 + hstepA, voffA);
            PG8_WAIT_V(8); PG8_WAIT_L(0); PG8_BAR; PG8_MMA(0, 0, At, B0); PG8_MMA(0, 1, At, B1); PG8_BAR; PG8_SCHED;
            PG8_LDA(At, 0, 1); PG8_STAGE(PG8_SB(0, 0), b2, voffB); PG8_STAGE(PG8_SB(0, 1), b2 + hstepB, voffB); PG8_STAGE(PG8_SA(0, 0), a2, voffA);
            PG8_WAIT_V(8); PG8_WAIT_L(0); PG8_BAR; PG8_MMA(1, 0, At, B0); PG8_MMA(1, 1, At, B1); PG8_BAR; PG8_SCHED;
            PG8_LDB(B0, 1, 0); PG8_LDB(B1, 1, 1); PG8_SCHED; PG8_LDA(At, 1, 0); PG8_STAGE(PG8_SA(0, 1), a2 + hstepA, voffA);
            PG8_WAIT_V(8); PG8_WAIT_L(0); PG8_BAR; PG8_MMA(0, 0, At, B0); PG8_MMA(0, 1, At, B1); PG8_BAR; PG8_SCHED;
            PG8_LDA(At, 1, 1); PG8_STAGE(PG8_SB(1, 0), b3, voffB); PG8_STAGE(PG8_SB(1, 1), b3 + hstepB, voffB); PG8_STAGE(PG8_SA(1, 0), a3, voffA);
            PG8_WAIT_V(8); PG8_WAIT_L(0); PG8_BAR; PG8_MMA(1, 0, At, B0); PG8_MMA(1, 1, At, B1); PG8_BAR; PG8_SCHED;
            } else {
            PG8_LDB(B0, 0, 0); PG8_SCHED; PG8_LDA(At, 0, 0); PG8_STAGE(PG8_SA(1, 1), a1 + hstepA, voffA);
            PG8_WAIT_L(8); PG8_BAR; PG8_WAIT_L(0); PG8_MMA(0, 0, At, B0); PG8_BAR; PG8_SCHED;
            PG8_LDB(B1, 0, 1); PG8_STAGE(PG8_SB(0, 0), b2, voffB);
            PG8_BAR; PG8_WAIT_L(0); PG8_MMA(0, 1, At, B1); PG8_BAR;
            PG8_LDA(At, 0, 1); PG8_STAGE(PG8_SA(0, 0), a2, voffA);
            PG8_BAR; PG8_WAIT_L(0); PG8_MMA(1, 0, At, B0); PG8_BAR; PG8_SCHED;
            PG8_STAGE(PG8_SB(0, 1), b2 + hstepB, voffB);
            PG8_WAIT_V(6); PG8_BAR; PG8_MMA(1, 1, At, B1); PG8_BAR;
            PG8_LDB(B0, 1, 0); PG8_SCHED; PG8_LDA(At, 1, 0); PG8_STAGE(PG8_SA(0, 1), a2 + hstepA, voffA);
            PG8_WAIT_L(8); PG8_BAR; PG8_WAIT_L(0); PG8_MMA(0, 0, At, B0); PG8_BAR; PG8_SCHED;
            PG8_LDB(B1, 1, 1); PG8_STAGE(PG8_SB(1, 0), b3, voffB);
            PG8_BAR; PG8_WAIT_L(0); PG8_MMA(0, 1, At, B1); PG8_BAR;
            PG8_LDA(At, 1, 1); PG8_STAGE(PG8_SA(1, 0), a3, voffA);
            PG8_BAR; PG8_WAIT_L(0); PG8_MMA(1, 0, At, B0); PG8_BAR; PG8_SCHED;
            PG8_STAGE(PG8_SB(1, 1), b3 + hstepB, voffB);
            PG8_WAIT_V(6); PG8_BAR; PG8_MMA(1, 1, At, B1); PG8_BAR;
            }
        }
        if constexpr (ALIGN_EPI) { if (wr == 0) PG8_BAR; }
        if constexpr (!Epi::AFTER_DRAIN) { E(acc, cur, wr, wc, fr, fq); S.done(cur); }
        if (!has_next) break;
#pragma unroll
        for (int a = 0; a < 2; ++a)
#pragma unroll
            for (int b = 0; b < 2; ++b)
#pragma unroll
                for (int m = 0; m < 4; ++m)
#pragma unroll
                    for (int n = 0; n < 2; ++n) acc[a][b][m][n] = (f32x4){0.f, 0.f, 0.f, 0.f};
        cur = nxt; cA = nA; cB = nB; ++ui;
        if constexpr (ALIGN_EPI) { if (wr == 1) PG8_BAR; }
    }
    PG8_WAIT_V(0);
    if constexpr (!ALIGN_EPI) { if (wr == 0) PG8_BAR; }
    PG8_BAR;
    if constexpr (Epi::AFTER_DRAIN) { E.fused(acc, cur, wr, wc, fr, fq, lds, wid, lane); S.done(cur); }
#undef PG8_SA
#undef PG8_SB
#undef PG8_STAGE
#undef PG8_LDA
#undef PG8_LDB
#undef PG8_MMA
#undef PG8_WAIT_V
#undef PG8_WAIT_L
#undef PG8_BAR
#undef PG8_SCHED
}
}

#define LAS __attribute__((address_space(3)))
#define XB_TMO      128
#define XB_XCNT(j)  (256  + 64 * (j))
#define XB_XSUB(j)  (1280 + 64 * (j))
#define XB_XGEN(j)  (2304 + 64 * (j))
#define XB_TOP      3328
#define XB_TOPGEN   3392
#define XCD_BAR_WORDS 3456
#define XB_SPIN_CAP (1u << 18)

__device__ __forceinline__ unsigned xb_ld(unsigned* p)              { return __hip_atomic_load(p, __ATOMIC_RELAXED, __HIP_MEMORY_SCOPE_AGENT); }
__device__ __forceinline__ unsigned xb_add(unsigned* p, unsigned v) { return __hip_atomic_fetch_add(p, v, __ATOMIC_RELAXED, __HIP_MEMORY_SCOPE_AGENT); }
__device__ __forceinline__ unsigned xb_xcc_id() { return (unsigned)__builtin_amdgcn_s_getreg((3 << 11) | 20) & 0xFu; }
#define XB_SPIN(cond, bar) do { unsigned _sp = 0; while (cond) { __builtin_amdgcn_s_sleep(1); \
    if ((++_sp & 255u) == 0u) { if (xb_ld(&(bar)[XB_TMO])) break; if (_sp > XB_SPIN_CAP) { atomicAdd(&(bar)[XB_TMO], 1u); break; } } } } while (0)

struct XcdBarrier {
    unsigned* bar; unsigned x;
    volatile LAS unsigned* st;
};

__device__ __forceinline__ XcdBarrier xcd_barrier_post(unsigned* bar, volatile LAS unsigned* st) {
    XcdBarrier b; b.bar = bar; b.x = xb_xcc_id(); b.st = st;
    if (threadIdx.x == 0) (void)xb_add(&bar[XB_XCNT(b.x)], 1u);
    return b;
}
__device__ __forceinline__ void xcd_barrier_complete(unsigned* bar, unsigned x, unsigned& nloc, unsigned& nx) {
    const unsigned G = gridDim.x * gridDim.y * gridDim.z;
    unsigned sum, cnt, mine, sp = 0u;
    for (;;) {
        sum = 0u; cnt = 0u; mine = 0u;
#pragma unroll
        for (unsigned j = 0; j < 16; ++j) { const unsigned c = xb_ld(&bar[XB_XCNT(j)]); sum += c; cnt += (c > 0u) ? 1u : 0u; mine = (j == x) ? c : mine; }
        if (sum == G) break;
        __builtin_amdgcn_s_sleep(1);
        if ((++sp & 255u) == 0u) { if (xb_ld(&bar[XB_TMO])) break; if (sp > XB_SPIN_CAP) { atomicAdd(&bar[XB_TMO], 1u); break; } }
    }
    nloc = mine > 0u ? mine : 1u; nx = cnt > 0u ? cnt : 1u;
}

__device__ __forceinline__ void xcd_barrier(const XcdBarrier& b) {
    asm volatile("s_waitcnt vmcnt(0)" ::: "memory");
    __syncthreads();
    if (threadIdx.x == 0) {
        unsigned* bar = b.bar;
        __builtin_amdgcn_s_waitcnt(0);
        unsigned nloc = b.st[0], nx = b.st[1];
        if (nloc == 0u) { xcd_barrier_complete(bar, b.x, nloc, nx); b.st[0] = nloc; b.st[1] = nx; }
        const unsigned old = xb_add(&bar[XB_XSUB(b.x)], 1u);
        const unsigned gen = old / nloc;
        if (old + 1u == (gen + 1u) * nloc) {
            __builtin_amdgcn_fence(__ATOMIC_RELEASE, "agent");
            asm volatile("s_waitcnt vmcnt(0)" ::: "memory");
            const unsigned og = xb_add(&bar[XB_TOP], 1u);
            const unsigned tg = og / nx;
            if (og + 1u == (tg + 1u) * nx) xb_add(&bar[XB_TOPGEN], 1u);
            else XB_SPIN(xb_ld(&bar[XB_TOPGEN]) == tg, bar);
            __builtin_amdgcn_fence(__ATOMIC_ACQUIRE, "agent");
            xb_add(&bar[XB_XGEN(b.x)], 1u);
            asm volatile("s_waitcnt vmcnt(0)" ::: "memory");
        } else {
            XB_SPIN(xb_ld(&bar[XB_XGEN(b.x)]) == gen, bar);
            __builtin_amdgcn_fence(__ATOMIC_ACQUIRE, "agent");
            asm volatile("s_waitcnt vmcnt(0)" ::: "memory");
        }
    }
    __syncthreads();
}

namespace mk {
using pg8::bf16_t;
constexpr int NWAVES = 8, NTHR = 512;
constexpr int D = 1024, NB = 16, S = 2048, T = NB * S, NIN = 9222, NP = 9216;
constexpr int DFF = 2816, NE = 8, DFE = 3584;
constexpr float EPS = 1e-6f, LOG2E = 1.4426950408889634f;
constexpr int CH_B = 8, CH_T = CH_B * S;

constexpr size_t WS_CTL = 0, CTL_BYTES = 1u << 20;
constexpr size_t WS_MOD = WS_CTL + CTL_BYTES;
constexpr size_t WS_MISC = WS_MOD + (size_t)2 * NB * 6 * D * 4;
constexpr size_t WS_WIN = WS_MISC + (8u << 20);
constexpr size_t WS_WBR = WS_WIN + (size_t)2 * NP * D * 2;
constexpr size_t WS_WOUT = WS_WBR + (size_t)2 * 1280 * D * 2;
constexpr size_t WS_WGU0 = WS_WOUT + (size_t)2 * D * D * 2;
constexpr size_t WS_WD0 = WS_WGU0 + (size_t)2 * DFF * D * 2;
constexpr size_t WS_WGU1 = WS_WD0 + (size_t)D * DFF * 2;
constexpr size_t WS_WD1 = WS_WGU1 + (size_t)NE * 2 * DFE * D * 2;
constexpr size_t WS_H = WS_WD1 + (size_t)NE * D * DFE * 2;
constexpr size_t WS_PROJ = WS_H + (size_t)T * D * 2;
constexpr size_t WS_END = WS_PROJ + (size_t)CH_T * NP * 2;
static_assert(WS_END <= 640000000ull, "d_ws map");
constexpr int MI_LAM = 0;
constexpr int MOE_MAXT = 264, MOE_ROWS = MOE_MAXT * 256;
constexpr int MI_TILE_E = 1024;
constexpr int MI_TOK_E = 4096;
constexpr int MI_TOK_POS = MI_TOK_E + 2 * T;
constexpr int MI_TOK_W = MI_TOK_POS + 2 * T;
constexpr int MI_ROW_W = MI_TOK_W + 2 * T;
constexpr int MI_LOGF = MI_ROW_W + MOE_ROWS;
constexpr int MI_NEGF = MI_LOGF + 8 * T;
constexpr int MI_LSE = MI_NEGF + NB * 6 * S;
constexpr int MI_LUTA = MI_LSE + 3 * CH_T * 8;
constexpr int MI_LUTB = MI_LUTA + 8 * 2240;
constexpr int MI_END = MI_LUTB + 18 * 384;
static_assert(MI_END * 4 <= (8 << 20), "MISC map");
constexpr size_t WS_HS = WS_PROJ;
constexpr size_t WS_ACT1 = WS_PROJ + (size_t)MOE_ROWS * D * 2;
constexpr int MOE_CH = 64;
static_assert(WS_ACT1 + (size_t)72 * 256 * DFE * 2 <= WS_END, "MoE buffers inside the PROJ region");
constexpr int CW_CNT = 64;
constexpr int CW_BAR = 4096;

constexpr int RING_BYTES = 131072, LDS_BYTES = 147456, LDSCTL_OFF = LDS_BYTES - 1024, MISC_OFF = LDSCTL_OFF + 320;

#define GAS __attribute__((address_space(1)))
typedef unsigned v4u __attribute__((ext_vector_type(4)));
typedef unsigned v2u __attribute__((ext_vector_type(2)));
typedef float f32x4 __attribute__((ext_vector_type(4)));
#define LDS_WAIT() asm volatile("s_waitcnt lgkmcnt(0)" ::: "memory")
__device__ __forceinline__ unsigned f2bf(float f) { unsigned u = __builtin_bit_cast(unsigned, f); return (u + 0x7fffu + ((u >> 16) & 1u)) >> 16; }
__device__ __forceinline__ unsigned pk2(float lo, float hi) { return f2bf(lo) | (f2bf(hi) << 16); }
__device__ __forceinline__ float wave_sum(float v) {
#pragma unroll
    for (int o = 1; o < 64; o <<= 1) v += __shfl_xor(v, o);
    return v;
}

struct Params { const float* in[26]; float* out; unsigned char* ws; int lo, hi, li, pad; };

typedef const __attribute__((address_space(4))) Params* CParams;
__device__ __forceinline__ Params load_params() {
#if defined(__HIP_DEVICE_COMPILE__)
    CParams pp = (CParams)__builtin_amdgcn_kernarg_segment_ptr(); asm volatile("" : "+s"(pp));
    Params q;
#pragma unroll
    for (int i = 0; i < 26; ++i) q.in[i] = pp->in[i];
    q.out = pp->out; q.ws = pp->ws; q.lo = pp->lo; q.hi = pp->hi; q.li = pp->li; q.pad = 0; return q;
#else
    return Params{};
#endif
}
constexpr int ST_PRO = 0, LSTEPS = 22, ST_L0 = 1;
constexpr int SO_NORM1 = 0, SO_CHUNK = 1, CSTEPS = 5, SO_NORM2 = 11, SO_FFN = 12;
constexpr int ST_END = ST_L0 + 2 * LSTEPS;

__device__ __forceinline__ void transpose_item(const float* W, int ldw, int K, bf16_t* WT, int k0, int n0, int drow0, LAS float* scr, int lane) {
#pragma unroll 8
    for (int i = 0; i < 32; ++i) { const int kk = 2 * i + (lane >> 5); scr[kk * 33 + (lane & 31)] = W[(size_t)(k0 + kk) * ldw + n0 + (lane & 31)]; }
    LDS_WAIT(); asm volatile("" ::: "memory");
    const int c = lane & 7;
#pragma unroll
    for (int j = 0; j < 4; ++j) { const int n = (lane >> 3) + 8 * j; const LAS float* s = scr + (8 * c) * 33 + n;
        v4u o; o.x = pk2(s[0 * 33], s[1 * 33]); o.y = pk2(s[2 * 33], s[3 * 33]); o.z = pk2(s[4 * 33], s[5 * 33]); o.w = pk2(s[6 * 33], s[7 * 33]);
        *(GAS v4u*)(WT + (size_t)(drow0 + n) * K + k0 + 8 * c) = o; }
    LDS_WAIT(); asm volatile("" ::: "memory");
}
struct Job { const float* W; bf16_t* WT; int ldw, K, nblk, mode, drow, first; };
constexpr int NJOBS = 2 * 6 + 3 + 3 * NE;
__device__ __forceinline__ void job_set(LAS Job* J, int& nj, int& items, const float* W, int ldw, int K, int ncols, int mode, int drow, bf16_t* WT) {
    J[nj].W = W; J[nj].WT = WT; J[nj].ldw = ldw; J[nj].K = K; J[nj].nblk = ncols / 32; J[nj].mode = mode; J[nj].drow = drow; J[nj].first = items; ++nj; items += (K / 64) * (ncols / 32);
}
constexpr int PRO_SCR = 0, PRO_SC = 8 * 64 * 33 * 4  , PRO_JOB = PRO_SC + NB * D * 4  , PRO_JN = PRO_JOB + 48 * 40;
static_assert(PRO_JN + 64 <= LDSCTL_OFF && sizeof(Job) == 40 && NJOBS <= 48, "prologue LDS map");

__device__ __forceinline__ void build_luts(const Params& p, int tid);
__device__ __forceinline__ void prologue(const Params& p, LAS unsigned char* lds, int tid, int lane, int wave) {
    unsigned char* ws = p.ws;
    LAS Job* J = (LAS Job*)(lds + PRO_JOB);
    LAS int* JN = (LAS int*)(lds + PRO_JN);
    if (tid == 0) {
        int nj = 0, items = 0;
        for (int l = 0; l < 2; ++l) {
            bf16_t* win = (bf16_t*)(ws + WS_WIN) + (size_t)l * NP * D; const float* w_in = p.in[6] + (size_t)l * D * NIN;
            job_set(J, nj, items, w_in, NIN, D, 6144, 0, 0, win);
            job_set(J, nj, items, w_in + 6150, NIN, D, 3072, 0, 6144, win);
            bf16_t* wbr = (bf16_t*)(ws + WS_WBR) + (size_t)l * 1280 * D;
            job_set(J, nj, items, p.in[14] + (size_t)l * 512 * D, D, 512, D, 0, 0, wbr);
            job_set(J, nj, items, p.in[15] + (size_t)l * 384 * D, D, 384, D, 0, 0, wbr + (size_t)512 * D);
            job_set(J, nj, items, p.in[16] + (size_t)l * 384 * D, D, 384, D, 0, 0, wbr + (size_t)896 * D);
            job_set(J, nj, items, p.in[17] + (size_t)l * D * D, D, D, D, 0, 0, (bf16_t*)(ws + WS_WOUT) + (size_t)l * D * D);
        }
        job_set(J, nj, items, p.in[18], DFF, D, DFF, 1, 0, (bf16_t*)(ws + WS_WGU0));
        job_set(J, nj, items, p.in[19], DFF, D, DFF, 1, 128, (bf16_t*)(ws + WS_WGU0));
        job_set(J, nj, items, p.in[20], D, DFF, D, 0, 0, (bf16_t*)(ws + WS_WD0));
        for (int e = 0; e < NE; ++e) {
            bf16_t* wgu = (bf16_t*)(ws + WS_WGU1) + (size_t)e * 2 * DFE * D;
            job_set(J, nj, items, p.in[22] + (size_t)e * D * DFE, DFE, D, DFE, 1, 0, wgu);
            job_set(J, nj, items, p.in[23] + (size_t)e * D * DFE, DFE, D, DFE, 1, 128, wgu);
            job_set(J, nj, items, p.in[24] + (size_t)e * DFE * D, D, DFE, D, 0, 0, (bf16_t*)(ws + WS_WD1) + (size_t)e * D * DFE);
        }
        JN[0] = nj; JN[1] = items;
    }
    LAS float* sc = (LAS float*)(lds + PRO_SC);
    const bool modblk = blockIdx.x < 192;
    if (modblk) for (int i = tid; i < NB * D; i += NTHR) { const float c = p.in[1][i]; sc[i] = c / (1.0f + __expf(-c)); }
    __syncthreads();
    float* misc = (float*)(ws + WS_MISC);
    if (blockIdx.x == 192 && wave < 2) {
        const int l = wave; const float a = wave_sum(p.in[8][l * 64 + lane] * p.in[9][l * 64 + lane]), b = wave_sum(p.in[10][l * 64 + lane] * p.in[11][l * 64 + lane]);
        const float lam_init = 0.8f - 0.6f * __expf(-0.3f * (float)l);
        if (lane == 0) { misc[MI_LAM + l] = __expf(a) - __expf(b) + lam_init; misc[MI_LAM + 8 + l] = lam_init; }
    }
    if (modblk && wave == 0) {
        const int l = blockIdx.x / 96, j = (blockIdx.x % 96) * 64 + lane;
        const float* w = p.in[4] + (size_t)l * D * 6 * D + j;
        float acc[NB];
#pragma unroll
        for (int b = 0; b < NB; ++b) acc[b] = 0.f;
        for (int k = 0; k < D; ++k) { const float wv = w[(size_t)k * 6 * D];
#pragma unroll
            for (int b = 0; b < NB; ++b) acc[b] += sc[b * D + k] * wv; }
        const float bm = p.in[5][l * 6 * D + j]; float* mod = (float*)(ws + WS_MOD) + (size_t)l * NB * 6 * D + j;
#pragma unroll
        for (int b = 0; b < NB; ++b) mod[(size_t)b * 6 * D] = acc[b] + bm;
    }
    build_luts(p, tid);
    LAS float* scr = (LAS float*)(lds + PRO_SCR) + wave * (64 * 33);
    const int nj = JN[0], nitems = JN[1];
    const int gw = blockIdx.x * NWAVES + wave, NGW = gridDim.x * NWAVES;
    for (int it = gw; it < nitems; it += NGW) {
        int ji = 0;
        for (int q = 1; q < nj; ++q) if (J[q].first <= it) ji = q;
        const float* jW = J[ji].W; bf16_t* jWT = J[ji].WT; const int jldw = J[ji].ldw, jK = J[ji].K, jnblk = J[ji].nblk, jmode = J[ji].mode, jdrow = J[ji].drow;
        const int r = it - J[ji].first, kb = r / jnblk, nb = r - kb * jnblk, n0 = 32 * nb;
        const int drow0 = jmode ? jdrow + 256 * (n0 >> 7) + (n0 & 127) : jdrow + n0;
        transpose_item(jW + n0, jldw, jK, jWT, 64 * kb, 0, drow0, scr, lane);
    }
}

__device__ __forceinline__ void norm_rows(const float* x, const float* g, const float* sc, const float* sh, bf16_t* h, int t0, int t1, int gw, int NGW, int lane) {
    for (int t = t0 + gw; t < t1; t += NGW) {
        const int b = t >> 11;
        const GAS f32x4* xr = (const GAS f32x4*)(x + (size_t)t * D) + lane;
        f32x4 v[4]; float s = 0.f;
#pragma unroll
        for (int j = 0; j < 4; ++j) { v[j] = xr[64 * j]; s += (v[j].x * v[j].x + v[j].y * v[j].y) + (v[j].z * v[j].z + v[j].w * v[j].w); }
        const float r = 1.0f / sqrtf(wave_sum(s) * (1.0f / D) + EPS);
        GAS v2u* o8 = (GAS v2u*)(h + (size_t)t * D) + lane;
#pragma unroll
        for (int j = 0; j < 4; ++j) { const int d = 4 * lane + 256 * j;
            const f32x4 g4 = *(const f32x4*)(g + d), c4 = *(const f32x4*)(sc + (size_t)b * 6 * D + d), h4 = *(const f32x4*)(sh + (size_t)b * 6 * D + d);
            const f32x4 o = v[j] * r * g4 * (c4 + 1.0f) + h4;
            v2u w; w.x = pk2(o.x, o.y); w.y = pk2(o.z, o.w); o8[64 * j] = w; }
    }
}


typedef float f32x16 __attribute__((ext_vector_type(16)));
typedef short bf16x8 __attribute__((ext_vector_type(8)));
typedef short s16x4 __attribute__((ext_vector_type(4)));
typedef float f32x2_t __attribute__((ext_vector_type(2))); typedef __bf16 bf16x2_t __attribute__((ext_vector_type(2)));
constexpr int PITCH = NP;
constexpr int AL_K = 0, AL_V = 32768, AL_LUT = 65536, AL_OST = 86016, AL_XCH = 0;
constexpr int LUTA_N = 2240, LUTB_N = 384;
constexpr float NEG_BIG = -1.0e30f;
__device__ __forceinline__ unsigned cvtpk_s(float lo, float hi) { f32x2_t v = {lo, hi}; bf16x2_t b = __builtin_convertvector(v, bf16x2_t); return __builtin_bit_cast(unsigned, b); }
__device__ __forceinline__ s16x4 vtr(const LAS unsigned char* p) { typedef short v4i16_t __attribute__((ext_vector_type(4))); return __builtin_bit_cast(s16x4, __builtin_amdgcn_ds_read_tr16_b64_v4i16((LAS v4i16_t*)p)); }
__device__ __forceinline__ float xhalf_max(float v) { return fmaxf(v, __shfl_xor(v, 32)); }
__device__ __forceinline__ float xhalf_sum(float v) { return v + __shfl_xor(v, 32); }

struct AttnArgs {
    bf16_t* proj;
    int rowbase;
    int q0;
    int qcol, kcol, vcol;
    const float* tab;
    int seqM;
    float* lse;
    float lam, osc;
    const float* subg;
};
template <int MODE> __device__ __forceinline__ void attn_unit(const AttnArgs& a, LAS unsigned char* lds, int tid, int lane, int wave) {
    constexpr int DV = MODE == 0 ? 128 : 64, NDB = DV / 32, NKL = MODE == 0 ? 2 : 1, NVL = MODE == 0 ? 2 : 1;
    const int r32 = lane & 31, hi = lane >> 5;
    const int map = MODE == 0 ? (wave >> 2) : 0, wq = MODE == 0 ? (wave & 3) : wave;
    const int qrow = a.q0 + 32 * wq;
    const bf16_t* P = a.proj + (size_t)a.rowbase * PITCH;
    LAS float* lut = (LAS float*)(lds + AL_LUT);
    { constexpr int NT = MODE == 0 ? 2 * LUTA_N : (MODE == 1 ? 2048 : LUTB_N);
      const int need = MODE == 1 ? (a.q0 + 256) : NT;
      for (int i = tid; i < need; i += NTHR) lut[i] = a.tab[i]; }
    bf16x8 qr[4];
    { const bf16_t* Qw = P + (size_t)(qrow + r32) * PITCH + a.qcol + map * 64 + hi * 8;
#pragma unroll
      for (int d0 = 0; d0 < 4; ++d0) qr[d0] = *(const bf16x8*)(Qw + d0 * 16); }
    int tlo, thi;
    if (MODE == 0) { tlo = 0; thi = (a.q0 + 128) / 64 - 1; }
    else if (MODE == 1) { tlo = 0; thi = (a.q0 + 256) / 64 - 1; }
    else { const int lo = a.q0 - 128; tlo = lo > 0 ? lo / 64 : 0; thi = (a.q0 + 256) / 64 - 1; }
    const bf16_t* gK = P + (size_t)(tid & 63) * PITCH + a.kcol + (tid >> 6) * 8;
    const bf16_t* gV = P + (size_t)(16 * (wave & 3) + (lane >> 2)) * PITCH + a.vcol + (wave >> 2) * 32 + (lane & 3) * 8;
    const int kst = (tid >> 6) * 1024 + (tid & 63) * 16, vst = wave * 1024 + lane * 16;
    v4u kreg[NKL], vreg[NVL];
#define AT_LOAD(t) do { const size_t ro = (size_t)(t) * 64 * PITCH; \
        _Pragma("unroll") for (int i_ = 0; i_ < NKL; ++i_) kreg[i_] = *(const GAS v4u*)(gK + ro + i_ * 64); \
        _Pragma("unroll") for (int i_ = 0; i_ < NVL; ++i_) vreg[i_] = *(const GAS v4u*)(gV + ro + i_ * 64); } while (0)
#define AT_WRITE(buf) do { \
        _Pragma("unroll") for (int i_ = 0; i_ < NKL; ++i_) *(LAS v4u*)(lds + AL_K + (buf) * 16384 + i_ * 8192 + kst) = kreg[i_]; \
        _Pragma("unroll") for (int i_ = 0; i_ < NVL; ++i_) *(LAS v4u*)(lds + AL_V + (buf) * 16384 + i_ * 8192 + vst) = vreg[i_]; } while (0)
    float m_run = NEG_BIG, l_run = 0.f;
    f32x16 o[NDB];
#pragma unroll
    for (int i = 0; i < NDB; ++i) o[i] = f32x16{};
    const int e0 = qrow + r32 - 4 * hi;
    int imax = 0, seq0 = 0;
    if (MODE == 2) { seq0 = qrow & ~(a.seqM - 1); const int dq = qrow + r32 - seq0; imax = dq < 128 ? dq : 128; }
    AT_LOAD(tlo); AT_WRITE(0);
    __syncthreads();
    for (int t = tlo; t <= thi; ++t) {
        const int buf = (t - tlo) & 1;
        if (t < thi) AT_LOAD(t + 1);
        bool active = true;
        if (MODE == 2) { const int klo = qrow - 128 > seq0 ? qrow - 128 : seq0; active = (64 * t <= qrow + 31) && (64 * t + 63 >= klo); }
        if (active) {
            const int E = e0 - 64 * t;
            f32x16 p0, p1;
            if (MODE == 1) { const LAS float* nf = lut + 64 * t + 4 * hi;
#pragma unroll
                for (int g = 0; g < 4; ++g) { const f32x4 a0 = *(const LAS f32x4*)(nf + 8 * g), a1 = *(const LAS f32x4*)(nf + 32 + 8 * g);
                    p0[4 * g] = a0.x; p0[4 * g + 1] = a0.y; p0[4 * g + 2] = a0.z; p0[4 * g + 3] = a0.w; p1[4 * g] = a1.x; p1[4 * g + 1] = a1.y; p1[4 * g + 2] = a1.z; p1[4 * g + 3] = a1.w; }
            } else { const LAS float* lb = lut + (MODE == 0 ? map * LUTA_N + 2047 - E : 255 - E);
#pragma unroll
                for (int r = 0; r < 16; ++r) { p0[r] = lb[(r & 3) + 8 * (r >> 2)]; p1[r] = lb[32 + (r & 3) + 8 * (r >> 2)]; } }
            { const LAS unsigned char* kb = lds + AL_K + buf * 16384 + map * 8192 + hi * 1024 + r32 * 16;
#pragma unroll
              for (int d0 = 0; d0 < 4; ++d0) { const bf16x8 b0 = *(const LAS bf16x8*)(kb + d0 * 2048), b1 = *(const LAS bf16x8*)(kb + d0 * 2048 + 512);
                  p0 = __builtin_amdgcn_mfma_f32_32x32x16_bf16(b0, qr[d0], p0, 0, 0, 0); p1 = __builtin_amdgcn_mfma_f32_32x32x16_bf16(b1, qr[d0], p1, 0, 0, 0); } }
            if (MODE == 2) {
#pragma unroll
                for (int r = 0; r < 16; ++r) { const int c0 = (r & 3) + 8 * (r >> 2), c1 = c0 + 32;
                    if (c0 > E || c0 < E - imax) p0[r] = -INFINITY; if (c1 > E || c1 < E - imax) p1[r] = -INFINITY; }
            } else if (t >= thi - (MODE == 0 ? 1 : 3)) {
#pragma unroll
                for (int r = 0; r < 16; ++r) { const int c0 = (r & 3) + 8 * (r >> 2), c1 = c0 + 32; if (c0 > E) p0[r] = -INFINITY; if (c1 > E) p1[r] = -INFINITY; }
            }
            float tm = fmaxf(p0[0], p1[0]);
#pragma unroll
            for (int r = 1; r < 16; ++r) tm = fmaxf(tm, fmaxf(p0[r], p1[r]));
            tm = xhalf_max(tm);
            if (__any(tm > m_run)) {
                const float mn = fmaxf(m_run, tm), al = __builtin_amdgcn_exp2f(m_run - mn);
                m_run = mn; l_run *= al;
#pragma unroll
                for (int i = 0; i < NDB; ++i)
#pragma unroll
                    for (int r = 0; r < 16; ++r) o[i][r] *= al;
            }
            float rs = 0.f;
#pragma unroll
            for (int r = 0; r < 16; ++r) { p0[r] = __builtin_amdgcn_exp2f(p0[r] - m_run); p1[r] = __builtin_amdgcn_exp2f(p1[r] - m_run); rs += p0[r] + p1[r]; }
            l_run += rs;
            bf16x8 pw[4];
#pragma unroll
            for (int ks = 0; ks < 4; ++ks) { v4u w;
                if (ks < 2) { w.x = cvtpk_s(p0[8 * ks], p0[8 * ks + 1]); w.y = cvtpk_s(p0[8 * ks + 2], p0[8 * ks + 3]); w.z = cvtpk_s(p0[8 * ks + 4], p0[8 * ks + 5]); w.w = cvtpk_s(p0[8 * ks + 6], p0[8 * ks + 7]); }
                else { const int k2 = ks - 2; w.x = cvtpk_s(p1[8 * k2], p1[8 * k2 + 1]); w.y = cvtpk_s(p1[8 * k2 + 2], p1[8 * k2 + 3]); w.z = cvtpk_s(p1[8 * k2 + 4], p1[8 * k2 + 5]); w.w = cvtpk_s(p1[8 * k2 + 6], p1[8 * k2 + 7]); }
                pw[ks] = __builtin_bit_cast(bf16x8, w); }
            { const LAS unsigned char* vb = lds + AL_V + buf * 16384 + ((lane >> 4) & 1) * 32 + (lane & 3) * 8 + (4 * hi + ((lane & 15) >> 2)) * 64;
#pragma unroll
              for (int db = 0; db < NDB; ++db)
#pragma unroll
                  for (int ks = 0; ks < 4; ++ks) { const s16x4 lo = vtr(vb + db * 4096 + ks * 1024), hh = vtr(vb + db * 4096 + ks * 1024 + 512);
                      const bf16x8 vf = {lo[0], lo[1], lo[2], lo[3], hh[0], hh[1], hh[2], hh[3]};
                      o[db] = __builtin_amdgcn_mfma_f32_32x32x16_bf16(vf, pw[ks], o[db], 0, 0, 0); } }
        }
        if (t < thi) AT_WRITE(buf ^ 1);
        __syncthreads();
    }
#undef AT_LOAD
#undef AT_WRITE
    const float lt = xhalf_sum(l_run), inv = 1.0f / lt;
#pragma unroll
    for (int i = 0; i < NDB; ++i)
#pragma unroll
        for (int r = 0; r < 16; ++r) o[i][r] *= inv;
    if (MODE == 2) { if (hi == 0) a.lse[(size_t)(a.rowbase + qrow + r32) * 8] = m_run + __builtin_amdgcn_logf(lt); }
    bool store = true;
    if (MODE == 0) {
        LAS float* xch = (LAS float*)(lds + AL_XCH) + wq * 4096;
        if (map == 1) {
#pragma unroll
            for (int i = 0; i < NDB; ++i)
#pragma unroll
                for (int r = 0; r < 16; ++r) xch[(i * 16 + r) * 64 + lane] = o[i][r];
        }
        __syncthreads();
        if (map == 0) {
            float ss = 0.f;
#pragma unroll
            for (int i = 0; i < NDB; ++i)
#pragma unroll
                for (int r = 0; r < 16; ++r) { const float v = o[i][r] - a.lam * xch[(i * 16 + r) * 64 + lane]; o[i][r] = v; ss += v * v; }
            ss = xhalf_sum(ss);
            const float rn = (1.0f / sqrtf(ss * (1.0f / 128.0f) + EPS)) * a.osc;
#pragma unroll
            for (int i = 0; i < NDB; ++i)
#pragma unroll
                for (int g = 0; g < 4; ++g) { const f32x4 sg = *(const f32x4*)(a.subg + 32 * i + 8 * g + 4 * hi);
                    o[i][4 * g] *= rn * sg.x; o[i][4 * g + 1] *= rn * sg.y; o[i][4 * g + 2] *= rn * sg.z; o[i][4 * g + 3] *= rn * sg.w; }
        }
        store = map == 0;
    }
    if (store) {
        constexpr int RS = DV * 2 + 16;
        LAS unsigned char* ost = lds + AL_OST + wq * (32 * RS);
#pragma unroll
        for (int i = 0; i < NDB; ++i)
#pragma unroll
            for (int g = 0; g < 4; ++g) { v2u w; w.x = cvtpk_s(o[i][4 * g], o[i][4 * g + 1]); w.y = cvtpk_s(o[i][4 * g + 2], o[i][4 * g + 3]);
                *(LAS v2u*)(ost + r32 * RS + (32 * i + 8 * g + 4 * hi) * 2) = w; }
        LDS_WAIT();
        bf16_t* Ow = a.proj + (size_t)(a.rowbase + qrow) * PITCH + a.qcol;
        constexpr int CPR = DV / 8, RPI = 64 / CPR;
#pragma unroll
        for (int i = 0; i < 32 / RPI; ++i) { const int row = i * RPI + lane / CPR, ch = lane % CPR;
            const v4u v = *(const LAS v4u*)(ost + row * RS + ch * 16); *(GAS v4u*)(Ow + (size_t)row * PITCH + ch * 8) = v; }
    }
    __syncthreads();
}
__device__ const unsigned short SCHED_AC[256][6] = {
{0,848,1280,65535,65535,65535},
{1,849,1281,65535,65535,65535},
{2,850,1282,65535,65535,65535},
{3,851,1283,65535,65535,65535},
{4,852,1284,65535,65535,65535},
{5,853,1285,65535,65535,65535},
{6,854,1286,65535,65535,65535},
{7,855,1287,65535,65535,65535},
{8,856,1288,65535,65535,65535},
{9,857,1289,65535,65535,65535},
{10,858,1290,65535,65535,65535},
{11,859,1291,65535,65535,65535},
{12,860,1292,65535,65535,65535},
{13,861,1293,65535,65535,65535},
{14,862,1294,65535,65535,65535},
{15,863,1295,65535,65535,65535},
{16,864,1296,65535,65535,65535},
{17,865,1297,65535,65535,65535},
{18,866,1298,65535,65535,65535},
{19,867,1299,65535,65535,65535},
{20,868,1300,65535,65535,65535},
{21,869,1301,65535,65535,65535},
{22,870,1302,65535,65535,65535},
{23,871,1303,65535,65535,65535},
{24,872,1304,65535,65535,65535},
{25,873,1305,65535,65535,65535},
{26,874,1306,65535,65535,65535},
{27,875,1307,65535,65535,65535},
{28,876,1308,65535,65535,65535},
{29,877,1309,65535,65535,65535},
{30,878,1310,65535,65535,65535},
{31,879,1311,65535,65535,65535},
{64,784,1216,1344,65535,65535},
{65,785,1217,1345,65535,65535},
{66,786,1218,1346,65535,65535},
{67,787,1219,1347,65535,65535},
{68,788,1220,1348,65535,65535},
{69,789,1221,1349,65535,65535},
{70,790,1222,1350,65535,65535},
{71,791,1223,1351,65535,65535},
{72,792,1224,1352,65535,65535},
{73,793,1225,1353,65535,65535},
{74,794,1226,1354,65535,65535},
{75,795,1227,1355,65535,65535},
{76,796,1228,1356,65535,65535},
{77,797,1229,1357,65535,65535},
{78,798,1230,1358,65535,65535},
{79,799,1231,1359,65535,65535},
{80,832,1184,65535,65535,65535},
{81,833,1185,65535,65535,65535},
{82,834,1186,65535,65535,65535},
{83,835,1187,65535,65535,65535},
{84,836,1188,65535,65535,65535},
{85,837,1189,65535,65535,65535},
{86,838,1190,65535,65535,65535},
{87,839,1191,65535,65535,65535},
{88,840,1192,65535,65535,65535},
{89,841,1193,65535,65535,65535},
{90,842,1194,65535,65535,65535},
{91,843,1195,65535,65535,65535},
{92,844,1196,65535,65535,65535},
{93,845,1197,65535,65535,65535},
{94,846,1198,65535,65535,65535},
{95,847,1199,65535,65535,65535},
{128,736,1232,1360,65535,65535},
{129,737,1233,1361,65535,65535},
{130,738,1234,1362,65535,65535},
{131,739,1235,1363,65535,65535},
{132,740,1236,1364,65535,65535},
{133,741,1237,1365,65535,65535},
{134,742,1238,1366,65535,65535},
{135,743,1239,1367,65535,65535},
{136,744,1240,1368,65535,65535},
{137,745,1241,1369,65535,65535},
{138,746,1242,1370,65535,65535},
{139,747,1243,1371,65535,65535},
{140,748,1244,1372,65535,65535},
{141,749,1245,1373,65535,65535},
{142,750,1246,1374,65535,65535},
{143,751,1247,1375,65535,65535},
{144,768,1104,1408,65535,65535},
{145,769,1105,1409,65535,65535},
{146,770,1106,1410,65535,65535},
{147,771,1107,1411,65535,65535},
{148,772,1108,1412,65535,65535},
{149,773,1109,1413,65535,65535},
{150,774,1110,1414,65535,65535},
{151,775,1111,1415,65535,65535},
{152,776,1112,1416,65535,65535},
{153,777,1113,1417,65535,65535},
{154,778,1114,1418,65535,65535},
{155,779,1115,1419,65535,65535},
{156,780,1116,1420,65535,65535},
{157,781,1117,1421,65535,65535},
{158,782,1118,1422,65535,65535},
{159,783,1119,1423,65535,65535},
{192,704,1152,1424,65535,65535},
{193,705,1153,1425,65535,65535},
{194,706,1154,1426,65535,65535},
{195,707,1155,1427,65535,65535},
{196,708,1156,1428,65535,65535},
{197,709,1157,1429,65535,65535},
{198,710,1158,1430,65535,65535},
{199,711,1159,1431,65535,65535},
{200,712,1160,1432,65535,65535},
{201,713,1161,1433,65535,65535},
{202,714,1162,1434,65535,65535},
{203,715,1163,1435,65535,65535},
{204,716,1164,1436,65535,65535},
{205,717,1165,1437,65535,65535},
{206,718,1166,1438,65535,65535},
{207,719,1167,1439,65535,65535},
{208,720,1168,1440,65535,65535},
{209,721,1169,1441,65535,65535},
{210,722,1170,1442,65535,65535},
{211,723,1171,1443,65535,65535},
{212,724,1172,1444,65535,65535},
{213,725,1173,1445,65535,65535},
{214,726,1174,1446,65535,65535},
{215,727,1175,1447,65535,65535},
{216,728,1176,1448,65535,65535},
{217,729,1177,1449,65535,65535},
{218,730,1178,1450,65535,65535},
{219,731,1179,1451,65535,65535},
{220,732,1180,1452,65535,65535},
{221,733,1181,1453,65535,65535},
{222,734,1182,1454,65535,65535},
{223,735,1183,1455,65535,65535},
{256,640,896,65535,65535,65535},
{257,641,897,65535,65535,65535},
{258,642,898,65535,65535,65535},
{259,643,899,65535,65535,65535},
{260,644,900,65535,65535,65535},
{261,645,901,65535,65535,65535},
{262,646,902,65535,65535,65535},
{263,647,903,65535,65535,65535},
{264,648,904,65535,65535,65535},
{265,649,905,65535,65535,65535},
{266,650,906,65535,65535,65535},
{267,651,907,65535,65535,65535},
{268,652,908,65535,65535,65535},
{269,653,909,65535,65535,65535},
{270,654,910,65535,65535,65535},
{271,655,911,65535,65535,65535},
{272,656,912,65535,65535,65535},
{273,657,913,65535,65535,65535},
{274,658,914,65535,65535,65535},
{275,659,915,65535,65535,65535},
{276,660,916,65535,65535,65535},
{277,661,917,65535,65535,65535},
{278,662,918,65535,65535,65535},
{279,663,919,65535,65535,65535},
{280,664,920,65535,65535,65535},
{281,665,921,65535,65535,65535},
{282,666,922,65535,65535,65535},
{283,667,923,65535,65535,65535},
{284,668,924,65535,65535,65535},
{285,669,925,65535,65535,65535},
{286,670,926,65535,65535,65535},
{287,671,927,65535,65535,65535},
{320,576,960,65535,65535,65535},
{321,577,961,65535,65535,65535},
{322,578,962,65535,65535,65535},
{323,579,963,65535,65535,65535},
{324,580,964,65535,65535,65535},
{325,581,965,65535,65535,65535},
{326,582,966,65535,65535,65535},
{327,583,967,65535,65535,65535},
{328,584,968,65535,65535,65535},
{329,585,969,65535,65535,65535},
{330,586,970,65535,65535,65535},
{331,587,971,65535,65535,65535},
{332,588,972,65535,65535,65535},
{333,589,973,65535,65535,65535},
{334,590,974,65535,65535,65535},
{335,591,975,65535,65535,65535},
{336,592,976,65535,65535,65535},
{337,593,977,65535,65535,65535},
{338,594,978,65535,65535,65535},
{339,595,979,65535,65535,65535},
{340,596,980,65535,65535,65535},
{341,597,981,65535,65535,65535},
{342,598,982,65535,65535,65535},
{343,599,983,65535,65535,65535},
{344,600,984,65535,65535,65535},
{345,601,985,65535,65535,65535},
{346,602,986,65535,65535,65535},
{347,603,987,65535,65535,65535},
{348,604,988,65535,65535,65535},
{349,605,989,65535,65535,65535},
{350,606,990,65535,65535,65535},
{351,607,991,65535,65535,65535},
{384,512,992,65535,65535,65535},
{385,513,993,65535,65535,65535},
{386,514,994,65535,65535,65535},
{387,515,995,65535,65535,65535},
{388,516,996,65535,65535,65535},
{389,517,997,65535,65535,65535},
{390,518,998,65535,65535,65535},
{391,519,999,65535,65535,65535},
{392,520,1000,65535,65535,65535},
{393,521,1001,65535,65535,65535},
{394,522,1002,65535,65535,65535},
{395,523,1003,65535,65535,65535},
{396,524,1004,65535,65535,65535},
{397,525,1005,65535,65535,65535},
{398,526,1006,65535,65535,65535},
{399,527,1007,65535,65535,65535},
{400,528,1024,1472,65535,65535},
{401,529,1025,1473,65535,65535},
{402,530,1026,1474,65535,65535},
{403,531,1027,1475,65535,65535},
{404,532,1028,1476,65535,65535},
{405,533,1029,1477,65535,65535},
{406,534,1030,1478,65535,65535},
{407,535,1031,1479,65535,65535},
{408,536,1032,1480,65535,65535},
{409,537,1033,1481,65535,65535},
{410,538,1034,1482,65535,65535},
{411,539,1035,1483,65535,65535},
{412,540,1036,1484,65535,65535},
{413,541,1037,1485,65535,65535},
{414,542,1038,1486,65535,65535},
{415,543,1039,1487,65535,65535},
{416,544,1040,1488,65535,65535},
{417,545,1041,1489,65535,65535},
{418,546,1042,1490,65535,65535},
{419,547,1043,1491,65535,65535},
{420,548,1044,1492,65535,65535},
{421,549,1045,1493,65535,65535},
{422,550,1046,1494,65535,65535},
{423,551,1047,1495,65535,65535},
{424,552,1048,1496,65535,65535},
{425,553,1049,1497,65535,65535},
{426,554,1050,1498,65535,65535},
{427,555,1051,1499,65535,65535},
{428,556,1052,1500,65535,65535},
{429,557,1053,1501,65535,65535},
{430,558,1054,1502,65535,65535},
{431,559,1055,1503,65535,65535},
{448,464,1088,1312,65535,65535},
{449,465,1089,1313,65535,65535},
{450,466,1090,1314,65535,65535},
{451,467,1091,1315,65535,65535},
{452,468,1092,1316,65535,65535},
{453,469,1093,1317,65535,65535},
{454,470,1094,1318,65535,65535},
{455,471,1095,1319,65535,65535},
{456,472,1096,1320,65535,65535},
{457,473,1097,1321,65535,65535},
{458,474,1098,1322,65535,65535},
{459,475,1099,1323,65535,65535},
{460,476,1100,1324,65535,65535},
{461,477,1101,1325,65535,65535},
{462,478,1102,1326,65535,65535},
{463,479,1103,1327,65535,65535}
};

static_assert(LUTA_N == 2240 && LUTB_N == 384, "table sizes vs the MISC map");
__device__ __forceinline__ int t5_bucket(int n) {
    if (n < 16) return n < 0 ? 0 : n;
    int b = 16;
    b += n >= 22; b += n >= 30; b += n >= 40; b += n >= 54; b += n >= 73; b += n >= 99; b += n >= 134; b += n >= 182; b += n >= 246; b += n >= 332; b += n >= 450; b += n >= 609; b += n >= 825; b += n >= 1117; b += n >= 1513;
    return b;
}
__device__ __forceinline__ void build_luts(const Params& p, int tid) {
    float* misc = (float*)(p.ws + WS_MISC); const float* rb = p.in[13];
    for (int i = blockIdx.x * NTHR + tid; i < 8 * LUTA_N + 18 * LUTB_N; i += gridDim.x * NTHR) {
        if (i < 8 * LUTA_N) { const int hm = i / LUTA_N, j = i % LUTA_N, d = 2047 - j; misc[MI_LUTA + i] = d >= 0 ? rb[t5_bucket(d) * 26 + hm] * LOG2E : 0.f; }
        else { const int k = i - 8 * LUTA_N, gh = k / LUTB_N, j = k % LUTB_N, ii = 255 - j, g = gh / 6; misc[MI_LUTB + k] = (ii >= 0 && ii <= 128) ? rb[t5_bucket(ii << (2 * g)) * 26 + 8 + gh] * LOG2E : 0.f; }
    }
}
__device__ __forceinline__ void norm_logf(const Params& p, int L, const float* x, const float* g, const float* sc, const float* sh, bf16_t* h, LAS unsigned char* lds, int tid, int lane, int wave) {
    LAS float* wf = (LAS float*)lds;
    const float* w_in = p.in[6] + (size_t)L * D * NIN;
    for (int i = tid; i < D * 8; i += NTHR) { const int d = i >> 3, e = i & 7; wf[i] = e < 6 ? w_in[(size_t)d * NIN + 6144 + e] : 0.f; }
    __syncthreads();
    const int gw = blockIdx.x * NWAVES + wave, NGW = gridDim.x * NWAVES;
    float* logf = (float*)(p.ws + WS_MISC) + MI_LOGF;
    const float bfv = lane < 6 ? p.in[7][L * 6 + lane] : 0.f;
    for (int t = gw; t < T; t += NGW) {
        const int b = t >> 11;
        const GAS f32x4* xr = (const GAS f32x4*)(x + (size_t)t * D) + lane;
        f32x4 v[4]; float s = 0.f;
#pragma unroll
        for (int j = 0; j < 4; ++j) { v[j] = xr[64 * j]; s += (v[j].x * v[j].x + v[j].y * v[j].y) + (v[j].z * v[j].z + v[j].w * v[j].w); }
        const float r = 1.0f / sqrtf(wave_sum(s) * (1.0f / D) + EPS);
        GAS v2u* o8 = (GAS v2u*)(h + (size_t)t * D) + lane;
        float lg[8];
#pragma unroll
        for (int e = 0; e < 8; ++e) lg[e] = 0.f;
#pragma unroll
        for (int j = 0; j < 4; ++j) { const int d = 4 * lane + 256 * j;
            const f32x4 g4 = *(const f32x4*)(g + d), c4 = *(const f32x4*)(sc + (size_t)b * 6 * D + d), h4 = *(const f32x4*)(sh + (size_t)b * 6 * D + d);
            const f32x4 o = v[j] * r * g4 * (c4 + 1.0f) + h4;
            v2u w; w.x = pk2(o.x, o.y); w.y = pk2(o.z, o.w); o8[64 * j] = w;
#pragma unroll
            for (int cc = 0; cc < 4; ++cc) { const f32x4 w0 = *(const LAS f32x4*)(wf + (d + cc) * 8), w1 = *(const LAS f32x4*)(wf + (d + cc) * 8 + 4); const float ov = o[cc];
                lg[0] += ov * w0.x; lg[1] += ov * w0.y; lg[2] += ov * w0.z; lg[3] += ov * w0.w; lg[4] += ov * w1.x; lg[5] += ov * w1.y; } }
        float mine = 0.f;
#pragma unroll
        for (int e = 0; e < 6; ++e) { const float sm = wave_sum(lg[e]); if (lane == e) mine = sm; }
        if (lane < 6) { const float z = mine + bfv; logf[(size_t)t * 8 + lane] = fminf(z, 0.f) - log1pf(__expf(-fabsf(z))); }
    }
}
__device__ __forceinline__ void negf_cumsum(const Params& p, int b, int hh, int lane) {
    const float* logf = (const float*)(p.ws + WS_MISC) + MI_LOGF + (size_t)b * S * 8 + hh;
    float* nf = (float*)(p.ws + WS_MISC) + MI_NEGF + (size_t)(b * 6 + hh) * S;
    float run = 0.f; float loc[32];
#pragma unroll
    for (int i = 0; i < 32; ++i) { run += logf[(size_t)(lane * 32 + i) * 8]; loc[i] = run; }
    float incl = run;
#pragma unroll
    for (int o = 1; o < 64; o <<= 1) { const float u = __shfl_up(incl, o); if (lane >= o) incl += u; }
    const float excl = incl - run;
#pragma unroll
    for (int i = 0; i < 32; ++i) nf[lane * 32 + i] = -(excl + loc[i]) * LOG2E;
}
__device__ __forceinline__ void merge_b(const Params& p, int lane, int wave) {
    bf16_t* proj = (bf16_t*)(p.ws + WS_PROJ); const float* lse = (const float*)(p.ws + WS_MISC) + MI_LSE;
    const int gw = blockIdx.x * NWAVES + wave, NGW = gridDim.x * NWAVES;
    for (int r = gw; r < CH_T; r += NGW) {
        if (lane < 48) {
            const int t = r & 2047, base = r & ~2047, h = lane >> 3;
            const int r1 = base | ((t & 3) << 9) | (t >> 2), r2 = base | ((t & 15) << 7) | (t >> 4);
            const float l0 = lse[(size_t)r * 8 + h], l1 = lse[(size_t)(CH_T + r1) * 8 + h], l2 = lse[(size_t)(2 * CH_T + r2) * 8 + h];
            const float mx = fmaxf(l0, fmaxf(l1, l2));
            float a0 = __builtin_amdgcn_exp2f(l0 - mx), a1 = __builtin_amdgcn_exp2f(l1 - mx), a2 = __builtin_amdgcn_exp2f(l2 - mx);
            const float is = 1.0f / (a0 + a1 + a2); a0 *= is; a1 *= is; a2 *= is;
            const v4u o0 = *(const GAS v4u*)(proj + (size_t)r * NP + 1536 + lane * 8), o1 = *(const GAS v4u*)(proj + (size_t)r1 * NP + 1536 + 384 + lane * 8), o2 = *(const GAS v4u*)(proj + (size_t)r2 * NP + 1536 + 768 + lane * 8);
            v4u w;
            w.x = pk2(a0 * pg8::bf_lo(o0.x) + a1 * pg8::bf_lo(o1.x) + a2 * pg8::bf_lo(o2.x), a0 * pg8::bf_hi(o0.x) + a1 * pg8::bf_hi(o1.x) + a2 * pg8::bf_hi(o2.x));
            w.y = pk2(a0 * pg8::bf_lo(o0.y) + a1 * pg8::bf_lo(o1.y) + a2 * pg8::bf_lo(o2.y), a0 * pg8::bf_hi(o0.y) + a1 * pg8::bf_hi(o1.y) + a2 * pg8::bf_hi(o2.y));
            w.z = pk2(a0 * pg8::bf_lo(o0.z) + a1 * pg8::bf_lo(o1.z) + a2 * pg8::bf_lo(o2.z), a0 * pg8::bf_hi(o0.z) + a1 * pg8::bf_hi(o1.z) + a2 * pg8::bf_hi(o2.z));
            w.w = pk2(a0 * pg8::bf_lo(o0.w) + a1 * pg8::bf_lo(o1.w) + a2 * pg8::bf_lo(o2.w), a0 * pg8::bf_hi(o0.w) + a1 * pg8::bf_hi(o1.w) + a2 * pg8::bf_hi(o2.w));
            *(GAS v4u*)(proj + (size_t)r * NP + 1536 + lane * 8) = w;
        }
    }
}
__device__ __forceinline__ void attn_b_phase(const Params& p, LAS unsigned char* lds, int tid, int lane, int wave) {
    const float* misc = (const float*)(p.ws + WS_MISC);
    for (int L = blockIdx.x; L < CH_B * 3 * 6 * 8; L += gridDim.x) {
        const int blk = L & 7, h = (L >> 3) % 6, g = (L / 48) % 3, b = L / 144;
        AttnArgs a; a.proj = (bf16_t*)(p.ws + WS_PROJ); a.rowbase = b * S; a.q0 = blk * 256; a.qcol = 1536 + g * 384 + h * 64; a.kcol = 2688 + g * 384 + h * 64; a.vcol = 3840 + g * 384 + h * 64;
        a.tab = misc + MI_LUTB + (g * 6 + h) * LUTB_N; a.seqM = S >> (2 * g); a.lse = (float*)(p.ws + WS_MISC) + MI_LSE + (size_t)g * CH_T * 8 + h; a.lam = 0.f; a.osc = 0.f; a.subg = nullptr;
        attn_unit<2>(a, lds, tid, lane, wave);
    }
}
__device__ __forceinline__ void attn_ac_phase(const Params& p, int L, int c, LAS unsigned char* lds, int tid, int lane, int wave) {
    const float* misc = (const float*)(p.ws + WS_MISC);
    constexpr unsigned char CTYPE[24] = {0,0,0,0,0,0,1,0,1,0,0,1,0,1,0,1,0,0,1,0,1,0,1,0}, CQB[24] = {15,14,13,12,11,10,7,9,6,8,7,5,6,4,5,3,4,3,2,2,1,1,0,0};
    constexpr unsigned short CFIRST[25] = {0,32,64,96,128,160,192,240,272,320,352,384,432,464,512,544,592,624,656,704,736,784,816,864,896};
    const bool lpt = gridDim.x == 256;
#pragma unroll 1
    for (int i = 0; ; ++i) {
        int cls, k;
        if (lpt) { if (i >= 6) break; const unsigned e = SCHED_AC[blockIdx.x][i]; if (e == 0xFFFFu) break; cls = (int)(e >> 6); k = (int)(e & 63u); }
        else { const int j = i * (int)gridDim.x + (int)blockIdx.x; if (j >= 896) break; cls = 0; for (int q = 1; q < 24; ++q) if ((int)CFIRST[q] <= j) cls = q; k = j - (int)CFIRST[cls]; }
        cls = __builtin_amdgcn_readfirstlane(cls); k = __builtin_amdgcn_readfirstlane(k);
        if (CTYPE[cls] != 0) continue;
        const int qb = CQB[cls], b = k >> 2, h = k & 3;
        AttnArgs a; a.proj = (bf16_t*)(p.ws + WS_PROJ); a.seqM = 0; a.lse = nullptr;
        a.rowbase = b * S; a.q0 = qb * 128; a.qcol = h * 128; a.kcol = 512 + h * 128; a.vcol = 1024 + h * 128;
        a.tab = misc + MI_LUTA + 2 * h * LUTA_N; a.lam = misc[MI_LAM + L]; a.osc = 1.0f - misc[MI_LAM + 8 + L]; a.subg = p.in[12] + L * 128;
        attn_unit<0>(a, lds, tid, lane, wave);
    }
#pragma unroll 1
    for (int i = 0; ; ++i) {
        int cls, k;
        if (lpt) { if (i >= 6) break; const unsigned e = SCHED_AC[blockIdx.x][i]; if (e == 0xFFFFu) break; cls = (int)(e >> 6); k = (int)(e & 63u); }
        else { const int j = i * (int)gridDim.x + (int)blockIdx.x; if (j >= 896) break; cls = 0; for (int q = 1; q < 24; ++q) if ((int)CFIRST[q] <= j) cls = q; k = j - (int)CFIRST[cls]; }
        cls = __builtin_amdgcn_readfirstlane(cls); k = __builtin_amdgcn_readfirstlane(k);
        if (CTYPE[cls] != 1) continue;
        const int qb = CQB[cls], b = k / 6, h = k % 6;
        AttnArgs a; a.proj = (bf16_t*)(p.ws + WS_PROJ); a.seqM = 0; a.lse = nullptr;
        a.rowbase = b * S; a.q0 = qb * 256; a.qcol = 4992 + h * 64; a.kcol = 5376 + h * 64; a.vcol = 5760 + h * 64;
        a.tab = misc + MI_NEGF + (size_t)((c * CH_B + b) * 6 + h) * S; a.lam = 0.f; a.osc = 0.f; a.subg = nullptr;
        attn_unit<1>(a, lds, tid, lane, wave);
    }
    merge_b(p, lane, wave);
}

constexpr int RT_WR = 0, RT_CNT = D * NE * 4, RT_REC = RT_CNT + 64, RT_RECW = 64;
__device__ __forceinline__ void norm_route(const Params& p, const float* g, const float* sc, const float* sh, bf16_t* h, LAS unsigned char* lds, int tid, int lane, int wave) {
    LAS float* wr = (LAS float*)(lds + RT_WR); LAS unsigned* lcnt = (LAS unsigned*)(lds + RT_CNT); LAS unsigned* lbase = lcnt + 8;
    LAS int* rec = (LAS int*)(lds + RT_REC) + wave * (RT_RECW * 8);
    for (int i = tid; i < D * NE; i += NTHR) wr[i] = p.in[21][i];
    if (tid < 16) lcnt[tid] = 0u;
    __syncthreads();
    const int gw = blockIdx.x * NWAVES + wave, NGW = gridDim.x * NWAVES;
    const float* x = p.out;
    int k = 0;
    for (int t = gw; t < T && k < RT_RECW; t += NGW, ++k) {
        const int b = t >> 11;
        const GAS f32x4* xr = (const GAS f32x4*)(x + (size_t)t * D) + lane;
        f32x4 v[4]; float s = 0.f;
#pragma unroll
        for (int j = 0; j < 4; ++j) { v[j] = xr[64 * j]; s += (v[j].x * v[j].x + v[j].y * v[j].y) + (v[j].z * v[j].z + v[j].w * v[j].w); }
        const float r = 1.0f / sqrtf(wave_sum(s) * (1.0f / D) + EPS);
        GAS v2u* o8 = (GAS v2u*)(h + (size_t)t * D) + lane;
        float lg[NE];
#pragma unroll
        for (int e = 0; e < NE; ++e) lg[e] = 0.f;
#pragma unroll
        for (int j = 0; j < 4; ++j) { const int d = 4 * lane + 256 * j;
            const f32x4 g4 = *(const f32x4*)(g + d), c4 = *(const f32x4*)(sc + (size_t)b * 6 * D + d), h4 = *(const f32x4*)(sh + (size_t)b * 6 * D + d);
            const f32x4 o = v[j] * r * g4 * (c4 + 1.0f) + h4;
            v2u w; w.x = pk2(o.x, o.y); w.y = pk2(o.z, o.w); o8[64 * j] = w;
#pragma unroll
            for (int cc = 0; cc < 4; ++cc) { const f32x4 w0 = *(const LAS f32x4*)(wr + (d + cc) * NE), w1 = *(const LAS f32x4*)(wr + (d + cc) * NE + 4); const float ov = o[cc];
                lg[0] += ov * w0.x; lg[1] += ov * w0.y; lg[2] += ov * w0.z; lg[3] += ov * w0.w; lg[4] += ov * w1.x; lg[5] += ov * w1.y; lg[6] += ov * w1.z; lg[7] += ov * w1.w; } }
#pragma unroll
        for (int e = 0; e < NE; ++e) lg[e] = wave_sum(lg[e]);
        if (lane == 0) {
            int e0 = 0; float v0 = lg[0];
#pragma unroll
            for (int e = 1; e < NE; ++e) if (lg[e] > v0) { v0 = lg[e]; e0 = e; }
            int e1 = -1; float v1 = -INFINITY;
#pragma unroll
            for (int e = 0; e < NE; ++e) if (e != e0 && lg[e] > v1) { v1 = lg[e]; e1 = e; }
            const float w1 = 1.0f / (1.0f + __expf(v0 - v1)), w0 = 1.0f - w1;
            const unsigned lp0 = __hip_atomic_fetch_add(lcnt + e0, 1u, __ATOMIC_RELAXED, __HIP_MEMORY_SCOPE_WORKGROUP), lp1 = __hip_atomic_fetch_add(lcnt + e1, 1u, __ATOMIC_RELAXED, __HIP_MEMORY_SCOPE_WORKGROUP);
            LAS int* rc = rec + k * 8; rc[0] = t; rc[1] = e0; rc[2] = e1; rc[3] = (int)lp0; rc[4] = (int)lp1; rc[5] = (int)__float_as_uint(w0); rc[6] = (int)__float_as_uint(w1);
        }
    }
    __syncthreads();
    unsigned* ctl = (unsigned*)(p.ws + WS_CTL);
    if (tid < NE) lbase[tid] = __hip_atomic_fetch_add(ctl + CW_CNT + tid, lcnt[tid], __ATOMIC_RELAXED, __HIP_MEMORY_SCOPE_AGENT);
    __syncthreads();
    unsigned* misc = (unsigned*)(p.ws + WS_MISC);
    if (lane < k) { const LAS int* rc = rec + lane * 8; const int t = rc[0], e0 = rc[1], e1 = rc[2];
        misc[MI_TOK_E + 2 * t] = (unsigned)e0; misc[MI_TOK_E + 2 * t + 1] = (unsigned)e1;
        misc[MI_TOK_POS + 2 * t] = lbase[e0] + (unsigned)rc[3]; misc[MI_TOK_POS + 2 * t + 1] = lbase[e1] + (unsigned)rc[4];
        misc[MI_TOK_W + 2 * t] = (unsigned)rc[5]; misc[MI_TOK_W + 2 * t + 1] = (unsigned)rc[6]; }
}
__device__ __forceinline__ void moe_scan_gather(const Params& p, LAS unsigned char* lds, int tid, int lane, int wave) {
    LAS unsigned* sseg = (LAS unsigned*)lds;
    unsigned* ctl = (unsigned*)(p.ws + WS_CTL); unsigned* misc = (unsigned*)(p.ws + WS_MISC);
    if (tid == 0) { unsigned a = 0u;
        for (int e = 0; e < NE; ++e) { const unsigned c = __hip_atomic_load(ctl + CW_CNT + e, __ATOMIC_RELAXED, __HIP_MEMORY_SCOPE_AGENT); sseg[e] = a; sseg[16 + e] = c; a += (c + 255u) & ~255u; }
        sseg[8] = a; }
    __syncthreads();
    const unsigned ntile = sseg[8] >> 8;
    if (blockIdx.x == 0) {
        if (tid < MOE_MAXT) { unsigned e = 0u; for (int q = 1; q < NE; ++q) if (sseg[q] <= 256u * (unsigned)tid) e = (unsigned)q; misc[MI_TILE_E + tid] = e; }
        if (tid == 0) misc[MI_TILE_E + 500] = ntile;
    }
    const bf16_t* h = (const bf16_t*)(p.ws + WS_H); bf16_t* hs = (bf16_t*)(p.ws + WS_HS);
    const int gw = blockIdx.x * NWAVES + wave, NGW = gridDim.x * NWAVES;
    for (int t = gw; t < T; t += NGW) {
        const unsigned e0 = misc[MI_TOK_E + 2 * t], e1 = misc[MI_TOK_E + 2 * t + 1];
        const unsigned r0 = sseg[e0] + misc[MI_TOK_POS + 2 * t], r1 = sseg[e1] + misc[MI_TOK_POS + 2 * t + 1];
        const v4u a = *(const GAS v4u*)(h + (size_t)t * D + lane * 8), c = *(const GAS v4u*)(h + (size_t)t * D + 512 + lane * 8);
        *(GAS v4u*)(hs + (size_t)r0 * D + lane * 8) = a; *(GAS v4u*)(hs + (size_t)r0 * D + 512 + lane * 8) = c;
        *(GAS v4u*)(hs + (size_t)r1 * D + lane * 8) = a; *(GAS v4u*)(hs + (size_t)r1 * D + 512 + lane * 8) = c;
        if (lane == 0) { misc[MI_ROW_W + r0] = misc[MI_TOK_W + 2 * t]; misc[MI_ROW_W + r1] = misc[MI_TOK_W + 2 * t + 1]; }
        asm volatile("" ::: "memory");
        if (lane == 0) { misc[MI_TOK_POS + 2 * t] = r0; misc[MI_TOK_POS + 2 * t + 1] = r1; }
    }
    if (blockIdx.x < NE) {
        const unsigned e = blockIdx.x, p0 = sseg[e] + sseg[16 + e], p1 = sseg[e + 1];
        for (unsigned r = p0 + (unsigned)wave; r < p1; r += NWAVES) { const v4u z = {0u, 0u, 0u, 0u};
            *(GAS v4u*)(hs + (size_t)r * D + lane * 8) = z; *(GAS v4u*)(hs + (size_t)r * D + 512 + lane * 8) = z; if (lane == 0) misc[MI_ROW_W + r] = 0u; }
    }
}
struct GroupedOrder {
    const unsigned* tile_e; int t0, t1, nN, G, c, a_pm_off; size_t bstride;
    __device__ __forceinline__ bool next(int i, pg8::Unit& u) const {
        const long L = (long)i * G + c; if (L >= (long)(t1 - t0) * nN) return false;
        u.pm = t0 + (int)(L / nN); u.pn = (int)(L % nN); u.e = __builtin_amdgcn_readfirstlane((int)tile_e[u.pm]); u.aux = 0; return true;
    }
    __device__ __forceinline__ const char* a_ptr(const pg8::Gemm& g, const pg8::Unit& u) const { return (const char*)g.A + (size_t)(u.pm - a_pm_off) * (size_t)(pg8::BM * 2) * g.lda; }
    __device__ __forceinline__ const char* b_ptr(const pg8::Gemm& g, const pg8::Unit& u) const { return (const char*)g.Bt + ((size_t)u.e * bstride + (size_t)u.pn * pg8::BM * g.K) * 2; }
    __device__ __forceinline__ void a_ready(const pg8::Unit&) const {}
    __device__ __forceinline__ void done(const pg8::Unit&) const {}
};
__device__ __forceinline__ void moe_combine_final(const Params& p, const float* g2, int lane, int wave) {
    const unsigned* misc = (const unsigned*)(p.ws + WS_MISC); const bf16_t* y = (const bf16_t*)(p.ws + WS_HS);
    const int gw = blockIdx.x * NWAVES + wave, NGW = gridDim.x * NWAVES;
    for (int t = gw; t < T; t += NGW) {
        const int b = t >> 11; const unsigned r0 = misc[MI_TOK_POS + 2 * t], r1 = misc[MI_TOK_POS + 2 * t + 1];
        GAS f32x4* xr = (GAS f32x4*)(p.out + (size_t)t * D) + lane;
        f32x4 v[4]; float s = 0.f;
#pragma unroll
        for (int j = 0; j < 4; ++j) { const int d = 4 * lane + 256 * j;
            const v2u a = *(const GAS v2u*)(y + (size_t)r0 * D + d), c = *(const GAS v2u*)(y + (size_t)r1 * D + d);
            f32x4 ya, yc; ya.x = __uint_as_float(a.x << 16); ya.y = __uint_as_float(a.x & 0xffff0000u); ya.z = __uint_as_float(a.y << 16); ya.w = __uint_as_float(a.y & 0xffff0000u);
            yc.x = __uint_as_float(c.x << 16); yc.y = __uint_as_float(c.x & 0xffff0000u); yc.z = __uint_as_float(c.y << 16); yc.w = __uint_as_float(c.y & 0xffff0000u);
            const f32x4 g4 = *(const f32x4*)(g2 + (size_t)b * 6 * D + d);
            v[j] = xr[64 * j] + g4 * (ya + yc); s += (v[j].x * v[j].x + v[j].y * v[j].y) + (v[j].z * v[j].z + v[j].w * v[j].w); }
        const float r = 1.0f / sqrtf(wave_sum(s) * (1.0f / D) + EPS);
#pragma unroll
        for (int j = 0; j < 4; ++j) { const f32x4 f4 = *(const f32x4*)(p.in[25] + 4 * lane + 256 * j); xr[64 * j] = v[j] * r * f4; }
    }
}

#define STEP(id) if (p0.lo <= (id) && (id) < p0.hi && (first ? (first = false, true) : (xcd_barrier(bar), true)))
#define IDS const Params p = load_params(); int tid = threadIdx.x; asm volatile("" : "+v"(tid)); const int lane = tid & 63, wave = __builtin_amdgcn_readfirstlane(tid >> 6); (void)lane; (void)wave; const int G = gridDim.x, NGW = G * NWAVES; (void)NGW; unsigned char* ws = p.ws; const float* mod_ = (const float*)(ws + WS_MOD); (void)mod_;
template <int L, int c> __device__ __forceinline__ void chunk_steps(const Params& p0, LAS unsigned char* lds, const XcdBarrier& bar, bool& first) {
    constexpr int sb = ST_L0 + L * LSTEPS;
        constexpr int cs = sb + SO_CHUNK + CSTEPS * c;
#define CHP bf16_t* hc = (bf16_t*)(ws + WS_H) + (size_t)c * CH_T * D; bf16_t* proj = (bf16_t*)(ws + WS_PROJ); (void)hc; (void)proj;
        STEP(cs + 0) { IDS CHP
            if (blockIdx.x < CH_B * 6 && wave == 0) negf_cumsum(p, c * CH_B + (int)blockIdx.x / 6, (int)blockIdx.x % 6, lane);
            pg8::Gemm g{hc, (const bf16_t*)(ws + WS_WIN) + (size_t)L * NP * D, CH_T, NP, D, D}; pg8::StaticOrder S; S.init(CH_T, NP, G, (int)blockIdx.x);
            pg8::EpiInProj E{proj, NP};
            pg8::gemm_phase<pg8::EpiInProj, pg8::StaticOrder, true, true>(lds, g, S, E);
        }
        STEP(cs + 1) { IDS attn_b_phase(p, lds, tid, lane, wave); }
        STEP(cs + 2) { IDS attn_ac_phase(p, L, c, lds, tid, lane, wave); }
        STEP(cs + 3) { IDS CHP
            const bf16_t* wbr = (const bf16_t*)(ws + WS_WBR) + (size_t)L * 1280 * D;
            pg8::StaticOrder S; S.init(CH_T, D, G, (int)blockIdx.x);
            { pg8::Gemm g{proj, wbr, CH_T, D, 512, NP}; pg8::EpiMerge<0> E{proj, hc, NP}; pg8::gemm_phase<pg8::EpiMerge<0>, pg8::StaticOrder, true, true>(lds, g, S, E); }
            { pg8::Gemm g{proj + 1536, wbr + (size_t)512 * D, CH_T, D, 384, NP}; pg8::EpiMerge<1> E{proj, hc, NP}; pg8::gemm_phase<pg8::EpiMerge<1>, pg8::StaticOrder, true, true>(lds, g, S, E); }
            { pg8::Gemm g{proj + 4992, wbr + (size_t)896 * D, CH_T, D, 384, NP}; pg8::EpiMerge<2> E{proj, hc, NP}; pg8::gemm_phase<pg8::EpiMerge<2>, pg8::StaticOrder, true, true>(lds, g, S, E); }
        }
        STEP(cs + 4) { IDS CHP
            pg8::Gemm g{hc, (const bf16_t*)(ws + WS_WOUT) + (size_t)L * D * D, CH_T, D, D, D}; pg8::StaticOrder S; S.init(CH_T, D, G, (int)blockIdx.x);
            pg8::EpiResid E{L == 0 ? p.in[0] : p.out, p.out, (mod_ + (size_t)L * NB * 6 * D) + 2 * D, c * CH_T};
            pg8::gemm_phase<pg8::EpiResid, pg8::StaticOrder, true, true>(lds, g, S, E);
        }
    }
template <int L> __device__ __forceinline__ void layer_steps(const Params& p0, LAS unsigned char* lds, const XcdBarrier& bar, bool& first) {
    constexpr int sb = ST_L0 + L * LSTEPS;
    STEP(sb + SO_NORM1) { IDS norm_logf(p, L, L == 0 ? p.in[0] : p.out, p.in[2] + L * D, (mod_ + (size_t)L * NB * 6 * D) + D, (mod_ + (size_t)L * NB * 6 * D), (bf16_t*)(ws + WS_H), lds, tid, lane, wave); }
    chunk_steps<L, 0>(p0, lds, bar, first);
    chunk_steps<L, 1>(p0, lds, bar, first);
    STEP(sb + SO_NORM2) { IDS
        if constexpr (L == 0) norm_rows(p.out, p.in[3] + L * D, (mod_ + (size_t)L * NB * 6 * D) + 4 * D, (mod_ + (size_t)L * NB * 6 * D) + 3 * D, (bf16_t*)(ws + WS_H), 0, T, (int)blockIdx.x * NWAVES + wave, NGW, lane);
        else norm_route(p, p.in[3] + L * D, (mod_ + (size_t)L * NB * 6 * D) + 4 * D, (mod_ + (size_t)L * NB * 6 * D) + 3 * D, (bf16_t*)(ws + WS_H), lds, tid, lane, wave);
    }
    if constexpr (L == 0) {
        STEP(sb + SO_FFN) { IDS
            pg8::Gemm g{(const bf16_t*)(ws + WS_H), (const bf16_t*)(ws + WS_WGU0), T, 2 * DFF, D, D}; pg8::StaticOrder S; S.init(T, 2 * DFF, G, (int)blockIdx.x);
            pg8::EpiSwiglu E{(bf16_t*)(ws + WS_PROJ), DFF, 0};
            pg8::gemm_phase<pg8::EpiSwiglu, pg8::StaticOrder, true, true>(lds, g, S, E);
        }
        STEP(sb + SO_FFN + 1) { IDS
            pg8::Gemm g{(const bf16_t*)(ws + WS_PROJ), (const bf16_t*)(ws + WS_WD0), T, D, DFF, DFF}; pg8::StaticOrder S; S.init(T, D, G, (int)blockIdx.x);
            pg8::EpiResid E{p.out, p.out, (mod_ + (size_t)L * NB * 6 * D) + 5 * D, 0};
            pg8::gemm_phase<pg8::EpiResid, pg8::StaticOrder, true, true>(lds, g, S, E);
        }
    } else {
        STEP(sb + SO_FFN) { IDS moe_scan_gather(p, lds, tid, lane, wave); }
#pragma unroll 1
        for (int ch = 0; ch < 4; ++ch) {
            STEP(sb + SO_FFN + 1 + 2 * ch) { IDS const unsigned* misc = (const unsigned*)(ws + WS_MISC);
                const int ntile = (int)misc[MI_TILE_E + 500], t0 = ch * MOE_CH, t1 = ch == 3 ? ntile : (ch + 1) * MOE_CH;
                pg8::Gemm g{(const bf16_t*)(ws + WS_HS), (const bf16_t*)(ws + WS_WGU1), MOE_ROWS, 2 * DFE, D, D};
                GroupedOrder S{misc + MI_TILE_E, t0, t1, 2 * DFE / 256, G, (int)blockIdx.x, 0, (size_t)2 * DFE * D};
                pg8::EpiSwiglu E{(bf16_t*)(ws + WS_ACT1), DFE, t0};
                pg8::gemm_phase<pg8::EpiSwiglu, GroupedOrder, true, true>(lds, g, S, E);
            }
            STEP(sb + SO_FFN + 2 + 2 * ch) { IDS const unsigned* misc = (const unsigned*)(ws + WS_MISC);
                const int ntile = (int)misc[MI_TILE_E + 500], t0 = ch * MOE_CH, t1 = ch == 3 ? ntile : (ch + 1) * MOE_CH;
                pg8::Gemm g{(const bf16_t*)(ws + WS_ACT1), (const bf16_t*)(ws + WS_WD1), MOE_ROWS, D, DFE, DFE};
                GroupedOrder S{misc + MI_TILE_E, t0, t1, D / 256, G, (int)blockIdx.x, t0, (size_t)D * DFE};
                pg8::EpiMoeDown E{(bf16_t*)(ws + WS_HS), (const float*)(misc + MI_ROW_W)};
                pg8::gemm_phase<pg8::EpiMoeDown, GroupedOrder, true, true>(lds, g, S, E);
            }
        }
        STEP(sb + SO_FFN + 9) { IDS moe_combine_final(p, (mod_ + (size_t)L * NB * 6 * D) + 5 * D, lane, wave); }
    }
}

__global__ void __launch_bounds__(NTHR, 2) mk_fwd(Params p0) {
    extern __shared__ __attribute__((aligned(16))) unsigned char lds_raw[];
    LAS unsigned char* lds = (LAS unsigned char*)lds_raw;
    for (int u = threadIdx.x; u < (LDS_BYTES - LDSCTL_OFF) / 4; u += NTHR) ((LAS unsigned*)(lds + LDSCTL_OFF))[u] = 0u;
    __syncthreads();
    const XcdBarrier bar = xcd_barrier_post((unsigned*)(p0.ws + WS_CTL) + CW_BAR + p0.li * XCD_BAR_WORDS, (volatile LAS unsigned*)(lds + MISC_OFF) + 8);
    bool first = true;
    STEP(ST_PRO) { IDS prologue(p, lds, tid, lane, wave); }
    layer_steps<0>(p0, lds, bar, first);
    layer_steps<1>(p0, lds, bar, first);
}
#undef STEP
}

extern "C" void kernel_launch(void* const* d_in, const int* in_sizes, int n_in, void* d_out, int out_size, void* d_ws, size_t ws_size, hipStream_t stream) {
    static int grid = 0;
    if (grid == 0) {
        int dev = 0, cus = 0;
        (void)hipGetDevice(&dev); (void)hipDeviceGetAttribute(&cus, hipDeviceAttributeMultiprocessorCount, dev);
        if (hipFuncSetAttribute((const void*)mk::mk_fwd, hipFuncAttributeMaxDynamicSharedMemorySize, mk::LDS_BYTES) != hipSuccess) fprintf(stderr, "kernel_launch: hipFuncSetAttribute failed\n");
        (void)hipGetLastError();
        grid = cus > 0 ? cus : 256;
        if (ws_size < mk::WS_END) fprintf(stderr, "kernel_launch: workspace too small: %zu < %zu\n", ws_size, (size_t)mk::WS_END);
    }
    (void)in_sizes; (void)n_in; (void)out_size;
    (void)hipMemsetAsync((char*)d_ws + mk::WS_CTL, 0, mk::CTL_BYTES, stream);
    mk::Params p{};
    for (int i = 0; i < 26; ++i) p.in[i] = (const float*)d_in[i];
    p.out = (float*)d_out; p.ws = (unsigned char*)d_ws; p.lo = 0; p.hi = mk::ST_END; p.li = 0; p.pad = 0;
    hipLaunchKernelGGL(mk::mk_fwd, dim3(grid), dim3(mk::NTHR), mk::LDS_BYTES, stream, p);
}
```

```cpp
#include <hip/hip_runtime.h>
#include <cstdint>
#include <cstdio>

namespace pg8 {
#define PG8_LAS __attribute__((address_space(3)))
typedef unsigned short bf16_t;
typedef short bf16x8 __attribute__((ext_vector_type(8)));
typedef float f32x4 __attribute__((ext_vector_type(4)));
typedef unsigned u32x4 __attribute__((ext_vector_type(4)));
constexpr int BM = 256, BK = 64, HALF = 128, HTB = HALF * BK * 2  , STAGE_BYTES = 8 * HTB, NXCD = 8, WGM = 8;

__host__ __device__ __forceinline__ int lds_byte(int r, int c) { const int st = (r >> 4) * 2 + (c >> 5), rr = r & 15, cc = c & 31, ob = rr * 64 + cc * 2; return st * 1024 + (ob ^ (((ob >> 9) & 1) << 5)); }
__host__ __device__ __forceinline__ void stage_rc(int b, int& R, int& C) { const int st = b / 1024, sb = b % 1024, swz = sb ^ (((sb >> 9) & 1) << 5); R = (st >> 1) * 16 + swz / 64; C = (st & 1) * 32 + (swz % 64) / 2; }
__host__ __device__ __forceinline__ int perm32(int rho) { const int n = rho >> 4, i = rho & 15; return 8 * (i >> 2) + 4 * n + (i & 3); }

struct Unit { int pm, pn, e, aux; };
struct Gemm { const bf16_t* A; const bf16_t* Bt; int M, N, K, lda, ldb; };

struct StaticOrder {
    int nM, nN, nwg, G, c;
    __host__ __device__ void init(int M, int N, int G_, int c_) { nM = M / BM; nN = N / BM; nwg = nM * nN; G = G_; c = c_; }
    __host__ __device__ bool next(int i, Unit& u) const {
        const long L = (long)i * G + c; if (L >= nwg) return false;
        int wgid = (int)L; { const int q = nwg / NXCD, r = nwg % NXCD, xcd = wgid % NXCD, off = wgid / NXCD; wgid = (xcd < r ? xcd * (q + 1) : r * (q + 1) + (xcd - r) * q) + off; }
        const int nig = WGM * nN, gid = wgid / nig, fm = gid * WGM, gsz = (nM - fm) < WGM ? (nM - fm) : WGM;
        u.pm = fm + ((wgid % nig) % gsz); u.pn = (wgid % nig) / gsz; u.e = 0; u.aux = 0; return true;
    }
    __device__ __forceinline__ const char* a_ptr(const Gemm& g, const Unit& u) const { return (const char*)g.A + (size_t)u.pm * (size_t)(BM * 2) * g.lda; }
    __device__ __forceinline__ const char* b_ptr(const Gemm& g, const Unit& u) const { return (const char*)g.Bt + (size_t)u.pn * (size_t)(BM * 2) * g.ldb; }
    __device__ __forceinline__ int kt(const Gemm& g, const Unit&) const { return g.K / BK; }
    __device__ __forceinline__ bool last_seg(const Unit&) const { return true; }
    __device__ __forceinline__ void a_ready(const Unit&) const {}
    __device__ __forceinline__ void done(const Unit&) const {}
};

__device__ __forceinline__ unsigned cvt_pk_bf16(float lo, float hi) { unsigned r; asm volatile("v_cvt_pk_bf16_f32 %0, %1, %2" : "=v"(r) : "v"(lo), "v"(hi)); return r; }
typedef float f32x2 __attribute__((ext_vector_type(2)));
__device__ __forceinline__ float silu_f(float z) { return z * __builtin_amdgcn_rcpf(1.0f + __builtin_amdgcn_exp2f(-1.4426950408889634f * z)); }
__device__ __forceinline__ float sigm_f(float z) { return __builtin_amdgcn_rcpf(1.0f + __builtin_amdgcn_exp2f(-1.4426950408889634f * z)); }
struct EpiSwiglu {
    static constexpr bool PERM = true, AFTER_DRAIN = false, SEGMENTED = false;
    bf16_t* O; int ldc; int pm_off;
    __device__ __forceinline__ void operator()(const f32x4 (&acc)[2][2][4][2], const Unit& u, int wr, int wc, int fr, int fq) const {
        const int row0 = (u.pm - pm_off) * BM + wr * 64 + fr, col0 = u.pn * HALF + wc * 32 + 8 * fq;
#pragma unroll
        for (int ai = 0; ai < 2; ++ai)
#pragma unroll
            for (int m = 0; m < 4; ++m) { bf16_t* rowp = O + (size_t)(row0 + ai * HALF + m * 16) * ldc + col0;
                const f32x4 g0 = acc[ai][0][m][0], g1 = acc[ai][0][m][1], u0 = acc[ai][1][m][0], u1 = acc[ai][1][m][1];
                u32x4 w; w.x = cvt_pk_bf16(silu_f(g0[0]) * u0[0], silu_f(g0[1]) * u0[1]); w.y = cvt_pk_bf16(silu_f(g0[2]) * u0[2], silu_f(g0[3]) * u0[3]);
                w.z = cvt_pk_bf16(silu_f(g1[0]) * u1[0], silu_f(g1[1]) * u1[1]); w.w = cvt_pk_bf16(silu_f(g1[2]) * u1[2], silu_f(g1[3]) * u1[3]);
                *(u32x4*)rowp = w; }
    }
};
struct EpiResid {
    static constexpr bool PERM = false, AFTER_DRAIN = false, SEGMENTED = false;
    const float* src; float* dst; const float* gv; int row_off;
    __device__ __forceinline__ void operator()(const f32x4 (&acc)[2][2][4][2], const Unit& u, int wr, int wc, int fr, int fq) const {
        const int rowt = row_off + u.pm * BM, row0 = rowt + wr * 64 + fr, col0 = u.pn * BM + wc * 32 + 4 * fq;
        const float* gp = gv + (size_t)(rowt >> 11) * 6144 + col0;
        f32x4 gg[2][2];
#pragma unroll
        for (int bj = 0; bj < 2; ++bj)
#pragma unroll
            for (int n = 0; n < 2; ++n) gg[bj][n] = *(const f32x4*)(gp + bj * HALF + n * 16);
#pragma unroll
        for (int ai = 0; ai < 2; ++ai) {
            f32x4 sv[4][2][2];
#pragma unroll
            for (int m = 0; m < 4; ++m) { const size_t off = (size_t)(row0 + ai * HALF + m * 16) * 1024 + col0;
#pragma unroll
                for (int bj = 0; bj < 2; ++bj)
#pragma unroll
                    for (int n = 0; n < 2; ++n) sv[m][bj][n] = *(const f32x4*)(src + off + bj * HALF + n * 16); }
            asm volatile("" ::: "memory");
#pragma unroll
            for (int m = 0; m < 4; ++m) { const size_t off = (size_t)(row0 + ai * HALF + m * 16) * 1024 + col0;
#pragma unroll
                for (int bj = 0; bj < 2; ++bj)
#pragma unroll
                    for (int n = 0; n < 2; ++n) *(f32x4*)(dst + off + bj * HALF + n * 16) = sv[m][bj][n] + gg[bj][n] * acc[ai][bj][m][n]; }
            asm volatile("" ::: "memory");
        }
    }
};
struct EpiMoeDown {
    static constexpr bool PERM = true, AFTER_DRAIN = false, SEGMENTED = false;
    bf16_t* O; const float* row_w;
    __device__ __forceinline__ void operator()(const f32x4 (&acc)[2][2][4][2], const Unit& u, int wr, int wc, int fr, int fq) const {
        const int row0 = u.pm * BM + wr * 64 + fr, col0 = u.pn * BM + wc * 32 + 8 * fq;
        float w[2][4];
#pragma unroll
        for (int ai = 0; ai < 2; ++ai)
#pragma unroll
            for (int m = 0; m < 4; ++m) w[ai][m] = row_w[row0 + ai * HALF + m * 16];
#pragma unroll
        for (int ai = 0; ai < 2; ++ai)
#pragma unroll
            for (int m = 0; m < 4; ++m) { bf16_t* rowp = O + (size_t)(row0 + ai * HALF + m * 16) * 1024 + col0; const float ww = w[ai][m];
#pragma unroll
                for (int bj = 0; bj < 2; ++bj) { const f32x4 v0 = acc[ai][bj][m][0] * ww, v1 = acc[ai][bj][m][1] * ww;
                    u32x4 o; o.x = cvt_pk_bf16(v0[0], v0[1]); o.y = cvt_pk_bf16(v0[2], v0[3]); o.z = cvt_pk_bf16(v1[0], v1[1]); o.w = cvt_pk_bf16(v1[2], v1[3]);
                    *(u32x4*)(rowp + bj * HALF) = o; } }
    }
};
struct EpiInProj {
    static constexpr bool PERM = true, AFTER_DRAIN = false, SEGMENTED = false;
    bf16_t* QO; bf16_t* KV; bf16_t* GT;
    __device__ __forceinline__ void operator()(const f32x4 (&acc)[2][2][4][2], const Unit& u, int wr, int wc, int fr, int fq) const {
        const int rowl0 = u.pm * BM + wr * 64 + fr, b = (u.pm * BM) >> 11;
        constexpr float C2 = 0.125f * 1.4426950408889634f;
        constexpr size_t KVB0 = (size_t)8 * 4 * 2 * 2048 * 128, KVC0 = KVB0 + (size_t)8 * 18 * 2 * 2048 * 64;
#pragma unroll
        for (int bj = 0; bj < 2; ++bj) {
            const int hh = 2 * u.pn + bj, c = 32 * wc + 8 * fq; float sc = 1.0f; int s = 0, pitch = 2048; bool sig = false, tokmajor = true; bf16_t* dst;
            if (hh < 4) { dst = QO + 128 * hh + c; sc = C2; }
            else if (hh < 12) { const int kv = hh >= 8, h = hh - (kv ? 8 : 4); dst = KV + (size_t)((b * 4 + h) * 2 + kv) * (2048 * 128) + c; pitch = 128; tokmajor = false; }
            else if (hh < 21) { const int g = (hh - 12) / 3, j = (hh - 12) % 3; dst = QO + 512 + g * 384 + j * 128 + c; s = 2 * g; sc = C2; }
            else if (hh < 39) { const int kv = hh >= 30, x = hh - (kv ? 30 : 21), g = x / 3, j = x % 3, hd = 2 * j + (c >> 6);
                dst = KV + KVB0 + (size_t)(((b * 3 + g) * 6 + hd) * 2 + kv) * (2048 * 64) + (c & 63); pitch = 64; s = 2 * g; tokmajor = false; }
            else if (hh < 42) { dst = QO + 1664 + (hh - 39) * 128 + c; sc = C2; }
            else if (hh < 48) { const int kv = hh >= 45, j = hh - (kv ? 45 : 42), hd = 2 * j + (c >> 6); dst = KV + KVC0 + (size_t)((b * 6 + hd) * 2 + kv) * (2048 * 64) + (c & 63); pitch = 64; tokmajor = false; }
            else { dst = GT + (hh - 48) * 128 + c; pitch = 3072; sig = true; }
#pragma unroll
            for (int ai = 0; ai < 2; ++ai)
#pragma unroll
                for (int m = 0; m < 4; ++m) { const int r = rowl0 + ai * HALF + m * 16, t = r & 2047, tp = ((t & ((1 << s) - 1)) << (11 - s)) | (t >> s), ro = (tokmajor ? (r & ~2047) : 0) | tp;
                    f32x4 v0 = acc[ai][bj][m][0], v1 = acc[ai][bj][m][1];
                    if (sig) { v0[0] = sigm_f(v0[0]); v0[1] = sigm_f(v0[1]); v0[2] = sigm_f(v0[2]); v0[3] = sigm_f(v0[3]); v1[0] = sigm_f(v1[0]); v1[1] = sigm_f(v1[1]); v1[2] = sigm_f(v1[2]); v1[3] = sigm_f(v1[3]); }
                    else { v0 = v0 * sc; v1 = v1 * sc; }
                    u32x4 w; w.x = cvt_pk_bf16(v0[0], v0[1]); w.y = cvt_pk_bf16(v0[2], v0[3]); w.z = cvt_pk_bf16(v1[0], v1[1]); w.w = cvt_pk_bf16(v1[2], v1[3]);
                    *(u32x4*)(dst + (size_t)ro * pitch) = w; }
        }
    }
};
__device__ __forceinline__ float bf_lo(unsigned u) { return __builtin_bit_cast(float, u << 16); }
__device__ __forceinline__ float bf_hi(unsigned u) { return __builtin_bit_cast(float, u & 0xffff0000u); }
template <int BR> struct EpiMerge {
    static constexpr bool PERM = true, AFTER_DRAIN = false, SEGMENTED = false;
    const bf16_t* proj; bf16_t* mg; int ldp;
    __device__ __forceinline__ void operator()(const f32x4 (&acc)[2][2][4][2], const Unit& u, int wr, int wc, int fr, int fq) const {
        const int row0 = u.pm * BM + wr * 64 + fr, col0 = u.pn * BM + wc * 32 + 8 * fq;
#pragma unroll
        for (int ai = 0; ai < 2; ++ai)
#pragma unroll
        for (int mp = 0; mp < 4; ++mp) {
            u32x4 gt[1][2], od[1][2];
#pragma unroll
            for (int mm = 0; mm < 1; ++mm)
#pragma unroll
                for (int bj = 0; bj < 2; ++bj) { const size_t r = (size_t)(row0 + ai * HALF + (mp + mm) * 16);
                    gt[mm][bj] = *(const u32x4*)(proj + r * ldp + 6144 + 1024 * BR + col0 + bj * HALF);
                    if (BR) od[mm][bj] = *(const u32x4*)(mg + r * 1024 + col0 + bj * HALF); else od[mm][bj] = (u32x4){0u, 0u, 0u, 0u}; }
            asm volatile("" ::: "memory");
#pragma unroll
            for (int mm = 0; mm < 1; ++mm)
#pragma unroll
                for (int bj = 0; bj < 2; ++bj) { const int m = mp + mm; const size_t r = (size_t)(row0 + ai * HALF + m * 16); const u32x4 g = gt[mm][bj], o = od[mm][bj]; const f32x4 v0 = acc[ai][bj][m][0], v1 = acc[ai][bj][m][1];
                    u32x4 w; w.x = cvt_pk_bf16(bf_lo(o.x) + bf_lo(g.x) * v0[0], bf_hi(o.x) + bf_hi(g.x) * v0[1]); w.y = cvt_pk_bf16(bf_lo(o.y) + bf_lo(g.y) * v0[2], bf_hi(o.y) + bf_hi(g.y) * v0[3]);
                    w.z = cvt_pk_bf16(bf_lo(o.z) + bf_lo(g.z) * v1[0], bf_hi(o.z) + bf_hi(g.z) * v1[1]); w.w = cvt_pk_bf16(bf_lo(o.w) + bf_lo(g.w) * v1[2], bf_hi(o.w) + bf_hi(g.w) * v1[3]);
                    *(u32x4*)(mg + r * 1024 + col0 + bj * HALF) = w; }
            asm volatile("" ::: "memory");
        }
    }
};
struct EpiMergeS {
    static constexpr bool PERM = true, AFTER_DRAIN = false, SEGMENTED = false;
    const bf16_t* proj; bf16_t* mg; int ldp;
    __device__ __forceinline__ void operator()(const f32x4 (&acc)[2][2][4][2], const Unit& u, int wr, int wc, int fr, int fq) const {
        const int row0 = u.pm * BM + wr * 64 + fr, col0 = u.pn * BM + wc * 32 + 8 * fq; const int s = u.e;
#pragma unroll
        for (int ai = 0; ai < 2; ++ai) {
            u32x4 gt[4][2], od[4][2];
#pragma unroll
            for (int m = 0; m < 4; ++m)
#pragma unroll
                for (int bj = 0; bj < 2; ++bj) { const size_t r = (size_t)(row0 + ai * HALF + m * 16);
                    gt[m][bj] = *(const u32x4*)(proj + r * ldp + 1024 * s + col0 + bj * HALF);     od[m][bj] = *(const u32x4*)(mg + r * 1024 + col0 + bj * HALF); }
            asm volatile("" ::: "memory");
#pragma unroll
            for (int m = 0; m < 4; ++m)
#pragma unroll
                for (int bj = 0; bj < 2; ++bj) { const size_t r = (size_t)(row0 + ai * HALF + m * 16); const u32x4 g = gt[m][bj]; u32x4 o = od[m][bj]; if (s == 0) o = (u32x4){0u, 0u, 0u, 0u};
                    const f32x4 v0 = acc[ai][bj][m][0], v1 = acc[ai][bj][m][1];
                    u32x4 w; w.x = cvt_pk_bf16(bf_lo(o.x) + bf_lo(g.x) * v0[0], bf_hi(o.x) + bf_hi(g.x) * v0[1]); w.y = cvt_pk_bf16(bf_lo(o.y) + bf_lo(g.y) * v0[2], bf_hi(o.y) + bf_hi(g.y) * v0[3]);
                    w.z = cvt_pk_bf16(bf_lo(o.z) + bf_lo(g.z) * v1[0], bf_hi(o.z) + bf_hi(g.z) * v1[1]); w.w = cvt_pk_bf16(bf_lo(o.w) + bf_lo(g.w) * v1[2], bf_hi(o.w) + bf_hi(g.w) * v1[3]);
                    *(u32x4*)(mg + r * 1024 + col0 + bj * HALF) = w; }
            asm volatile("" ::: "memory");
        }
    }
};
struct SegOrder : StaticOrder {
    __device__ __forceinline__ bool next(int i, Unit& u) const { const int ti = i / 3, sg = i - 3 * ti; if (!StaticOrder::next(ti, u)) return false; u.e = sg; return true; }
    __device__ __forceinline__ const char* a_ptr(const Gemm& g, const Unit& u) const { return (const char*)g.A + (size_t)u.pm * (size_t)(BM * 2) * g.lda + (u.e == 0 ? 0 : (u.e == 1 ? 512 * 2 : 1664 * 2)); }
    __device__ __forceinline__ const char* b_ptr(const Gemm& g, const Unit& u) const { return (const char*)g.Bt + (size_t)u.pn * (size_t)(BM * 2) * g.ldb + (u.e == 0 ? 0 : (u.e == 1 ? 512 * 2 : 896 * 2)); }
    __device__ __forceinline__ int kt(const Gemm&, const Unit& u) const { return u.e == 0 ? 8 : 6; }
    __device__ __forceinline__ bool last_seg(const Unit& u) const { return u.e == 2; }
};
template <class Epi, class Sched, bool ALIGN_EPI = false, bool SP2 = false>
__device__ __forceinline__ void gemm_phase(PG8_LAS unsigned char* lds, const Gemm g, const Sched& S, const Epi& E) {
    int tid = threadIdx.x; asm volatile("" : "+v"(tid));
    const int wid = __builtin_amdgcn_readfirstlane(tid >> 6), lane = tid & 63, wr = wid >> 2, wc = wid & 3, fr = lane & 15, fq = lane >> 4;
    const int K = g.K;
    unsigned voffA[2], voffB[2];
#pragma unroll
    for (int i = 0; i < 2; ++i) { int R, C; stage_rc(tid * 16 + i * 8192, R, C); const int Rb = Epi::PERM ? ((R & ~31) + perm32(R & 31)) : R;
        voffA[i] = (unsigned)(R * g.lda + C) * 2u; voffB[i] = (unsigned)(Rb * g.ldb + C) * 2u; }
    const size_t kstep = (size_t)(BK * 2);
    const size_t hstepA = (size_t)HALF * g.lda * 2, hstepB = (size_t)HALF * g.ldb * 2;
    const unsigned ldsw = (unsigned)wid * 1024u;
    const int aoff = lds_byte(wr * 64 + fr, fq * 8), boff = lds_byte(wc * 32 + fr, fq * 8);
#define PG8_SA(b, h) (((b) * 2 + (h)) * HTB)
#define PG8_SB(b, h) ((4 + (b) * 2 + (h)) * HTB)
#define PG8_STAGE(bufoff, gbase, voff) do { _Pragma("unroll") for (int _i = 0; _i < 2; ++_i) \
        __builtin_amdgcn_global_load_lds((const unsigned*)((const char*)(gbase) + (voff)[_i]), (PG8_LAS unsigned*)(lds + (bufoff) + ldsw + _i * 8192), 16, 0, 0); } while (0)
#define PG8_LDA(dst, b, h) do { _Pragma("unroll") for (int m = 0; m < 4; ++m) _Pragma("unroll") for (int k = 0; k < 2; ++k) dst[m][k] = *(const PG8_LAS bf16x8*)(lds + PG8_SA(b, h) + aoff + m * 2048 + k * 1024); } while (0)
#define PG8_LDB(dst, b, h) do { _Pragma("unroll") for (int n = 0; n < 2; ++n) _Pragma("unroll") for (int k = 0; k < 2; ++k) dst[n][k] = *(const PG8_LAS bf16x8*)(lds + PG8_SB(b, h) + boff + n * 2048 + k * 1024); } while (0)
#define PG8_MMA(ai, bj, At, Bt) do { __builtin_amdgcn_s_setprio(1); _Pragma("unroll") for (int m = 0; m < 4; ++m) _Pragma("unroll") for (int n = 0; n < 2; ++n) _Pragma("unroll") for (int k = 0; k < 2; ++k) \
        acc[ai][bj][m][n] = __builtin_amdgcn_mfma_f32_16x16x32_bf16(Bt[n][k], At[m][k], acc[ai][bj][m][n], 0, 0, 0); __builtin_amdgcn_s_setprio(0); } while (0)
#define PG8_WAIT_V(n) asm volatile("s_waitcnt vmcnt(" #n ")" ::: "memory")
#define PG8_WAIT_L(n) asm volatile("s_waitcnt lgkmcnt(" #n ")" ::: "memory")
#define PG8_BAR __builtin_amdgcn_s_barrier()
#define PG8_SCHED __builtin_amdgcn_sched_barrier(0)
    Unit cur, nxt; int ui = 0;
    if (!S.next(0, cur)) return;
    int nt = S.kt(g, cur);
    f32x4 acc[2][2][4][2];
#pragma unroll
    for (int a = 0; a < 2; ++a)
#pragma unroll
        for (int b = 0; b < 2; ++b)
#pragma unroll
            for (int m = 0; m < 4; ++m)
#pragma unroll
                for (int n = 0; n < 2; ++n) acc[a][b][m][n] = (f32x4){0.f, 0.f, 0.f, 0.f};
    bf16x8 At[4][2], B0[2][2], B1[2][2];
    const char* cA = S.a_ptr(g, cur); const char* cB = S.b_ptr(g, cur);
    S.a_ready(cur);
    if constexpr (SP2) {
        PG8_STAGE(PG8_SB(0, 0), cB, voffB); PG8_STAGE(PG8_SB(0, 1), cB + hstepB, voffB); PG8_STAGE(PG8_SA(0, 0), cA, voffA); PG8_STAGE(PG8_SA(0, 1), cA + hstepA, voffA);
        if (wr == 1) PG8_BAR;
        PG8_WAIT_V(2); PG8_BAR;
        PG8_STAGE(PG8_SB(1, 0), cB + kstep, voffB); PG8_STAGE(PG8_SA(1, 0), cA + kstep, voffA); PG8_STAGE(PG8_SB(1, 1), cB + hstepB + kstep, voffB);
        PG8_WAIT_V(6); PG8_BAR;
    } else {
        PG8_STAGE(PG8_SB(0, 0), cB, voffB); PG8_STAGE(PG8_SA(0, 0), cA, voffA); PG8_STAGE(PG8_SB(0, 1), cB + hstepB, voffB); PG8_STAGE(PG8_SA(0, 1), cA + hstepA, voffA);
        if (wr == 1) PG8_BAR;
        PG8_WAIT_V(4); PG8_BAR;
        PG8_STAGE(PG8_SB(1, 0), cB + kstep, voffB); PG8_STAGE(PG8_SA(1, 0), cA + kstep, voffA); PG8_STAGE(PG8_SB(1, 1), cB + hstepB + kstep, voffB);
        PG8_WAIT_V(6); PG8_BAR;
    }
    for (;;) {
        const bool has_next = S.next(ui + 1, nxt);
        const char* nA = has_next ? S.a_ptr(g, nxt) : cA; const char* nB = has_next ? S.b_ptr(g, nxt) : cB;
        for (int t = 0; t < nt; t += 2) {
            const bool last = (t == nt - 2);
            const char* a1 = cA + (size_t)(t + 1) * kstep;
            const char* a2 = last ? nA : cA + (size_t)(t + 2) * kstep; const char* b2 = last ? nB : cB + (size_t)(t + 2) * kstep;
            const char* a3 = a2 + kstep; const char* b3 = b2 + kstep;
            if (last && has_next) S.a_ready(nxt);
            if constexpr (SP2) {
            PG8_LDB(B0, 0, 0); PG8_LDB(B1, 0, 1); PG8_SCHED; PG8_LDA(At, 0, 0); PG8_STAGE(PG8_SA(1, 1), a1 + hstepA, voffA);
            PG8_WAIT_V(8); PG8_WAIT_L(0); PG8_BAR; PG8_MMA(0, 0, At, B0); PG8_MMA(0, 1, At, B1); PG8_BAR; PG8_SCHED;
            PG8_LDA(At, 0, 1); PG8_STAGE(PG8_SB(0, 0), b2, voffB); PG8_STAGE(PG8_SB(0, 1), b2 + hstepB, voffB); PG8_STAGE(PG8_SA(0, 0), a2, voffA);
            PG8_WAIT_V(8); PG8_WAIT_L(0); PG8_BAR; PG8_MMA(1, 0, At, B0); PG8_MMA(1, 1, At, B1); PG8_BAR; PG8_SCHED;
            PG8_LDB(B0, 1, 0); PG8_LDB(B1, 1, 1); PG8_SCHED; PG8_LDA(At, 1, 0); PG8_STAGE(PG8_SA(0, 1), a2 + hstepA, voffA);
            PG8_WAIT_V(8); PG8_WAIT_L(0); PG8_BAR; PG8_MMA(0, 0, At, B0); PG8_MMA(0, 1, At, B1); PG8_BAR; PG8_SCHED;
            PG8_LDA(At, 1, 1); PG8_STAGE(PG8_SB(1, 0), b3, voffB); PG8_STAGE(PG8_SB(1, 1), b3 + hstepB, voffB); PG8_STAGE(PG8_SA(1, 0), a3, voffA);
            PG8_WAIT_V(8); PG8_WAIT_L(0); PG8_BAR; PG8_MMA(1, 0, At, B0); PG8_MMA(1, 1, At, B1); PG8_BAR; PG8_SCHED;
            } else {
            PG8_LDB(B0, 0, 0); PG8_SCHED; PG8_LDA(At, 0, 0); PG8_STAGE(PG8_SA(1, 1), a1 + hstepA, voffA);
            PG8_WAIT_L(8); PG8_BAR; PG8_WAIT_L(0); PG8_MMA(0, 0, At, B0); PG8_BAR; PG8_SCHED;
            PG8_LDB(B1, 0, 1); PG8_STAGE(PG8_SB(0, 0), b2, voffB);
            PG8_BAR; PG8_WAIT_L(0); PG8_MMA(0, 1, At, B1); PG8_BAR;
            PG8_LDA(At, 0, 1); PG8_STAGE(PG8_SA(0, 0), a2, voffA);
            PG8_BAR; PG8_WAIT_L(0); PG8_MMA(1, 0, At, B0); PG8_BAR; PG8_SCHED;
            PG8_STAGE(PG8_SB(0, 1), b2 + hstepB, voffB);
            PG8_WAIT_V(6); PG8_BAR; PG8_MMA(1, 1, At, B1); PG8_BAR;
            PG8_LDB(B0, 1, 0); PG8_SCHED; PG8_LDA(At, 1, 0); PG8_STAGE(PG8_SA(0, 1), a2 + hstepA, voffA);
            PG8_WAIT_L(8); PG8_BAR; PG8_WAIT_L(0); PG8_MMA(0, 0, At, B0); PG8_BAR; PG8_SCHED;
            PG8_LDB(B1, 1, 1); PG8_STAGE(PG8_SB(1, 0), b3, voffB);
            PG8_BAR; PG8_WAIT_L(0); PG8_MMA(0, 1, At, B1); PG8_BAR;
            PG8_LDA(At, 1, 1); PG8_STAGE(PG8_SA(1, 0), a3, voffA);
            PG8_BAR; PG8_WAIT_L(0); PG8_MMA(1, 0, At, B0); PG8_BAR; PG8_SCHED;
            PG8_STAGE(PG8_SB(1, 1), b3 + hstepB, voffB);
            PG8_WAIT_V(6); PG8_BAR; PG8_MMA(1, 1, At, B1); PG8_BAR;
            }
        }
        if constexpr (ALIGN_EPI) { if (wr == 0) PG8_BAR; }
        if constexpr (!Epi::AFTER_DRAIN) { E(acc, cur, wr, wc, fr, fq); S.done(cur); }
        if (!has_next) break;
#pragma unroll
        for (int a = 0; a < 2; ++a)
#pragma unroll
            for (int b = 0; b < 2; ++b)
#pragma unroll
                for (int m = 0; m < 4; ++m)
#pragma unroll
                    for (int n = 0; n < 2; ++n) acc[a][b][m][n] = (f32x4){0.f, 0.f, 0.f, 0.f};
        cur = nxt; cA = nA; cB = nB; ++ui; nt = S.kt(g, cur);
        if constexpr (ALIGN_EPI) { if (wr == 1) PG8_BAR; }
    }
    PG8_WAIT_V(0);
    if constexpr (!ALIGN_EPI) { if (wr == 0) PG8_BAR; }
    PG8_BAR;
    if constexpr (Epi::AFTER_DRAIN) { E.fused(acc, cur, wr, wc, fr, fq, lds, wid, lane); S.done(cur); }
#undef PG8_SA
#undef PG8_SB
#undef PG8_STAGE
#undef PG8_LDA
#undef PG8_LDB
#undef PG8_MMA
#undef PG8_WAIT_V
#undef PG8_WAIT_L
#undef PG8_BAR
#undef PG8_SCHED
}
}

#define LAS __attribute__((address_space(3)))
#define XB_TMO      128
#define XB_XCNT(j)  (256  + 64 * (j))
#define XB_XSUB(j)  (1280 + 64 * (j))
#define XB_XGEN(j)  (2304 + 64 * (j))
#define XB_TOP      3328
#define XB_TOPGEN   3392
#define XCD_BAR_WORDS 3456
#define XB_SPIN_CAP (1u << 18)

__device__ __forceinline__ unsigned xb_ld(unsigned* p)              { return __hip_atomic_load(p, __ATOMIC_RELAXED, __HIP_MEMORY_SCOPE_AGENT); }
__device__ __forceinline__ unsigned xb_add(unsigned* p, unsigned v) { return __hip_atomic_fetch_add(p, v, __ATOMIC_RELAXED, __HIP_MEMORY_SCOPE_AGENT); }
__device__ __forceinline__ unsigned xb_xcc_id() { return (unsigned)__builtin_amdgcn_s_getreg((3 << 11) | 20) & 0xFu; }
#define XB_SPIN(cond, bar) do { unsigned _sp = 0; while (cond) { __builtin_amdgcn_s_sleep(1); \
    if ((++_sp & 255u) == 0u) { if (xb_ld(&(bar)[XB_TMO])) break; if (_sp > XB_SPIN_CAP) { atomicAdd(&(bar)[XB_TMO], 1u); break; } } } } while (0)

struct XcdBarrier {
    unsigned* bar; unsigned x;
    volatile LAS unsigned* st;
};

__device__ __forceinline__ XcdBarrier xcd_barrier_post(unsigned* bar, volatile LAS unsigned* st) {
    XcdBarrier b; b.bar = bar; b.x = xb_xcc_id(); b.st = st;
    if (threadIdx.x == 0) (void)xb_add(&bar[XB_XCNT(b.x)], 1u);
    return b;
}
__device__ __forceinline__ void xcd_barrier_complete(unsigned* bar, unsigned x, unsigned& nloc, unsigned& nx) {
    const unsigned G = gridDim.x * gridDim.y * gridDim.z;
    unsigned sum, cnt, mine, sp = 0u;
    for (;;) {
        sum = 0u; cnt = 0u; mine = 0u;
#pragma unroll
        for (unsigned j = 0; j < 16; ++j) { const unsigned c = xb_ld(&bar[XB_XCNT(j)]); sum += c; cnt += (c > 0u) ? 1u : 0u; mine = (j == x) ? c : mine; }
        if (sum == G) break;
        __builtin_amdgcn_s_sleep(1);
        if ((++sp & 255u) == 0u) { if (xb_ld(&bar[XB_TMO])) break; if (sp > XB_SPIN_CAP) { atomicAdd(&bar[XB_TMO], 1u); break; } }
    }
    nloc = mine > 0u ? mine : 1u; nx = cnt > 0u ? cnt : 1u;
}

__device__ __forceinline__ void xcd_barrier(const XcdBarrier& b) {
    asm volatile("s_waitcnt vmcnt(0)" ::: "memory");
    __syncthreads();
    if (threadIdx.x == 0) {
        unsigned* bar = b.bar;
        __builtin_amdgcn_s_waitcnt(0);
        unsigned nloc = b.st[0], nx = b.st[1];
        if (nloc == 0u) { xcd_barrier_complete(bar, b.x, nloc, nx); b.st[0] = nloc; b.st[1] = nx; }
        const unsigned old = xb_add(&bar[XB_XSUB(b.x)], 1u);
        const unsigned gen = old / nloc;
        if (old + 1u == (gen + 1u) * nloc) {
            __builtin_amdgcn_fence(__ATOMIC_RELEASE, "agent");
            asm volatile("s_waitcnt vmcnt(0)" ::: "memory");
            const unsigned og = xb_add(&bar[XB_TOP], 1u);
            const unsigned tg = og / nx;
            if (og + 1u == (tg + 1u) * nx) xb_add(&bar[XB_TOPGEN], 1u);
            else XB_SPIN(xb_ld(&bar[XB_TOPGEN]) == tg, bar);
            __builtin_amdgcn_fence(__ATOMIC_ACQUIRE, "agent");
            xb_add(&bar[XB_XGEN(b.x)], 1u);
            asm volatile("s_waitcnt vmcnt(0)" ::: "memory");
        } else {
            XB_SPIN(xb_ld(&bar[XB_XGEN(b.x)]) == gen, bar);
            __builtin_amdgcn_fence(__ATOMIC_ACQUIRE, "agent");
            asm volatile("s_waitcnt vmcnt(0)" ::: "memory");
        }
    }
    __syncthreads();
}

namespace mk {
using pg8::bf16_t;
constexpr int NWAVES = 8, NTHR = 512;
constexpr int D = 1024, NB = 16, S = 2048, T = NB * S, NIN = 9222, NP = 9216;
constexpr int DFF = 2816, NE = 8, DFE = 3584;
constexpr float EPS = 1e-6f, LOG2E = 1.4426950408889634f;
constexpr int CH_B = 8, CH_T = CH_B * S;

constexpr size_t WS_CTL = 0, CTL_BYTES = 1u << 20, CTL_ZERO = 64u << 10;
constexpr size_t WS_MOD = WS_CTL + CTL_BYTES;
constexpr size_t WS_MISC = WS_MOD + (size_t)2 * NB * 6 * D * 4;
constexpr size_t WS_WIN = WS_MISC + (8u << 20);
constexpr size_t WS_WBR = WS_WIN + (size_t)2 * NP * D * 2;
constexpr size_t WS_WOUT = WS_WBR + (size_t)2 * 1280 * D * 2;
constexpr size_t WS_WGU0 = WS_WOUT + (size_t)2 * D * D * 2;
constexpr size_t WS_WD0 = WS_WGU0 + (size_t)2 * DFF * D * 2;
constexpr size_t WS_WGU1 = WS_WD0 + (size_t)D * DFF * 2;
constexpr size_t WS_WD1 = WS_WGU1 + (size_t)NE * 2 * DFE * D * 2;
constexpr size_t WS_H = WS_WD1 + (size_t)NE * D * DFE * 2;
constexpr size_t WS_PROJ = WS_H + (size_t)T * D * 2;
constexpr size_t WS_END = WS_PROJ + (size_t)CH_T * NP * 2;
constexpr size_t WS_QO = WS_PROJ;
constexpr size_t WS_KV = WS_QO + (size_t)CH_T * 2048 * 2;
constexpr size_t WS_GATE = WS_KV + (size_t)CH_T * 4096 * 2;
constexpr size_t KVB0 = (size_t)8 * 4 * 2 * 2048 * 128, KVC0 = KVB0 + (size_t)8 * 18 * 2 * 2048 * 64;
static_assert(WS_GATE + (size_t)CH_T * 3072 * 2 == WS_END, "projection buffers");
constexpr size_t WS_QO1 = WS_WGU1, WS_GATE1 = WS_QO1 + (size_t)CH_T * 2048 * 2;
static_assert(WS_GATE1 + (size_t)CH_T * 3072 * 2 <= WS_H, "second QO / gate set inside the expert weight region");
static_assert(WS_END <= 640000000ull, "d_ws map");
constexpr int MI_LAM = 0;
constexpr int MOE_MAXT = 264, MOE_ROWS = MOE_MAXT * 256;
constexpr int MI_TILE_E = 1024;
constexpr int MI_TOK_E = 4096;
constexpr int MI_TOK_POS = MI_TOK_E + 2 * T;
constexpr int MI_TOK_W = MI_TOK_POS + 2 * T;
constexpr int MI_ROW_W = MI_TOK_W + 2 * T;
constexpr int MI_LOGF = MI_ROW_W + MOE_ROWS;
constexpr int MI_NEGF = MI_LOGF + 8 * T;
constexpr int MI_LSE = MI_NEGF + NB * 6 * S;
constexpr int MI_LUTA = MI_LSE + 3 * CH_T * 8;
constexpr int MI_LUTB = MI_LUTA + 8 * 2240;
constexpr int MI_WF = MI_LUTB + 18 * 384;
constexpr int MI_END = MI_WF + 2 * 1024 * 8;
static_assert(MI_END * 4 <= (8 << 20), "MISC map");
constexpr size_t WS_HS = WS_PROJ;
constexpr size_t WS_ACT1 = WS_PROJ + (size_t)MOE_ROWS * D * 2;
constexpr int MOE_CH = 64;
static_assert(WS_ACT1 + (size_t)72 * 256 * DFE * 2 <= WS_END, "MoE buffers inside the PROJ region");
constexpr int CW_CNT = 64;
constexpr int CW_BAR = 4096;

constexpr int RING_BYTES = 131072, LDS_BYTES = 147456, LDSCTL_OFF = LDS_BYTES - 1024, MISC_OFF = LDSCTL_OFF + 320;

#define GAS __attribute__((address_space(1)))
typedef unsigned v4u __attribute__((ext_vector_type(4)));
typedef unsigned v2u __attribute__((ext_vector_type(2)));
typedef float f32x4 __attribute__((ext_vector_type(4)));
#define LDS_WAIT() asm volatile("s_waitcnt lgkmcnt(0)" ::: "memory")
__device__ __forceinline__ unsigned f2bf(float f) { unsigned u = __builtin_bit_cast(unsigned, f); return (u + 0x7fffu + ((u >> 16) & 1u)) >> 16; }
__device__ __forceinline__ unsigned pk2(float lo, float hi) { return f2bf(lo) | (f2bf(hi) << 16); }
__device__ __forceinline__ float wave_sum(float v) {
#pragma unroll
    for (int o = 1; o < 64; o <<= 1) v += __shfl_xor(v, o);
    return v;
}

struct Params { const float* in[26]; float* out; unsigned char* ws; int lo, hi, li, pad; };

typedef const __attribute__((address_space(4))) Params* CParams;
__device__ __forceinline__ Params load_params() {
#if defined(__HIP_DEVICE_COMPILE__)
    CParams pp = (CParams)__builtin_amdgcn_kernarg_segment_ptr(); asm volatile("" : "+s"(pp));
    Params q;
#pragma unroll
    for (int i = 0; i < 26; ++i) q.in[i] = pp->in[i];
    q.out = pp->out; q.ws = pp->ws; q.lo = pp->lo; q.hi = pp->hi; q.li = pp->li; q.pad = 0; return q;
#else
    return Params{};
#endif
}
constexpr int ST_PRO = 0, LSTEPS = 22, ST_L0 = 1;
constexpr int SO_NORM1 = 0, SO_CHUNK = 1, CSTEPS = 5, SO_NORM2 = 11, SO_FFN = 12;
constexpr int ST_END = ST_L0 + 2 * LSTEPS;

__device__ __forceinline__ void transpose_item(const float* W, int ldw, int K  , bf16_t* WT, int k0, int n0, int drow0, LAS float* scr, int lane) {
    float tv[32];
#pragma unroll
    for (int i = 0; i < 32; ++i) tv[i] = W[(size_t)(k0 + 2 * i + (lane >> 5)) * ldw + n0 + (lane & 31)];
#pragma unroll
    for (int i = 0; i < 32; ++i) scr[(2 * i + (lane >> 5)) * 33 + (lane & 31)] = tv[i];
    LDS_WAIT(); asm volatile("" ::: "memory");
    const int c = lane & 7;
#pragma unroll
    for (int j = 0; j < 4; ++j) { const int n = (lane >> 3) + 8 * j; const LAS float* s = scr + (8 * c) * 33 + n;
        v4u o; o.x = pk2(s[0 * 33], s[1 * 33]); o.y = pk2(s[2 * 33], s[3 * 33]); o.z = pk2(s[4 * 33], s[5 * 33]); o.w = pk2(s[6 * 33], s[7 * 33]);
        *(GAS v4u*)(WT + (size_t)(drow0 + n) * K + k0 + 8 * c) = o; }
    LDS_WAIT(); asm volatile("" ::: "memory");
}
struct Job { const float* W; bf16_t* WT; int ldw, K, nblk, mode, drow, first, kp, pad; };
constexpr int NJOBS = 2 * 6 + 3 + 3 * NE;
__device__ __forceinline__ void job_set(LAS Job* J, int& nj, int& items, const float* W, int ldw, int K, int ncols, int mode, int drow, bf16_t* WT, int kp = 0) {
    J[nj].kp = kp ? kp : K; J[nj].W = W; J[nj].WT = WT; J[nj].ldw = ldw; J[nj].K = K; J[nj].nblk = ncols / 32; J[nj].mode = mode; J[nj].drow = drow; J[nj].first = items; ++nj; items += (K / 64) * (ncols / 32);
}
constexpr int PRO_SCR = 0, PRO_SC = 8 * 64 * 33 * 4  , PRO_JOB = PRO_SC + NB * D * 4  , PRO_JN = PRO_JOB + 48 * 48;
static_assert(PRO_JN + 64 <= LDSCTL_OFF && sizeof(Job) == 48 && NJOBS <= 48, "prologue LDS map");

__device__ __forceinline__ void build_luts(const Params& p, int tid);
__device__ __forceinline__ void run_jobs(LAS Job* J, LAS int* JN, LAS unsigned char* lds, int lane, int wave) {
    LAS float* scr = (LAS float*)(lds + PRO_SCR) + wave * (64 * 33);
    const int nj = JN[0], nitems = JN[1];
    const int gw = blockIdx.x * NWAVES + wave, NGW = gridDim.x * NWAVES;
    for (int it = gw; it < nitems; it += NGW) {
        int ji = 0;
        for (int q = 1; q < nj; ++q) if (J[q].first <= it) ji = q;
        const float* jW = J[ji].W; bf16_t* jWT = J[ji].WT; const int jldw = J[ji].ldw, jK = J[ji].kp, jnblk = J[ji].nblk, jmode = J[ji].mode, jdrow = J[ji].drow;
        const int r = it - J[ji].first, kb = r / jnblk, nb = r - kb * jnblk, n0 = 32 * nb;
        const int drow0 = jmode ? jdrow + 256 * (n0 >> 7) + (n0 & 127) : jdrow + n0;
        transpose_item(jW + n0, jldw, jK, jWT, 64 * kb, 0, drow0, scr, lane);
    }
}
__device__ __forceinline__ void prologue(const Params& p, LAS unsigned char* lds, int tid, int lane, int wave) {
    unsigned char* ws = p.ws;
    LAS Job* J = (LAS Job*)(lds + PRO_JOB);
    LAS int* JN = (LAS int*)(lds + PRO_JN);
    if (tid == 0) {
        int nj = 0, items = 0;
        for (int l = 0; l < 2; ++l) {
            bf16_t* win = (bf16_t*)(ws + WS_WIN) + (size_t)l * NP * D; const float* w_in = p.in[6] + (size_t)l * D * NIN;
            job_set(J, nj, items, w_in, NIN, D, 6144, 0, 0, win);
            job_set(J, nj, items, w_in + 6150, NIN, D, 3072, 0, 6144, win);
            bf16_t* wbr = (bf16_t*)(ws + WS_WBR) + (size_t)l * 1280 * D;
            job_set(J, nj, items, p.in[14] + (size_t)l * 512 * D, D, 512, D, 0, 0, wbr, 1280);
            job_set(J, nj, items, p.in[15] + (size_t)l * 384 * D, D, 384, D, 0, 0, wbr + 512, 1280);
            job_set(J, nj, items, p.in[16] + (size_t)l * 384 * D, D, 384, D, 0, 0, wbr + 896, 1280);
            job_set(J, nj, items, p.in[17] + (size_t)l * D * D, D, D, D, 0, 0, (bf16_t*)(ws + WS_WOUT) + (size_t)l * D * D);
        }
        job_set(J, nj, items, p.in[18], DFF, D, DFF, 1, 0, (bf16_t*)(ws + WS_WGU0));
        job_set(J, nj, items, p.in[19], DFF, D, DFF, 1, 128, (bf16_t*)(ws + WS_WGU0));
        job_set(J, nj, items, p.in[20], D, DFF, D, 0, 0, (bf16_t*)(ws + WS_WD0));
        JN[0] = nj; JN[1] = items;
    }
    LAS float* sc = (LAS float*)(lds + PRO_SC);
    const bool modblk = blockIdx.x < 192;
    if (modblk) for (int i = tid; i < NB * D; i += NTHR) { const float c = p.in[1][i]; sc[i] = c / (1.0f + __expf(-c)); }
    __syncthreads();
    float* misc = (float*)(ws + WS_MISC);
    if (blockIdx.x == 192 && wave < 2) {
        const int l = wave; const float a = wave_sum(p.in[8][l * 64 + lane] * p.in[9][l * 64 + lane]), b = wave_sum(p.in[10][l * 64 + lane] * p.in[11][l * 64 + lane]);
        const float lam_init = 0.8f - 0.6f * __expf(-0.3f * (float)l);
        if (lane == 0) { misc[MI_LAM + l] = __expf(a) - __expf(b) + lam_init; misc[MI_LAM + 8 + l] = lam_init; }
    }
    if (modblk) {
        const int l = blockIdx.x / 96, j = (blockIdx.x % 96) * 64 + lane;
        const float* w = p.in[4] + (size_t)l * D * 6 * D + (size_t)(wave * 128) * 6 * D + j;
        const LAS float* scw = sc + wave * 128;
        float acc[NB];
#pragma unroll
        for (int b = 0; b < NB; ++b) acc[b] = 0.f;
        for (int k0 = 0; k0 < 128; k0 += 16) {
            float wv[16];
#pragma unroll
            for (int i = 0; i < 16; ++i) wv[i] = w[(size_t)(k0 + i) * 6 * D];
#pragma unroll
            for (int i = 0; i < 16; ++i)
#pragma unroll
                for (int b = 0; b < NB; ++b) acc[b] += scw[b * D + k0 + i] * wv[i];
        }
        LAS float* part = (LAS float*)(lds + PRO_SCR) + wave * (64 * 33);
#pragma unroll
        for (int b = 0; b < NB; ++b) part[b * 64 + lane] = acc[b];
    }
    __syncthreads();
    if (modblk) {
        const int l = blockIdx.x / 96, j0 = (blockIdx.x % 96) * 64;
        float* mod = (float*)(ws + WS_MOD) + (size_t)l * NB * 6 * D;
        for (int o = tid; o < NB * 64; o += NTHR) { const int b = o >> 6, jj = o & 63; float sum = p.in[5][l * 6 * D + j0 + jj];
#pragma unroll
            for (int w8 = 0; w8 < NWAVES; ++w8) sum += ((const LAS float*)(lds + PRO_SCR) + w8 * (64 * 33))[b * 64 + jj];
            mod[(size_t)b * 6 * D + j0 + jj] = sum; }
    }
    __syncthreads();
    build_luts(p, tid);
    run_jobs(J, JN, lds, lane, wave);
}
__device__ __forceinline__ void convert_experts(const Params& p, LAS unsigned char* lds, int tid, int lane, int wave) {
    unsigned char* ws = p.ws;
    LAS Job* J = (LAS Job*)(lds + PRO_JOB); LAS int* JN = (LAS int*)(lds + PRO_JN);
    __syncthreads();
    if (tid == 0) { int nj = 0, items = 0;
        for (int e = 0; e < NE; ++e) {
            bf16_t* wgu = (bf16_t*)(ws + WS_WGU1) + (size_t)e * 2 * DFE * D;
            job_set(J, nj, items, p.in[22] + (size_t)e * D * DFE, DFE, D, DFE, 1, 0, wgu);
            job_set(J, nj, items, p.in[23] + (size_t)e * D * DFE, DFE, D, DFE, 1, 128, wgu);
            job_set(J, nj, items, p.in[24] + (size_t)e * DFE * D, D, DFE, D, 0, 0, (bf16_t*)(ws + WS_WD1) + (size_t)e * D * DFE);
        }
        JN[0] = nj; JN[1] = items; }
    __syncthreads();
    run_jobs(J, JN, lds, lane, wave);
}

__device__ __forceinline__ void norm_rows(const float* x, const float* g, const float* sc, const float* sh, bf16_t* h, int t0, int t1, int gw, int NGW, int lane) {
    f32x4 vn[4], vm[4];
    { const int tf = (t0 + gw < t1) ? t0 + gw : 0, tg = (t0 + gw + NGW < t1) ? t0 + gw + NGW : tf; const GAS f32x4* xn = (const GAS f32x4*)(x + (size_t)tf * D) + lane; const GAS f32x4* xm = (const GAS f32x4*)(x + (size_t)tg * D) + lane;
#pragma unroll
      for (int j = 0; j < 4; ++j) { vn[j] = xn[64 * j]; vm[j] = xm[64 * j]; } }
    const int TEND = t1;
    for (int t = t0 + gw; t < t1; t += NGW) {
        const int b = t >> 11;
        f32x4 v[4]; float s = 0.f;
#pragma unroll
        for (int j = 0; j < 4; ++j) { v[j] = vn[j]; vn[j] = vm[j]; s += (v[j].x * v[j].x + v[j].y * v[j].y) + (v[j].z * v[j].z + v[j].w * v[j].w); }
        { const int tn = (t + 2 * NGW < TEND) ? t + 2 * NGW : t; const GAS f32x4* xn = (const GAS f32x4*)(x + (size_t)tn * D) + lane;
#pragma unroll
          for (int j = 0; j < 4; ++j) vm[j] = xn[64 * j]; }
        const float r = 1.0f / sqrtf(wave_sum(s) * (1.0f / D) + EPS);
        GAS v2u* o8 = (GAS v2u*)(h + (size_t)t * D) + lane;
#pragma unroll
        for (int j = 0; j < 4; ++j) { const int d = 4 * lane + 256 * j;
            const f32x4 g4 = *(const f32x4*)(g + d), c4 = *(const f32x4*)(sc + (size_t)b * 6 * D + d), h4 = *(const f32x4*)(sh + (size_t)b * 6 * D + d);
            const f32x4 o = v[j] * r * g4 * (c4 + 1.0f) + h4;
            v2u w; w.x = pk2(o.x, o.y); w.y = pk2(o.z, o.w); o8[64 * j] = w; }
    }
}


typedef float f32x16 __attribute__((ext_vector_type(16)));
typedef short bf16x8 __attribute__((ext_vector_type(8)));
typedef short s16x4 __attribute__((ext_vector_type(4)));
typedef float f32x2_t __attribute__((ext_vector_type(2))); typedef __bf16 bf16x2_t __attribute__((ext_vector_type(2)));
constexpr int QP = 2048;
constexpr int AL_K = 0, AL_V = 49152, AL_LUT = 114688, AL_OST = 65536, AL_XCH = 0;
static_assert(AL_LUT + 2 * 2240 * 4 <= LDSCTL_OFF && AL_OST + 34816 <= AL_LUT && 6 * 8192 <= AL_V && AL_V + 6 * 8192 <= AL_LUT, "attention LDS map");
constexpr int LUTA_N = 2240, LUTB_N = 384;
constexpr float NEG_BIG = -1.0e30f;
__device__ __forceinline__ unsigned cvtpk_s(float lo, float hi) { f32x2_t v = {lo, hi}; bf16x2_t b = __builtin_convertvector(v, bf16x2_t); return __builtin_bit_cast(unsigned, b); }
__device__ __forceinline__ s16x4 vtr(const LAS unsigned char* p) { typedef short v4i16_t __attribute__((ext_vector_type(4))); return __builtin_bit_cast(s16x4, __builtin_amdgcn_ds_read_tr16_b64_v4i16((LAS v4i16_t*)p)); }
__device__ __forceinline__ float xhalf_max(float v) { auto rr = __builtin_amdgcn_permlane32_swap(__float_as_uint(v), __float_as_uint(v), false, false); return fmaxf(__uint_as_float(rr[0]), __uint_as_float(rr[1])); }
__device__ __forceinline__ float xhalf_sum(float v) { auto rr = __builtin_amdgcn_permlane32_swap(__float_as_uint(v), __float_as_uint(v), false, false); return __uint_as_float(rr[0]) + __uint_as_float(rr[1]); }

struct AttnArgs {
    bf16_t* q;
    const bf16_t* k;
    const bf16_t* v;
    int q0;
    const float* tab;
    int seqM;
    float* lse;
    float lam, osc;
    const float* subg;
};
template <int MODE> __device__ __forceinline__ void attn_unit(const AttnArgs& a, LAS unsigned char* lds, int tid_in, int lane_in, int wave) {
    int tid = tid_in; asm volatile("" : "+v"(tid)); const int lane = tid & 63; (void)lane_in;
    constexpr int DV = MODE == 0 ? 128 : 64, NDB = DV / 32, NKL = MODE == 0 ? 2 : 1, NVL = MODE == 0 ? 2 : 1;
    const int r32 = lane & 31, hi = lane >> 5;
    const int map = MODE == 0 ? (wave >> 2) : 0, wq = MODE == 0 ? (wave & 3) : wave;
    const int qrow = a.q0 + 32 * wq;
    constexpr int KP = MODE == 0 ? 128 : 64, VP = KP;
    LAS float* lut = (LAS float*)(lds + AL_LUT);
    { constexpr int NT = MODE == 0 ? 2 * LUTA_N : (MODE == 1 ? 2048 : LUTB_N), NIT = (NT + NTHR - 1) / NTHR;
      const int need = MODE == 1 ? (a.q0 + 256) : NT;
      float tv[NIT];
#pragma unroll
      for (int k = 0; k < NIT; ++k) { const int i = tid + k * NTHR; tv[k] = i < need ? a.tab[i] : 0.f; }
#pragma unroll
      for (int k = 0; k < NIT; ++k) { const int i = tid + k * NTHR; if (i < need) lut[i] = tv[k]; } }
    bf16x8 qr[4];
    { const bf16_t* Qw = a.q + (size_t)(qrow + r32) * QP + map * 64 + hi * 8;
#pragma unroll
      for (int d0 = 0; d0 < 4; ++d0) qr[d0] = *(const bf16x8*)(Qw + d0 * 16); }
    int tlo, thi;
    if (MODE == 0) { tlo = 0; thi = (a.q0 + 128) / 64 - 1; }
    else if (MODE == 1) { tlo = 0; thi = (a.q0 + 256) / 64 - 1; }
    else { const int lo = a.q0 - 128; tlo = lo > 0 ? lo / 64 : 0; thi = (a.q0 + 256) / 64 - 1; }
    const bf16_t* gK = a.k + (size_t)(tid & 63) * KP + (tid >> 6) * 8;
    const bf16_t* gV = a.v + (size_t)(16 * (wave & 3) + (lane >> 2)) * VP + (wave >> 2) * 32 + (lane & 3) * 8;
#define AT_DMA(t_) do { const size_t ro = (size_t)(t_) * 64 * KP; const int ks_ = (MODE == 2 ? ((t_) - tlo) * 8192 : ((t_) % 3) * 16384) + wave * 1024, vs_ = (MODE == 2 ? ((t_) - tlo) * 8192 : ((t_) & 3) * 16384) + wave * 1024; \
        _Pragma("unroll") for (int i_ = 0; i_ < NKL; ++i_) __builtin_amdgcn_global_load_lds((const unsigned*)(gK + ro + i_ * 64), (LAS unsigned*)(lds + AL_K + ks_ + i_ * 8192), 16, 0, 0); \
        _Pragma("unroll") for (int i_ = 0; i_ < NVL; ++i_) __builtin_amdgcn_global_load_lds((const unsigned*)(gV + ro + i_ * 64), (LAS unsigned*)(lds + AL_V + vs_ + i_ * 8192), 16, 0, 0); } while (0)
#define AT_WAITBAR(n_) asm volatile("s_waitcnt vmcnt(" #n_ ") lgkmcnt(0)\n\ts_barrier" ::: "memory")
    constexpr float THR = 6.0f;
    float m_run = 0.f, l_run = 0.f;
    f32x16 negm = f32x16{};
    f32x16 o[NDB];
#pragma unroll
    for (int i = 0; i < NDB; ++i) o[i] = f32x16{};
    const int e0 = qrow + r32 - 4 * hi;
    int imax = 0, seq0 = 0;
    if (MODE == 2) { seq0 = qrow & ~(a.seqM - 1); const int dq = qrow + r32 - seq0; imax = dq < 128 ? dq : 128; }
    bf16x8 pw[4];
    bool pend = false; int pend_vs = 0;
#define AT_PV() do { const unsigned vb = (unsigned)(size_t)(lds + AL_V + pend_vs) + ((lane >> 4) & 1) * 32 + (lane & 3) * 8 + (4 * hi + ((lane & 15) >> 2)) * 64; \
        _Pragma("unroll") for (int dp = 0; dp < NDB; dp += 2) { s16x4 lo_[2][4], hh_[2][4];          \
            _Pragma("unroll") for (int dd = 0; dd < 2; ++dd) _Pragma("unroll") for (int ks = 0; ks < 4; ++ks) { \
                asm volatile("ds_read_b64_tr_b16 %0, %1 offset:%c2" : "=&v"(lo_[dd][ks]) : "v"(vb), "i"((dp + dd) * 4096 + ks * 1024) : "memory"); \
                asm volatile("ds_read_b64_tr_b16 %0, %1 offset:%c2" : "=&v"(hh_[dd][ks]) : "v"(vb), "i"((dp + dd) * 4096 + ks * 1024 + 512) : "memory"); } \
            asm volatile("s_waitcnt lgkmcnt(0)" ::: "memory"); __builtin_amdgcn_sched_barrier(0);     \
            _Pragma("unroll") for (int ks = 0; ks < 4; ++ks) _Pragma("unroll") for (int dd = 0; dd < 2; ++dd) { const bf16x8 vf = __builtin_shufflevector(lo_[dd][ks], hh_[dd][ks], 0, 1, 2, 3, 4, 5, 6, 7); \
                o[dp + dd] = __builtin_amdgcn_mfma_f32_32x32x16_bf16(vf, pw[ks], o[dp + dd], 0, 0, 0); } } } while (0)
#define MX3(a_, b_, c_) __builtin_fmaxf(__builtin_fmaxf((a_), (b_)), (c_))
#define AT_STEP(MASKED, t) do { \
        const int E = e0 - 64 * (t); \
        f32x16 p0, p1; \
        { const LAS unsigned char* kb = lds + AL_K + (MODE == 2 ? ((t) - tlo) * 8192 : ((t) % 3) * 16384) + map * 8192 + hi * 1024 + r32 * 16; bf16x8 kf[8]; \
          _Pragma("unroll") for (int d0 = 0; d0 < 4; ++d0) { kf[2 * d0] = *(const LAS bf16x8*)(kb + d0 * 2048); kf[2 * d0 + 1] = *(const LAS bf16x8*)(kb + d0 * 2048 + 512); }     \
          p0 = __builtin_amdgcn_mfma_f32_32x32x16_bf16(kf[0], qr[0], negm, 0, 0, 0); p1 = __builtin_amdgcn_mfma_f32_32x32x16_bf16(kf[1], qr[0], negm, 0, 0, 0); \
          _Pragma("unroll") for (int d0 = 1; d0 < 4; ++d0) { p0 = __builtin_amdgcn_mfma_f32_32x32x16_bf16(kf[2 * d0], qr[d0], p0, 0, 0, 0); p1 = __builtin_amdgcn_mfma_f32_32x32x16_bf16(kf[2 * d0 + 1], qr[d0], p1, 0, 0, 0); } } \
        if (pend) AT_PV(); \
        if (MODE == 0) __builtin_amdgcn_sched_barrier(0); \
        _Pragma("unroll") for (int hf = 0; hf < 2; ++hf) { f32x16 bb; \
            if (MODE == 1) { const LAS float* nf = lut + 64 * (t) + 4 * hi + 32 * hf; \
                _Pragma("unroll") for (int g = 0; g < 4; ++g) { const f32x4 a0 = *(const LAS f32x4*)(nf + 8 * g); bb[4 * g] = a0.x; bb[4 * g + 1] = a0.y; bb[4 * g + 2] = a0.z; bb[4 * g + 3] = a0.w; } \
            } else { const LAS float* lb = lut + (MODE == 0 ? map * LUTA_N + 2047 - E : 255 - E) + 32 * hf; \
                _Pragma("unroll") for (int r = 0; r < 16; ++r) bb[r] = lb[(r & 3) + 8 * (r >> 2)]; } \
            if (hf == 0) p0 += bb; else p1 += bb; \
            if (MODE == 0) __builtin_amdgcn_sched_barrier(0); } \
        if (MASKED) {   \
            if (MODE == 2) { if (qrow - seq0 < 128) { const int lim = E - imax; _Pragma("unroll") for (int r = 0; r < 16; ++r) { const int c0 = (r & 3) + 8 * (r >> 2), c1 = c0 + 32; \
                if (c0 < lim) p0[r] = -INFINITY; if (c1 < lim) p1[r] = -INFINITY; } } } \
            else if (MODE == 1) { _Pragma("unroll") for (int r = 0; r < 16; ++r) { const int c0 = (r & 3) + 8 * (r >> 2), c1 = c0 + 32; if (c0 > E) p0[r] = -INFINITY; if (c1 > E) p1[r] = -INFINITY; } } } \
        float ta = MX3(p0[0], p0[1], p1[0]), tb = MX3(p0[2], p0[3], p1[1]); ta = MX3(ta, p1[2], p1[3]); \
        _Pragma("unroll") for (int r = 4; r < 16; r += 4) { ta = MX3(ta, p0[r], p0[r + 1]); tb = MX3(tb, p0[r + 2], p0[r + 3]); ta = MX3(ta, p1[r], p1[r + 1]); tb = MX3(tb, p1[r + 2], p1[r + 3]); } \
        const float tm = xhalf_max(__builtin_fmaxf(ta, tb)); \
        bool resc = false; float al = 1.0f; \
        if (__any(tm > THR)) { const float dl = __builtin_fmaxf(tm, 0.f); m_run += dl; al = __builtin_amdgcn_exp2f(-dl); l_run *= al; resc = true; \
            _Pragma("unroll") for (int r = 0; r < 16; ++r) { p0[r] -= dl; p1[r] -= dl; negm[r] -= dl; } } \
        float rs0 = 0.f, rs1 = 0.f; \
        _Pragma("unroll") for (int r = 0; r < 16; ++r) { p0[r] = __builtin_amdgcn_exp2f(p0[r]); p1[r] = __builtin_amdgcn_exp2f(p1[r]); rs0 += p0[r]; rs1 += p1[r]; } \
        l_run += rs0 + rs1; \
        _Pragma("unroll") for (int ks = 0; ks < 4; ++ks) { v4u w; \
            if (ks < 2) { w.x = cvtpk_s(p0[8 * ks], p0[8 * ks + 1]); w.y = cvtpk_s(p0[8 * ks + 2], p0[8 * ks + 3]); w.z = cvtpk_s(p0[8 * ks + 4], p0[8 * ks + 5]); w.w = cvtpk_s(p0[8 * ks + 6], p0[8 * ks + 7]); } \
            else { const int k2 = ks - 2; w.x = cvtpk_s(p1[8 * k2], p1[8 * k2 + 1]); w.y = cvtpk_s(p1[8 * k2 + 2], p1[8 * k2 + 3]); w.z = cvtpk_s(p1[8 * k2 + 4], p1[8 * k2 + 5]); w.w = cvtpk_s(p1[8 * k2 + 6], p1[8 * k2 + 7]); } \
            pw[ks] = __builtin_bit_cast(bf16x8, w); } \
        if (resc) { _Pragma("unroll") for (int i = 0; i < NDB; ++i) _Pragma("unroll") for (int r = 0; r < 16; ++r) o[i][r] *= al; } \
        pend = true; pend_vs = MODE == 2 ? ((t) - tlo) * 8192 : ((t) & 3) * 16384; } while (0)
    constexpr int NPT = NKL + NVL;
#ifdef PROBE_ATT
    unsigned long long pt0_ = 0; const bool pr_ = ((PROBE_ATT >> MODE) & 1) && blockIdx.x == 0 && tid == 0; if (pr_) pt0_ = __builtin_amdgcn_s_memrealtime();
#endif
    asm volatile("s_waitcnt vmcnt(0) lgkmcnt(0)" ::: "memory");
    if (MODE == 2) {
        for (int t = tlo; t <= thi; ++t) AT_DMA(t);
        AT_WAITBAR(0);
        for (int t = tlo; t <= thi; ++t) {
            const int klo = qrow - 128 > seq0 ? qrow - 128 : seq0;
            const bool active = (64 * t <= qrow + 31) && (64 * t + 63 >= klo);
            if (active) AT_STEP(true, t);
        }
    } else {
    AT_DMA(tlo); if (tlo < thi) AT_DMA(tlo + 1);
    if (tlo < thi) { if (NPT == 4) AT_WAITBAR(4); else AT_WAITBAR(2); } else AT_WAITBAR(0);
    const int tband = thi - (MODE == 0 ? 1 : 3);
    int t = tlo;
    for (; t < tband; ++t) {
        AT_DMA(t + 2);
        AT_STEP(false, t);
        if (NPT == 4) AT_WAITBAR(4); else AT_WAITBAR(2);
    }
    for (; t <= thi; ++t) {
        if (t + 2 <= thi) AT_DMA(t + 2);
        const bool active = 64 * t <= qrow + 31;
        if (active) AT_STEP(true, t);
        else if (pend) { AT_PV(); pend = false; }
        if (t + 2 <= thi) { if (NPT == 4) AT_WAITBAR(4); else AT_WAITBAR(2); } else AT_WAITBAR(0);
    }
    }
    if (pend) AT_PV();
#ifdef PROBE_ATT
    if (pr_) { volatile LAS unsigned long long* q_ = (volatile LAS unsigned long long*)(lds + LDSCTL_OFF + 64); q_[1] += __builtin_amdgcn_s_memrealtime() - pt0_; }
#endif
    asm volatile("s_waitcnt lgkmcnt(0)\n\ts_barrier" ::: "memory");
#undef AT_STEP
#undef MX3
#undef AT_PV
#undef AT_DMA
#undef AT_WAITBAR
    const float lt = xhalf_sum(l_run), inv = 1.0f / lt;
#pragma unroll
    for (int i = 0; i < NDB; ++i)
#pragma unroll
        for (int r = 0; r < 16; ++r) o[i][r] *= inv;
    if (MODE == 2) { if (hi == 0) a.lse[(size_t)(qrow + r32) * 8] = m_run + __builtin_amdgcn_logf(lt); }
    bool store = true;
    if (MODE == 0) {
        LAS float* xch = (LAS float*)(lds + AL_XCH) + wq * 4096;
        if (map == 1) {
#pragma unroll
            for (int i = 0; i < NDB; ++i)
#pragma unroll
                for (int r = 0; r < 16; ++r) xch[(i * 16 + r) * 64 + lane] = o[i][r];
        }
        __syncthreads();
        if (map == 0) {
            float ss = 0.f;
#pragma unroll
            for (int i = 0; i < NDB; ++i)
#pragma unroll
                for (int r = 0; r < 16; ++r) { const float v = o[i][r] - a.lam * xch[(i * 16 + r) * 64 + lane]; o[i][r] = v; ss += v * v; }
            ss = xhalf_sum(ss);
            const float rn = (1.0f / sqrtf(ss * (1.0f / 128.0f) + EPS)) * a.osc;
#pragma unroll
            for (int i = 0; i < NDB; ++i)
#pragma unroll
                for (int g = 0; g < 4; ++g) { const f32x4 sg = *(const f32x4*)(a.subg + 32 * i + 8 * g + 4 * hi);
                    o[i][4 * g] *= rn * sg.x; o[i][4 * g + 1] *= rn * sg.y; o[i][4 * g + 2] *= rn * sg.z; o[i][4 * g + 3] *= rn * sg.w; }
        }
        store = map == 0;
    }
    if (store) {
        constexpr int RS = DV * 2 + 16;
        LAS unsigned char* ost = lds + AL_OST + wq * (32 * RS);
#pragma unroll
        for (int i = 0; i < NDB; ++i)
#pragma unroll
            for (int g = 0; g < 4; ++g) { v2u w; w.x = cvtpk_s(o[i][4 * g], o[i][4 * g + 1]); w.y = cvtpk_s(o[i][4 * g + 2], o[i][4 * g + 3]);
                *(LAS v2u*)(ost + r32 * RS + (32 * i + 8 * g + 4 * hi) * 2) = w; }
        LDS_WAIT();
        bf16_t* Ow = a.q + (size_t)qrow * QP;
        constexpr int CPR = DV / 8, RPI = 64 / CPR;
#pragma unroll
        for (int i = 0; i < 32 / RPI; ++i) { const int row = i * RPI + lane / CPR, ch = lane % CPR;
            const v4u v = *(const LAS v4u*)(ost + row * RS + ch * 16); *(GAS v4u*)(Ow + (size_t)row * QP + ch * 8) = v; }
    }
    __syncthreads();
}
__device__ const unsigned short SCHED_AC[256][6] = {
{0,848,1280,65535,65535,65535},
{1,849,1281,65535,65535,65535},
{2,850,1282,65535,65535,65535},
{3,851,1283,65535,65535,65535},
{4,852,1284,65535,65535,65535},
{5,853,1285,65535,65535,65535},
{6,854,1286,65535,65535,65535},
{7,855,1287,65535,65535,65535},
{8,856,1288,65535,65535,65535},
{9,857,1289,65535,65535,65535},
{10,858,1290,65535,65535,65535},
{11,859,1291,65535,65535,65535},
{12,860,1292,65535,65535,65535},
{13,861,1293,65535,65535,65535},
{14,862,1294,65535,65535,65535},
{15,863,1295,65535,65535,65535},
{16,864,1296,65535,65535,65535},
{17,865,1297,65535,65535,65535},
{18,866,1298,65535,65535,65535},
{19,867,1299,65535,65535,65535},
{20,868,1300,65535,65535,65535},
{21,869,1301,65535,65535,65535},
{22,870,1302,65535,65535,65535},
{23,871,1303,65535,65535,65535},
{24,872,1304,65535,65535,65535},
{25,873,1305,65535,65535,65535},
{26,874,1306,65535,65535,65535},
{27,875,1307,65535,65535,65535},
{28,876,1308,65535,65535,65535},
{29,877,1309,65535,65535,65535},
{30,878,1310,65535,65535,65535},
{31,879,1311,65535,65535,65535},
{64,784,1216,1344,65535,65535},
{65,785,1217,1345,65535,65535},
{66,786,1218,1346,65535,65535},
{67,787,1219,1347,65535,65535},
{68,788,1220,1348,65535,65535},
{69,789,1221,1349,65535,65535},
{70,790,1222,1350,65535,65535},
{71,791,1223,1351,65535,65535},
{72,792,1224,1352,65535,65535},
{73,793,1225,1353,65535,65535},
{74,794,1226,1354,65535,65535},
{75,795,1227,1355,65535,65535},
{76,796,1228,1356,65535,65535},
{77,797,1229,1357,65535,65535},
{78,798,1230,1358,65535,65535},
{79,799,1231,1359,65535,65535},
{80,832,1184,65535,65535,65535},
{81,833,1185,65535,65535,65535},
{82,834,1186,65535,65535,65535},
{83,835,1187,65535,65535,65535},
{84,836,1188,65535,65535,65535},
{85,837,1189,65535,65535,65535},
{86,838,1190,65535,65535,65535},
{87,839,1191,65535,65535,65535},
{88,840,1192,65535,65535,65535},
{89,841,1193,65535,65535,65535},
{90,842,1194,65535,65535,65535},
{91,843,1195,65535,65535,65535},
{92,844,1196,65535,65535,65535},
{93,845,1197,65535,65535,65535},
{94,846,1198,65535,65535,65535},
{95,847,1199,65535,65535,65535},
{128,736,1232,1360,65535,65535},
{129,737,1233,1361,65535,65535},
{130,738,1234,1362,65535,65535},
{131,739,1235,1363,65535,65535},
{132,740,1236,1364,65535,65535},
{133,741,1237,1365,65535,65535},
{134,742,1238,1366,65535,65535},
{135,743,1239,1367,65535,65535},
{136,744,1240,1368,65535,65535},
{137,745,1241,1369,65535,65535},
{138,746,1242,1370,65535,65535},
{139,747,1243,1371,65535,65535},
{140,748,1244,1372,65535,65535},
{141,749,1245,1373,65535,65535},
{142,750,1246,1374,65535,65535},
{143,751,1247,1375,65535,65535},
{144,768,1104,1408,65535,65535},
{145,769,1105,1409,65535,65535},
{146,770,1106,1410,65535,65535},
{147,771,1107,1411,65535,65535},
{148,772,1108,1412,65535,65535},
{149,773,1109,1413,65535,65535},
{150,774,1110,1414,65535,65535},
{151,775,1111,1415,65535,65535},
{152,776,1112,1416,65535,65535},
{153,777,1113,1417,65535,65535},
{154,778,1114,1418,65535,65535},
{155,779,1115,1419,65535,65535},
{156,780,1116,1420,65535,65535},
{157,781,1117,1421,65535,65535},
{158,782,1118,1422,65535,65535},
{159,783,1119,1423,65535,65535},
{192,704,1152,1424,65535,65535},
{193,705,1153,1425,65535,65535},
{194,706,1154,1426,65535,65535},
{195,707,1155,1427,65535,65535},
{196,708,1156,1428,65535,65535},
{197,709,1157,1429,65535,65535},
{198,710,1158,1430,65535,65535},
{199,711,1159,1431,65535,65535},
{200,712,1160,1432,65535,65535},
{201,713,1161,1433,65535,65535},
{202,714,1162,1434,65535,65535},
{203,715,1163,1435,65535,65535},
{204,716,1164,1436,65535,65535},
{205,717,1165,1437,65535,65535},
{206,718,1166,1438,65535,65535},
{207,719,1167,1439,65535,65535},
{208,720,1168,1440,65535,65535},
{209,721,1169,1441,65535,65535},
{210,722,1170,1442,65535,65535},
{211,723,1171,1443,65535,65535},
{212,724,1172,1444,65535,65535},
{213,725,1173,1445,65535,65535},
{214,726,1174,1446,65535,65535},
{215,727,1175,1447,65535,65535},
{216,728,1176,1448,65535,65535},
{217,729,1177,1449,65535,65535},
{218,730,1178,1450,65535,65535},
{219,731,1179,1451,65535,65535},
{220,732,1180,1452,65535,65535},
{221,733,1181,1453,65535,65535},
{222,734,1182,1454,65535,65535},
{223,735,1183,1455,65535,65535},
{256,640,896,65535,65535,65535},
{257,641,897,65535,65535,65535},
{258,642,898,65535,65535,65535},
{259,643,899,65535,65535,65535},
{260,644,900,65535,65535,65535},
{261,645,901,65535,65535,65535},
{262,646,902,65535,65535,65535},
{263,647,903,65535,65535,65535},
{264,648,904,65535,65535,65535},
{265,649,905,65535,65535,65535},
{266,650,906,65535,65535,65535},
{267,651,907,65535,65535,65535},
{268,652,908,65535,65535,65535},
{269,653,909,65535,65535,65535},
{270,654,910,65535,65535,65535},
{271,655,911,65535,65535,65535},
{272,656,912,65535,65535,65535},
{273,657,913,65535,65535,65535},
{274,658,914,65535,65535,65535},
{275,659,915,65535,65535,65535},
{276,660,916,65535,65535,65535},
{277,661,917,65535,65535,65535},
{278,662,918,65535,65535,65535},
{279,663,919,65535,65535,65535},
{280,664,920,65535,65535,65535},
{281,665,921,65535,65535,65535},
{282,666,922,65535,65535,65535},
{283,667,923,65535,65535,65535},
{284,668,924,65535,65535,65535},
{285,669,925,65535,65535,65535},
{286,670,926,65535,65535,65535},
{287,671,927,65535,65535,65535},
{320,576,960,65535,65535,65535},
{321,577,961,65535,65535,65535},
{322,578,962,65535,65535,65535},
{323,579,963,65535,65535,65535},
{324,580,964,65535,65535,65535},
{325,581,965,65535,65535,65535},
{326,582,966,65535,65535,65535},
{327,583,967,65535,65535,65535},
{328,584,968,65535,65535,65535},
{329,585,969,65535,65535,65535},
{330,586,970,65535,65535,65535},
{331,587,971,65535,65535,65535},
{332,588,972,65535,65535,65535},
{333,589,973,65535,65535,65535},
{334,590,974,65535,65535,65535},
{335,591,975,65535,65535,65535},
{336,592,976,65535,65535,65535},
{337,593,977,65535,65535,65535},
{338,594,978,65535,65535,65535},
{339,595,979,65535,65535,65535},
{340,596,980,65535,65535,65535},
{341,597,981,65535,65535,65535},
{342,598,982,65535,65535,65535},
{343,599,983,65535,65535,65535},
{344,600,984,65535,65535,65535},
{345,601,985,65535,65535,65535},
{346,602,986,65535,65535,65535},
{347,603,987,65535,65535,65535},
{348,604,988,65535,65535,65535},
{349,605,989,65535,65535,65535},
{350,606,990,65535,65535,65535},
{351,607,991,65535,65535,65535},
{384,512,992,65535,65535,65535},
{385,513,993,65535,65535,65535},
{386,514,994,65535,65535,65535},
{387,515,995,65535,65535,65535},
{388,516,996,65535,65535,65535},
{389,517,997,65535,65535,65535},
{390,518,998,65535,65535,65535},
{391,519,999,65535,65535,65535},
{392,520,1000,65535,65535,65535},
{393,521,1001,65535,65535,65535},
{394,522,1002,65535,65535,65535},
{395,523,1003,65535,65535,65535},
{396,524,1004,65535,65535,65535},
{397,525,1005,65535,65535,65535},
{398,526,1006,65535,65535,65535},
{399,527,1007,65535,65535,65535},
{400,528,1024,1472,65535,65535},
{401,529,1025,1473,65535,65535},
{402,530,1026,1474,65535,65535},
{403,531,1027,1475,65535,65535},
{404,532,1028,1476,65535,65535},
{405,533,1029,1477,65535,65535},
{406,534,1030,1478,65535,65535},
{407,535,1031,1479,65535,65535},
{408,536,1032,1480,65535,65535},
{409,537,1033,1481,65535,65535},
{410,538,1034,1482,65535,65535},
{411,539,1035,1483,65535,65535},
{412,540,1036,1484,65535,65535},
{413,541,1037,1485,65535,65535},
{414,542,1038,1486,65535,65535},
{415,543,1039,1487,65535,65535},
{416,544,1040,1488,65535,65535},
{417,545,1041,1489,65535,65535},
{418,546,1042,1490,65535,65535},
{419,547,1043,1491,65535,65535},
{420,548,1044,1492,65535,65535},
{421,549,1045,1493,65535,65535},
{422,550,1046,1494,65535,65535},
{423,551,1047,1495,65535,65535},
{424,552,1048,1496,65535,65535},
{425,553,1049,1497,65535,65535},
{426,554,1050,1498,65535,65535},
{427,555,1051,1499,65535,65535},
{428,556,1052,1500,65535,65535},
{429,557,1053,1501,65535,65535},
{430,558,1054,1502,65535,65535},
{431,559,1055,1503,65535,65535},
{448,464,1088,1312,65535,65535},
{449,465,1089,1313,65535,65535},
{450,466,1090,1314,65535,65535},
{451,467,1091,1315,65535,65535},
{452,468,1092,1316,65535,65535},
{453,469,1093,1317,65535,65535},
{454,470,1094,1318,65535,65535},
{455,471,1095,1319,65535,65535},
{456,472,1096,1320,65535,65535},
{457,473,1097,1321,65535,65535},
{458,474,1098,1322,65535,65535},
{459,475,1099,1323,65535,65535},
{460,476,1100,1324,65535,65535},
{461,477,1101,1325,65535,65535},
{462,478,1102,1326,65535,65535},
{463,479,1103,1327,65535,65535}
};

static_assert(LUTA_N == 2240 && LUTB_N == 384, "table sizes vs the MISC map");
__device__ __forceinline__ int t5_bucket(int n) {
    if (n < 16) return n < 0 ? 0 : n;
    int b = 16;
    b += n >= 22; b += n >= 30; b += n >= 40; b += n >= 54; b += n >= 73; b += n >= 99; b += n >= 134; b += n >= 182; b += n >= 246; b += n >= 332; b += n >= 450; b += n >= 609; b += n >= 825; b += n >= 1117; b += n >= 1513;
    return b;
}
__device__ __forceinline__ void build_luts(const Params& p, int tid) {
    float* misc = (float*)(p.ws + WS_MISC); const float* rb = p.in[13];
    for (int i = blockIdx.x * NTHR + tid; i < 2 * D * 8; i += gridDim.x * NTHR) { const int l = i >> 13, d = (i >> 3) & 1023, e = i & 7; misc[MI_WF + i] = e < 6 ? p.in[6][(size_t)l * D * NIN + (size_t)d * NIN + 6144 + e] : 0.f; }
    for (int i = blockIdx.x * NTHR + tid; i < 8 * LUTA_N + 18 * LUTB_N; i += gridDim.x * NTHR) {
        if (i < 8 * LUTA_N) { const int hm = i / LUTA_N, j = i % LUTA_N, d = 2047 - j; misc[MI_LUTA + i] = d >= 0 ? rb[t5_bucket(d) * 26 + hm] * LOG2E : -INFINITY; }
        else { const int k = i - 8 * LUTA_N, gh = k / LUTB_N, j = k % LUTB_N, ii = 255 - j, g = gh / 6; misc[MI_LUTB + k] = (ii >= 0 && ii <= 128) ? rb[t5_bucket(ii << (2 * g)) * 26 + 8 + gh] * LOG2E : -INFINITY; }
    }
}
__device__ __forceinline__ void norm_logf(const Params& p, int L, const float* x, const float* g, const float* sc, const float* sh, bf16_t* h, LAS unsigned char* lds, int tid, int lane, int wave) {
    LAS float* wf = (LAS float*)lds;
    const float* w_in = p.in[6] + (size_t)L * D * NIN;
    { const float* src = (const float*)(p.ws + WS_MISC) + MI_WF + L * D * 8; f32x4 tv[4];
#pragma unroll
      for (int k = 0; k < 4; ++k) tv[k] = *(const GAS f32x4*)(src + (tid + k * NTHR) * 4);
#pragma unroll
      for (int k = 0; k < 4; ++k) *(LAS f32x4*)(wf + (tid + k * NTHR) * 4) = tv[k]; }
    (void)w_in;
    __syncthreads();
    const int gw = blockIdx.x * NWAVES + wave, NGW = gridDim.x * NWAVES;
    float* logf = (float*)(p.ws + WS_MISC) + MI_LOGF;
    const float bfv = lane < 6 ? p.in[7][L * 6 + lane] : 0.f;
    f32x4 vn[4], vm[4];
    { const int tf = (gw < T) ? gw : 0, tg = (gw + NGW < T) ? gw + NGW : tf; const GAS f32x4* xn = (const GAS f32x4*)(x + (size_t)tf * D) + lane; const GAS f32x4* xm = (const GAS f32x4*)(x + (size_t)tg * D) + lane;
#pragma unroll
      for (int j = 0; j < 4; ++j) { vn[j] = xn[64 * j]; vm[j] = xm[64 * j]; } }
    constexpr int TEND = T;
    for (int t = gw; t < T; t += NGW) {
        const int b = t >> 11;
        f32x4 v[4]; float s = 0.f;
#pragma unroll
        for (int j = 0; j < 4; ++j) { v[j] = vn[j]; vn[j] = vm[j]; s += (v[j].x * v[j].x + v[j].y * v[j].y) + (v[j].z * v[j].z + v[j].w * v[j].w); }
        { const int tn = (t + 2 * NGW < TEND) ? t + 2 * NGW : t; const GAS f32x4* xn = (const GAS f32x4*)(x + (size_t)tn * D) + lane;
#pragma unroll
          for (int j = 0; j < 4; ++j) vm[j] = xn[64 * j]; }
        const float r = 1.0f / sqrtf(wave_sum(s) * (1.0f / D) + EPS);
        GAS v2u* o8 = (GAS v2u*)(h + (size_t)t * D) + lane;
        float lg[8];
#pragma unroll
        for (int e = 0; e < 8; ++e) lg[e] = 0.f;
#pragma unroll
        for (int j = 0; j < 4; ++j) { const int d = 4 * lane + 256 * j;
            const f32x4 g4 = *(const f32x4*)(g + d), c4 = *(const f32x4*)(sc + (size_t)b * 6 * D + d), h4 = *(const f32x4*)(sh + (size_t)b * 6 * D + d);
            const f32x4 o = v[j] * r * g4 * (c4 + 1.0f) + h4;
            v2u w; w.x = pk2(o.x, o.y); w.y = pk2(o.z, o.w); o8[64 * j] = w;
#pragma unroll
            for (int cc = 0; cc < 4; ++cc) { const f32x4 w0 = *(const LAS f32x4*)(wf + (d + cc) * 8), w1 = *(const LAS f32x4*)(wf + (d + cc) * 8 + 4); const float ov = o[cc];
                lg[0] += ov * w0.x; lg[1] += ov * w0.y; lg[2] += ov * w0.z; lg[3] += ov * w0.w; lg[4] += ov * w1.x; lg[5] += ov * w1.y; } }
        float mine = 0.f;
#pragma unroll
        for (int e = 0; e < 6; ++e) { const float sm = wave_sum(lg[e]); if (lane == e) mine = sm; }
        if (lane < 6) { const float z = mine + bfv; logf[(size_t)t * 8 + lane] = fminf(z, 0.f) - log1pf(__expf(-fabsf(z))); }
    }
}
__device__ __forceinline__ void negf_cumsum(const Params& p, int b, int hh, int lane) {
    const float* logf = (const float*)(p.ws + WS_MISC) + MI_LOGF + (size_t)b * S * 8 + hh;
    float* nf = (float*)(p.ws + WS_MISC) + MI_NEGF + (size_t)(b * 6 + hh) * S;
    float run = 0.f; float loc[32];
#pragma unroll
    for (int i = 0; i < 32; ++i) { run += logf[(size_t)(lane * 32 + i) * 8]; loc[i] = run; }
    float incl = run;
#pragma unroll
    for (int o = 1; o < 64; o <<= 1) { const float u = __shfl_up(incl, o); if (lane >= o) incl += u; }
    const float excl = incl - run;
#pragma unroll
    for (int i = 0; i < 32; ++i) nf[lane * 32 + i] = -(excl + loc[i]) * LOG2E;
}
__device__ __forceinline__ void merge_b(const Params& p, bf16_t* qo, int lane, int wave) {
    bf16_t* proj = qo; const float* lse = (const float*)(p.ws + WS_MISC) + MI_LSE;
    const int gw = blockIdx.x * NWAVES + wave, NGW = gridDim.x * NWAVES;
    for (int r = gw; r < CH_T; r += NGW) {
        if (lane < 48) {
            const int t = r & 2047, base = r & ~2047, h = lane >> 3;
            const int r1 = base | ((t & 3) << 9) | (t >> 2), r2 = base | ((t & 15) << 7) | (t >> 4);
            const float l0 = lse[(size_t)r * 8 + h], l1 = lse[(size_t)(CH_T + r1) * 8 + h], l2 = lse[(size_t)(2 * CH_T + r2) * 8 + h];
            const float mx = fmaxf(l0, fmaxf(l1, l2));
            float a0 = __builtin_amdgcn_exp2f(l0 - mx), a1 = __builtin_amdgcn_exp2f(l1 - mx), a2 = __builtin_amdgcn_exp2f(l2 - mx);
            const float is = 1.0f / (a0 + a1 + a2); a0 *= is; a1 *= is; a2 *= is;
            const v4u o0 = *(const GAS v4u*)(proj + (size_t)r * QP + 512 + lane * 8), o1 = *(const GAS v4u*)(proj + (size_t)r1 * QP + 512 + 384 + lane * 8), o2 = *(const GAS v4u*)(proj + (size_t)r2 * QP + 512 + 768 + lane * 8);
            v4u w;
            w.x = pk2(a0 * pg8::bf_lo(o0.x) + a1 * pg8::bf_lo(o1.x) + a2 * pg8::bf_lo(o2.x), a0 * pg8::bf_hi(o0.x) + a1 * pg8::bf_hi(o1.x) + a2 * pg8::bf_hi(o2.x));
            w.y = pk2(a0 * pg8::bf_lo(o0.y) + a1 * pg8::bf_lo(o1.y) + a2 * pg8::bf_lo(o2.y), a0 * pg8::bf_hi(o0.y) + a1 * pg8::bf_hi(o1.y) + a2 * pg8::bf_hi(o2.y));
            w.z = pk2(a0 * pg8::bf_lo(o0.z) + a1 * pg8::bf_lo(o1.z) + a2 * pg8::bf_lo(o2.z), a0 * pg8::bf_hi(o0.z) + a1 * pg8::bf_hi(o1.z) + a2 * pg8::bf_hi(o2.z));
            w.w = pk2(a0 * pg8::bf_lo(o0.w) + a1 * pg8::bf_lo(o1.w) + a2 * pg8::bf_lo(o2.w), a0 * pg8::bf_hi(o0.w) + a1 * pg8::bf_hi(o1.w) + a2 * pg8::bf_hi(o2.w));
            *(GAS v4u*)(proj + (size_t)r * QP + 512 + lane * 8) = w;
        }
    }
}
__device__ __forceinline__ void attn_b_phase(const Params& p, bf16_t* qo, LAS unsigned char* lds, int tid, int lane, int wave) {
    const float* misc = (const float*)(p.ws + WS_MISC);
    for (int L = blockIdx.x; L < CH_B * 3 * 6 * 8; L += gridDim.x) {
        const int blk = L & 7, h = (L >> 3) % 6; int g, b; if (L < 768) { g = (L / 48) & 1; b = L / 96; } else { g = 2; b = (L - 768) / 48; }
        AttnArgs a; a.q0 = blk * 256; a.q = qo + (size_t)(b * S) * QP + 512 + g * 384 + h * 64;
        a.k = (const bf16_t*)(p.ws + WS_KV) + KVB0 + (size_t)(((b * 3 + g) * 6 + h) * 2) * (2048 * 64); a.v = a.k + 2048 * 64;
        a.tab = misc + MI_LUTB + (g * 6 + h) * LUTB_N; a.seqM = S >> (2 * g); a.lse = (float*)(p.ws + WS_MISC) + MI_LSE + ((size_t)g * CH_T + (size_t)b * S) * 8 + h; a.lam = 0.f; a.osc = 0.f; a.subg = nullptr;
        attn_unit<2>(a, lds, tid, lane, wave);
    }
}
__device__ __forceinline__ void attn_ac_phase(const Params& p, int L, int c, bf16_t* qo, LAS unsigned char* lds, int tid, int lane, int wave) {
    const float* misc = (const float*)(p.ws + WS_MISC);
    constexpr unsigned char CTYPE[24] = {0,0,0,0,0,0,1,0,1,0,0,1,0,1,0,1,0,0,1,0,1,0,1,0}, CQB[24] = {15,14,13,12,11,10,7,9,6,8,7,5,6,4,5,3,4,3,2,2,1,1,0,0};
    constexpr unsigned short CFIRST[25] = {0,32,64,96,128,160,192,240,272,320,352,384,432,464,512,544,592,624,656,704,736,784,816,864,896};
    const bool lpt = gridDim.x == 256;
#pragma unroll 1
    for (int i = 0; ; ++i) {
        int cls, k;
        if (lpt) { if (i >= 6) break; const unsigned e = SCHED_AC[blockIdx.x][i]; if (e == 0xFFFFu) break; cls = (int)(e >> 6); k = (int)(e & 63u); }
        else { const int j = i * (int)gridDim.x + (int)blockIdx.x; if (j >= 896) break; cls = 0; for (int q = 1; q < 24; ++q) if ((int)CFIRST[q] <= j) cls = q; k = j - (int)CFIRST[cls]; }
        cls = __builtin_amdgcn_readfirstlane(cls); k = __builtin_amdgcn_readfirstlane(k);
        if (CTYPE[cls] != 0) continue;
        const int qb = CQB[cls], b = k >> 2, h = k & 3;
        AttnArgs a; a.seqM = 0; a.lse = nullptr; a.q0 = qb * 128; a.q = qo + (size_t)(b * S) * QP + h * 128;
        a.k = (const bf16_t*)(p.ws + WS_KV) + (size_t)((b * 4 + h) * 2) * (2048 * 128); a.v = a.k + 2048 * 128;
        a.tab = misc + MI_LUTA + 2 * h * LUTA_N; a.lam = misc[MI_LAM + L]; a.osc = 1.0f - misc[MI_LAM + 8 + L]; a.subg = p.in[12] + L * 128;
        attn_unit<0>(a, lds, tid, lane, wave);
    }
#pragma unroll 1
    for (int i = 0; ; ++i) {
        int cls, k;
        if (lpt) { if (i >= 6) break; const unsigned e = SCHED_AC[blockIdx.x][i]; if (e == 0xFFFFu) break; cls = (int)(e >> 6); k = (int)(e & 63u); }
        else { const int j = i * (int)gridDim.x + (int)blockIdx.x; if (j >= 896) break; cls = 0; for (int q = 1; q < 24; ++q) if ((int)CFIRST[q] <= j) cls = q; k = j - (int)CFIRST[cls]; }
        cls = __builtin_amdgcn_readfirstlane(cls); k = __builtin_amdgcn_readfirstlane(k);
        if (CTYPE[cls] != 1) continue;
        const int qb = CQB[cls], b = k / 6, h = k % 6;
        AttnArgs a; a.seqM = 0; a.lse = nullptr; a.q0 = qb * 256; a.q = qo + (size_t)(b * S) * QP + 1664 + h * 64;
        a.k = (const bf16_t*)(p.ws + WS_KV) + KVC0 + (size_t)((b * 6 + h) * 2) * (2048 * 64); a.v = a.k + 2048 * 64;
        a.tab = misc + MI_NEGF + (size_t)((c * CH_B + b) * 6 + h) * S; a.lam = 0.f; a.osc = 0.f; a.subg = nullptr;
        attn_unit<1>(a, lds, tid, lane, wave);
    }
    merge_b(p, qo, lane, wave);
}

constexpr int RT_WR = 0, RT_CNT = D * NE * 4, RT_REC = RT_CNT + 64, RT_RECW = 64;
__device__ __forceinline__ void norm_route(const Params& p, const float* g, const float* sc, const float* sh, bf16_t* h, LAS unsigned char* lds, int tid, int lane, int wave) {
    LAS float* wr = (LAS float*)(lds + RT_WR); LAS unsigned* lcnt = (LAS unsigned*)(lds + RT_CNT); LAS unsigned* lbase = lcnt + 8;
    LAS int* rec = (LAS int*)(lds + RT_REC) + wave * (RT_RECW * 8);
    { f32x4 tv[4];
#pragma unroll
      for (int k = 0; k < 4; ++k) tv[k] = *(const GAS f32x4*)(p.in[21] + (tid + k * NTHR) * 4);
#pragma unroll
      for (int k = 0; k < 4; ++k) *(LAS f32x4*)(wr + (tid + k * NTHR) * 4) = tv[k]; }
    if (tid < 16) lcnt[tid] = 0u;
    __syncthreads();
    const int gw = blockIdx.x * NWAVES + wave, NGW = gridDim.x * NWAVES;
    const float* x = p.out;
    int k = 0;
    f32x4 vn[4], vm[4];
    { const int tf = (gw < T) ? gw : 0, tg = (gw + NGW < T) ? gw + NGW : tf; const GAS f32x4* xn = (const GAS f32x4*)(x + (size_t)tf * D) + lane; const GAS f32x4* xm = (const GAS f32x4*)(x + (size_t)tg * D) + lane;
#pragma unroll
      for (int j = 0; j < 4; ++j) { vn[j] = xn[64 * j]; vm[j] = xm[64 * j]; } }
    constexpr int TEND = T;
    for (int t = gw; t < T && k < RT_RECW; t += NGW, ++k) {
        const int b = t >> 11;
        f32x4 v[4]; float s = 0.f;
#pragma unroll
        for (int j = 0; j < 4; ++j) { v[j] = vn[j]; vn[j] = vm[j]; s += (v[j].x * v[j].x + v[j].y * v[j].y) + (v[j].z * v[j].z + v[j].w * v[j].w); }
        { const int tn = (t + 2 * NGW < TEND) ? t + 2 * NGW : t; const GAS f32x4* xn = (const GAS f32x4*)(x + (size_t)tn * D) + lane;
#pragma unroll
          for (int j = 0; j < 4; ++j) vm[j] = xn[64 * j]; }
        const float r = 1.0f / sqrtf(wave_sum(s) * (1.0f / D) + EPS);
        GAS v2u* o8 = (GAS v2u*)(h + (size_t)t * D) + lane;
        float lg[NE];
#pragma unroll
        for (int e = 0; e < NE; ++e) lg[e] = 0.f;
#pragma unroll
        for (int j = 0; j < 4; ++j) { const int d = 4 * lane + 256 * j;
            const f32x4 g4 = *(const f32x4*)(g + d), c4 = *(const f32x4*)(sc + (size_t)b * 6 * D + d), h4 = *(const f32x4*)(sh + (size_t)b * 6 * D + d);
            const f32x4 o = v[j] * r * g4 * (c4 + 1.0f) + h4;
            v2u w; w.x = pk2(o.x, o.y); w.y = pk2(o.z, o.w); o8[64 * j] = w;
#pragma unroll
            for (int cc = 0; cc < 4; ++cc) { const f32x4 w0 = *(const LAS f32x4*)(wr + (d + cc) * NE), w1 = *(const LAS f32x4*)(wr + (d + cc) * NE + 4); const float ov = o[cc];
                lg[0] += ov * w0.x; lg[1] += ov * w0.y; lg[2] += ov * w0.z; lg[3] += ov * w0.w; lg[4] += ov * w1.x; lg[5] += ov * w1.y; lg[6] += ov * w1.z; lg[7] += ov * w1.w; } }
#pragma unroll
        for (int e = 0; e < NE; ++e) lg[e] = wave_sum(lg[e]);
        if (lane == 0) {
            int e0 = 0; float v0 = lg[0];
#pragma unroll
            for (int e = 1; e < NE; ++e) if (lg[e] > v0) { v0 = lg[e]; e0 = e; }
            int e1 = e0 == 0 ? 1 : 0; float v1 = lg[e1];
#pragma unroll
            for (int e = 0; e < NE; ++e) if (e != e0 && lg[e] > v1) { v1 = lg[e]; e1 = e; }
            const float w1 = 1.0f / (1.0f + __expf(v0 - v1)), w0 = 1.0f - w1;
            const unsigned lp0 = __hip_atomic_fetch_add(lcnt + e0, 1u, __ATOMIC_RELAXED, __HIP_MEMORY_SCOPE_WORKGROUP), lp1 = __hip_atomic_fetch_add(lcnt + e1, 1u, __ATOMIC_RELAXED, __HIP_MEMORY_SCOPE_WORKGROUP);
            LAS int* rc = rec + k * 8; rc[0] = t; rc[1] = e0; rc[2] = e1; rc[3] = (int)lp0; rc[4] = (int)lp1; rc[5] = (int)__float_as_uint(w0); rc[6] = (int)__float_as_uint(w1);
        }
    }
    __syncthreads();
    unsigned* ctl = (unsigned*)(p.ws + WS_CTL);
    if (tid < NE) lbase[tid] = __hip_atomic_fetch_add(ctl + CW_CNT + tid, lcnt[tid], __ATOMIC_RELAXED, __HIP_MEMORY_SCOPE_AGENT);
    __syncthreads();
    unsigned* misc = (unsigned*)(p.ws + WS_MISC);
    if (lane < k) { const LAS int* rc = rec + lane * 8; const int t = rc[0], e0 = rc[1], e1 = rc[2];
        misc[MI_TOK_E + 2 * t] = (unsigned)e0; misc[MI_TOK_E + 2 * t + 1] = (unsigned)e1;
        misc[MI_TOK_POS + 2 * t] = lbase[e0] + (unsigned)rc[3]; misc[MI_TOK_POS + 2 * t + 1] = lbase[e1] + (unsigned)rc[4];
        misc[MI_TOK_W + 2 * t] = (unsigned)rc[5]; misc[MI_TOK_W + 2 * t + 1] = (unsigned)rc[6]; }
}
__device__ __forceinline__ void moe_scan_gather(const Params& p, LAS unsigned char* lds, int tid, int lane, int wave) {
    LAS unsigned* sseg = (LAS unsigned*)lds;
    unsigned* ctl = (unsigned*)(p.ws + WS_CTL); unsigned* misc = (unsigned*)(p.ws + WS_MISC);
    if (tid == 0) { unsigned a = 0u;
        for (int e = 0; e < NE; ++e) { const unsigned c = __hip_atomic_load(ctl + CW_CNT + e, __ATOMIC_RELAXED, __HIP_MEMORY_SCOPE_AGENT); sseg[e] = a; sseg[16 + e] = c; a += (c + 255u) & ~255u; }
        sseg[8] = a; }
    __syncthreads();
    const unsigned ntile = sseg[8] >> 8;
    if (blockIdx.x == 0) {
        if (tid < MOE_MAXT) { unsigned e = 0u; for (int q = 1; q < NE; ++q) if (sseg[q] <= 256u * (unsigned)tid) e = (unsigned)q; misc[MI_TILE_E + tid] = e; }
        if (tid == 0) misc[MI_TILE_E + 500] = ntile;
    }
    const bf16_t* h = (const bf16_t*)(p.ws + WS_H); bf16_t* hs = (bf16_t*)(p.ws + WS_HS);
    const int gw = blockIdx.x * NWAVES + wave, NGW = gridDim.x * NWAVES;
    const int nk = (T - gw + NGW - 1) / NGW;
    unsigned mr0 = 0u, mr1 = 0u;
    if (lane < nk) { const int t = gw + lane * NGW;
        const v2u ee = *(const GAS v2u*)(misc + MI_TOK_E + 2 * t), pp = *(const GAS v2u*)(misc + MI_TOK_POS + 2 * t), ww = *(const GAS v2u*)(misc + MI_TOK_W + 2 * t);
        mr0 = sseg[ee.x] + pp.x; mr1 = sseg[ee.y] + pp.y;
        misc[MI_ROW_W + mr0] = ww.x; misc[MI_ROW_W + mr1] = ww.y;
        v2u rr; rr.x = mr0; rr.y = mr1; *(GAS v2u*)(misc + MI_TOK_POS + 2 * t) = rr; }
    for (int k0 = 0; k0 < nk; k0 += 8) {
        v4u a[8], c[8];
#pragma unroll
        for (int i = 0; i < 8; ++i) { const int k = k0 + i < nk ? k0 + i : nk - 1; const int t = gw + k * NGW;
            a[i] = *(const GAS v4u*)(h + (size_t)t * D + lane * 8); c[i] = *(const GAS v4u*)(h + (size_t)t * D + 512 + lane * 8); }
#pragma unroll
        for (int i = 0; i < 8; ++i) { if (k0 + i < nk) { const unsigned r0 = (unsigned)__shfl((int)mr0, k0 + i), r1 = (unsigned)__shfl((int)mr1, k0 + i);
            *(GAS v4u*)(hs + (size_t)r0 * D + lane * 8) = a[i]; *(GAS v4u*)(hs + (size_t)r0 * D + 512 + lane * 8) = c[i];
            *(GAS v4u*)(hs + (size_t)r1 * D + lane * 8) = a[i]; *(GAS v4u*)(hs + (size_t)r1 * D + 512 + lane * 8) = c[i]; } }
    }
    if (blockIdx.x < NE) {
        const unsigned e = blockIdx.x, p0 = sseg[e] + sseg[16 + e], p1 = sseg[e + 1];
        for (unsigned r = p0 + (unsigned)wave; r < p1; r += NWAVES) { const v4u z = {0u, 0u, 0u, 0u};
            *(GAS v4u*)(hs + (size_t)r * D + lane * 8) = z; *(GAS v4u*)(hs + (size_t)r * D + 512 + lane * 8) = z; if (lane == 0) misc[MI_ROW_W + r] = 0u; }
    }
}
struct GroupedOrder {
    const unsigned* tile_e; int t0, t1, nN, G, c, a_pm_off; size_t bstride;
    __device__ __forceinline__ bool next(int i, pg8::Unit& u) const {
        const long L = (long)i * G + c; if (L >= (long)(t1 - t0) * nN) return false;
        u.pm = t0 + (int)(L / nN); u.pn = (int)(L % nN); u.e = __builtin_amdgcn_readfirstlane((int)tile_e[u.pm]); u.aux = 0; return true;
    }
    __device__ __forceinline__ const char* a_ptr(const pg8::Gemm& g, const pg8::Unit& u) const { return (const char*)g.A + (size_t)(u.pm - a_pm_off) * (size_t)(pg8::BM * 2) * g.lda; }
    __device__ __forceinline__ const char* b_ptr(const pg8::Gemm& g, const pg8::Unit& u) const { return (const char*)g.Bt + ((size_t)u.e * bstride + (size_t)u.pn * pg8::BM * g.K) * 2; }
    __device__ __forceinline__ int kt(const pg8::Gemm& g, const pg8::Unit&) const { return g.K / pg8::BK; }
    __device__ __forceinline__ bool last_seg(const pg8::Unit&) const { return true; }
    __device__ __forceinline__ void a_ready(const pg8::Unit&) const {}
    __device__ __forceinline__ void done(const pg8::Unit&) const {}
};
__device__ __forceinline__ void moe_combine_final(const Params& p, const float* g2, int lane, int wave) {
    const unsigned* misc = (const unsigned*)(p.ws + WS_MISC); const bf16_t* y = (const bf16_t*)(p.ws + WS_HS);
    const int gw = blockIdx.x * NWAVES + wave, NGW = gridDim.x * NWAVES;
    const int nk = (T - gw + NGW - 1) / NGW;
    unsigned mr0 = 0u, mr1 = 0u;
    if (lane < nk) { const v2u rr = *(const GAS v2u*)(misc + MI_TOK_POS + 2 * (gw + lane * NGW)); mr0 = rr.x; mr1 = rr.y; }
    f32x4 xv[4]; v2u ya[4], yc[4];
#define CMB_LOAD(k_) do { const int t_ = gw + (k_) * NGW; const unsigned r0_ = (unsigned)__shfl((int)mr0, (k_)), r1_ = (unsigned)__shfl((int)mr1, (k_)); \
        _Pragma("unroll") for (int j = 0; j < 4; ++j) { const int d = 4 * lane + 256 * j; xv[j] = *(const GAS f32x4*)(p.out + (size_t)t_ * D + d); \
            ya[j] = *(const GAS v2u*)(y + (size_t)r0_ * D + d); yc[j] = *(const GAS v2u*)(y + (size_t)r1_ * D + d); } } while (0)
    if (nk > 0) CMB_LOAD(0);
    for (int k = 0; k < nk; ++k) {
        const int t = gw + k * NGW, b = t >> 11;
        GAS f32x4* xr = (GAS f32x4*)(p.out + (size_t)t * D) + lane;
        f32x4 v[4]; float s = 0.f;
#pragma unroll
        for (int j = 0; j < 4; ++j) { const int d = 4 * lane + 256 * j; const v2u a = ya[j], c = yc[j];
            f32x4 fa, fc; fa.x = __uint_as_float(a.x << 16); fa.y = __uint_as_float(a.x & 0xffff0000u); fa.z = __uint_as_float(a.y << 16); fa.w = __uint_as_float(a.y & 0xffff0000u);
            fc.x = __uint_as_float(c.x << 16); fc.y = __uint_as_float(c.x & 0xffff0000u); fc.z = __uint_as_float(c.y << 16); fc.w = __uint_as_float(c.y & 0xffff0000u);
            const f32x4 g4 = *(const f32x4*)(g2 + (size_t)b * 6 * D + d);
            v[j] = xv[j] + g4 * (fa + fc); s += (v[j].x * v[j].x + v[j].y * v[j].y) + (v[j].z * v[j].z + v[j].w * v[j].w); }
        if (k + 1 < nk) CMB_LOAD(k + 1);
        const float r = 1.0f / sqrtf(wave_sum(s) * (1.0f / D) + EPS);
#pragma unroll
        for (int j = 0; j < 4; ++j) { const f32x4 f4 = *(const f32x4*)(p.in[25] + 4 * lane + 256 * j); xr[64 * j] = v[j] * r * f4; }
    }
#undef CMB_LOAD
}

#ifdef PROBE_CATS
#ifndef PROBE_MULT
#define PROBE_MULT 4
#endif
struct Probe { int unused; };
__device__ __forceinline__ int step_cat(int id) {
    if (id == 0) return 0;
    const int l = (id - 1) / LSTEPS, o = (id - 1) % LSTEPS;
    if (o == 0) return 1; if (o <= 10) return 2 + (o - 1) % 5; if (o == 11) return l == 0 ? 7 : 10;
    if (l == 0) return o == 12 ? 8 : 9;
    if (o == 12) return 11; if (o == 21) return 14; return (o & 1) ? 12 : 13;
}
__device__ __forceinline__ bool probe_tick_lds(LAS unsigned char* lds, int id) {
    int t_ = threadIdx.x; asm volatile("" : "+v"(t_));
    if (blockIdx.x == 0 && t_ == 0) {
        volatile LAS unsigned long long* q = (volatile LAS unsigned long long*)(lds + LDSCTL_OFF + 64);
        const unsigned long long now = __builtin_amdgcn_s_memrealtime();
        if (q[2]) q[1] += now - q[0];
        q[0] = now; q[2] = ((id >= 0) && ((PROBE_CATS >> step_cat(id)) & 1)) ? 1ull : 0ull;
    }
    return true;
}
#define probe_tick(pr, id) probe_tick_lds(lds, (id))
#else
struct Probe { int unused; };
__device__ __forceinline__ bool probe_tick(Probe&, int) { return true; }
#endif
#define STEP(id) if (p0.lo <= (id) && (id) < p0.hi && (first ? (first = false, true) : (xcd_barrier(bar), true)) && probe_tick(pr, (id)))
#define IDS const Params p = load_params(); int tid = threadIdx.x; asm volatile("" : "+v"(tid)); const int lane = tid & 63, wave = __builtin_amdgcn_readfirstlane(tid >> 6); (void)lane; (void)wave; const int G = gridDim.x, NGW = G * NWAVES; (void)NGW; unsigned char* ws = p.ws; const float* mod_ = (const float*)(ws + WS_MOD); (void)mod_;
template <int L> __device__ __forceinline__ void layer_steps(const Params& p0, LAS unsigned char* lds, const XcdBarrier& bar, bool& first, Probe& pr) {
    constexpr int sb = ST_L0 + L * LSTEPS;
#define QO_(c) ((bf16_t*)(ws + ((c) == 0 ? WS_QO : WS_QO1)))
#define GT_(c) ((bf16_t*)(ws + ((c) == 0 ? WS_GATE : WS_GATE1)))
#define HC_(c) ((bf16_t*)(ws + WS_H) + (size_t)(c) * CH_T * D)
#define INPROJ(c) do { if (blockIdx.x < CH_B * 6 && wave == 0) negf_cumsum(p, (c) * CH_B + (int)blockIdx.x / 6, (int)blockIdx.x % 6, lane); \
        pg8::Gemm g{HC_(c), (const bf16_t*)(ws + WS_WIN) + (size_t)L * NP * D, CH_T, NP, D, D, D}; pg8::StaticOrder S; S.init(CH_T, NP, G, (int)blockIdx.x); \
        pg8::EpiInProj E{QO_(c), (bf16_t*)(ws + WS_KV), GT_(c)}; \
        pg8::gemm_phase<pg8::EpiInProj, pg8::StaticOrder, true, true>(lds, g, S, E); } while (0)
#define MERGE(c) do { const bf16_t* wbr = (const bf16_t*)(ws + WS_WBR) + (size_t)L * 1280 * D; \
        pg8::SegOrder S; S.init(CH_T, D, G, (int)blockIdx.x); \
        pg8::Gemm g{QO_(c), wbr, CH_T, D, 1280, 2048, 1280}; pg8::EpiMergeS E{GT_(c), HC_(c), 3072}; \
        pg8::gemm_phase<pg8::EpiMergeS, pg8::SegOrder, true, true>(lds, g, S, E); } while (0)
#define OUTPROJ(c) do { pg8::Gemm g{HC_(c), (const bf16_t*)(ws + WS_WOUT) + (size_t)L * D * D, CH_T, D, D, D, D}; pg8::StaticOrder S; S.init(CH_T, D, G, (int)blockIdx.x); \
        pg8::EpiResid E{L == 0 ? p.in[0] : p.out, p.out, (mod_ + (size_t)L * NB * 6 * D) + 2 * D, (c) * CH_T}; \
        pg8::gemm_phase<pg8::EpiResid, pg8::StaticOrder, true, true>(lds, g, S, E); } while (0)
    STEP(sb + 0) { IDS norm_logf(p, L, L == 0 ? p.in[0] : p.out, p.in[2] + L * D, (mod_ + (size_t)L * NB * 6 * D) + D, (mod_ + (size_t)L * NB * 6 * D), (bf16_t*)(ws + WS_H), lds, tid, lane, wave); }
    STEP(sb + 1) { IDS INPROJ(0); }
    STEP(sb + 2) { IDS attn_b_phase(p, QO_(0), lds, tid, lane, wave); }
    STEP(sb + 3) { IDS attn_ac_phase(p, L, 0, QO_(0), lds, tid, lane, wave); }
    STEP(sb + 4) { IDS MERGE(0); INPROJ(1); }
    STEP(sb + 5) { IDS OUTPROJ(0); attn_b_phase(p, QO_(1), lds, tid, lane, wave); }
    STEP(sb + 6) { IDS attn_ac_phase(p, L, 1, QO_(1), lds, tid, lane, wave); }
    STEP(sb + 7) { IDS MERGE(1); }
    STEP(sb + 8) { IDS OUTPROJ(1); }
#undef INPROJ
#undef MERGE
#undef OUTPROJ
    STEP(sb + SO_NORM2) { IDS
        if constexpr (L == 0) norm_rows(p.out, p.in[3] + L * D, (mod_ + (size_t)L * NB * 6 * D) + 4 * D, (mod_ + (size_t)L * NB * 6 * D) + 3 * D, (bf16_t*)(ws + WS_H), 0, T, (int)blockIdx.x * NWAVES + wave, NGW, lane);
        else { norm_route(p, p.in[3] + L * D, (mod_ + (size_t)L * NB * 6 * D) + 4 * D, (mod_ + (size_t)L * NB * 6 * D) + 3 * D, (bf16_t*)(ws + WS_H), lds, tid, lane, wave); convert_experts(p, lds, tid, lane, wave); }
    }
    if constexpr (L == 0) {
        STEP(sb + SO_FFN) { IDS
            pg8::Gemm g{(const bf16_t*)(ws + WS_H), (const bf16_t*)(ws + WS_WGU0), T, 2 * DFF, D, D, D}; pg8::StaticOrder S; S.init(T, 2 * DFF, G, (int)blockIdx.x);
            pg8::EpiSwiglu E{(bf16_t*)(ws + WS_PROJ), DFF, 0};
            pg8::gemm_phase<pg8::EpiSwiglu, pg8::StaticOrder, true, true>(lds, g, S, E);
        }
        STEP(sb + SO_FFN + 1) { IDS
            pg8::Gemm g{(const bf16_t*)(ws + WS_PROJ), (const bf16_t*)(ws + WS_WD0), T, D, DFF, DFF, DFF}; pg8::StaticOrder S; S.init(T, D, G, (int)blockIdx.x);
            pg8::EpiResid E{p.out, p.out, (mod_ + (size_t)L * NB * 6 * D) + 5 * D, 0};
            pg8::gemm_phase<pg8::EpiResid, pg8::StaticOrder, true, true>(lds, g, S, E);
        }
    } else {
        STEP(sb + SO_FFN) { IDS moe_scan_gather(p, lds, tid, lane, wave); }
#pragma unroll 1
        for (int ch = 0; ch < 4; ++ch) {
            STEP(sb + SO_FFN + 1 + 2 * ch) { IDS const unsigned* misc = (const unsigned*)(ws + WS_MISC);
                const int ntile = (int)misc[MI_TILE_E + 500], t0 = ch * MOE_CH, t1 = ch == 3 ? ntile : (ch + 1) * MOE_CH;
                pg8::Gemm g{(const bf16_t*)(ws + WS_HS), (const bf16_t*)(ws + WS_WGU1), MOE_ROWS, 2 * DFE, D, D, D};
                GroupedOrder S{misc + MI_TILE_E, t0, t1, 2 * DFE / 256, G, (int)blockIdx.x, 0, (size_t)2 * DFE * D};
                pg8::EpiSwiglu E{(bf16_t*)(ws + WS_ACT1), DFE, t0};
                pg8::gemm_phase<pg8::EpiSwiglu, GroupedOrder, true, true>(lds, g, S, E);
            }
            STEP(sb + SO_FFN + 2 + 2 * ch) { IDS const unsigned* misc = (const unsigned*)(ws + WS_MISC);
                const int ntile = (int)misc[MI_TILE_E + 500], t0 = ch * MOE_CH, t1 = ch == 3 ? ntile : (ch + 1) * MOE_CH;
                pg8::Gemm g{(const bf16_t*)(ws + WS_ACT1), (const bf16_t*)(ws + WS_WD1), MOE_ROWS, D, DFE, DFE, DFE};
                GroupedOrder S{misc + MI_TILE_E, t0, t1, D / 256, G, (int)blockIdx.x, t0, (size_t)D * DFE};
                pg8::EpiMoeDown E{(bf16_t*)(ws + WS_HS), (const float*)(misc + MI_ROW_W)};
                pg8::gemm_phase<pg8::EpiMoeDown, GroupedOrder, true, true>(lds, g, S, E);
            }
        }
        STEP(sb + SO_FFN + 9) { IDS moe_combine_final(p, (mod_ + (size_t)L * NB * 6 * D) + 5 * D, lane, wave); }
    }
}

__global__ void __launch_bounds__(NTHR, 2) mk_fwd(Params p0) {
    extern __shared__ __attribute__((aligned(16))) unsigned char lds_raw[];
    LAS unsigned char* lds = (LAS unsigned char*)lds_raw;
    for (int u = threadIdx.x; u < (LDS_BYTES - LDSCTL_OFF) / 4; u += NTHR) ((LAS unsigned*)(lds + LDSCTL_OFF))[u] = 0u;
    __syncthreads();
    const XcdBarrier bar = xcd_barrier_post((unsigned*)(p0.ws + WS_CTL) + CW_BAR + p0.li * XCD_BAR_WORDS, (volatile LAS unsigned*)(lds + MISC_OFF) + 8);
    bool first = true; Probe pr{};
    STEP(ST_PRO) { IDS prologue(p, lds, tid, lane, wave); }
    layer_steps<0>(p0, lds, bar, first, pr);
    layer_steps<1>(p0, lds, bar, first, pr);
#ifdef PROBE_CATS
    probe_tick(pr, -1);
    int t_ = threadIdx.x; asm volatile("" : "+v"(t_));
    if (blockIdx.x == 0 && t_ == 0) { const unsigned long long t1 = __builtin_amdgcn_s_memrealtime(), want = ((volatile LAS unsigned long long*)(lds + LDSCTL_OFF + 64))[1] * PROBE_MULT; while (__builtin_amdgcn_s_memrealtime() - t1 < want) __builtin_amdgcn_s_sleep(32); }
#endif
}
#undef STEP
}

extern "C" void kernel_launch(void* const* d_in, const int* in_sizes, int n_in, void* d_out, int out_size, void* d_ws, size_t ws_size, hipStream_t stream) {
    static int grid = 0;
    if (grid == 0) {
        int dev = 0, cus = 0;
        (void)hipGetDevice(&dev); (void)hipDeviceGetAttribute(&cus, hipDeviceAttributeMultiprocessorCount, dev);
        if (hipFuncSetAttribute((const void*)mk::mk_fwd, hipFuncAttributeMaxDynamicSharedMemorySize, mk::LDS_BYTES) != hipSuccess) fprintf(stderr, "kernel_launch: hipFuncSetAttribute failed\n");
        (void)hipGetLastError();
        grid = cus > 0 ? cus : 256;
        if (ws_size < mk::WS_END) fprintf(stderr, "kernel_launch: workspace too small: %zu < %zu\n", ws_size, (size_t)mk::WS_END);
    }
    (void)in_sizes; (void)n_in; (void)out_size;
    (void)hipMemsetAsync((char*)d_ws + mk::WS_CTL, 0, mk::CTL_ZERO, stream);
    mk::Params p{};
    for (int i = 0; i < 26; ++i) p.in[i] = (const float*)d_in[i];
    p.out = (float*)d_out; p.ws = (unsigned char*)d_ws; p.lo = 0; p.hi = mk::ST_END; p.li = 0; p.pad = 0;
    hipLaunchKernelGGL(mk::mk_fwd, dim3(grid), dim3(mk::NTHR), mk::LDS_BYTES, stream, p);
}
```

```cpp
#include <hip/hip_runtime.h>
#include <cstdint>
#include <cstdio>

namespace pg8 {
#define PG8_LAS __attribute__((address_space(3)))
typedef unsigned short bf16_t;
typedef short bf16x8 __attribute__((ext_vector_type(8)));
typedef float f32x4 __attribute__((ext_vector_type(4)));
typedef unsigned u32x4 __attribute__((ext_vector_type(4)));
constexpr int BM = 256, BK = 64, HALF = 128, HTB = HALF * BK * 2  , STAGE_BYTES = 8 * HTB, NXCD = 8, WGM = 8;

__host__ __device__ __forceinline__ int lds_byte(int r, int c) { const int st = (r >> 4) * 2 + (c >> 5), rr = r & 15, cc = c & 31, ob = rr * 64 + cc * 2; return st * 1024 + (ob ^ (((ob >> 9) & 1) << 5)); }
__host__ __device__ __forceinline__ void stage_rc(int b, int& R, int& C) { const int st = b / 1024, sb = b % 1024, swz = sb ^ (((sb >> 9) & 1) << 5); R = (st >> 1) * 16 + swz / 64; C = (st & 1) * 32 + (swz % 64) / 2; }
__host__ __device__ __forceinline__ int perm32(int rho) { const int n = rho >> 4, i = rho & 15; return 8 * (i >> 2) + 4 * n + (i & 3); }

struct Unit { int pm, pn, e, aux; };
struct Gemm { const bf16_t* A; const bf16_t* Bt; int M, N, K, lda, ldb; };

struct StaticOrder {
    int nM, nN, nwg, G, c;
    __host__ __device__ void init(int M, int N, int G_, int c_) { nM = M / BM; nN = N / BM; nwg = nM * nN; G = G_; c = c_; }
    __host__ __device__ bool next(int i, Unit& u) const {
        const long L = (long)i * G + c; if (L >= nwg) return false;
        int wgid = (int)L; { const int q = nwg / NXCD, r = nwg % NXCD, xcd = wgid % NXCD, off = wgid / NXCD; wgid = (xcd < r ? xcd * (q + 1) : r * (q + 1) + (xcd - r) * q) + off; }
        const int nig = WGM * nN, gid = wgid / nig, fm = gid * WGM, gsz = (nM - fm) < WGM ? (nM - fm) : WGM;
        u.pm = fm + ((wgid % nig) % gsz); u.pn = (wgid % nig) / gsz; u.e = 0; u.aux = 0; return true;
    }
    __device__ __forceinline__ const char* a_ptr(const Gemm& g, const Unit& u) const { return (const char*)g.A + (size_t)u.pm * (size_t)(BM * 2) * g.lda; }
    __device__ __forceinline__ const char* b_ptr(const Gemm& g, const Unit& u) const { return (const char*)g.Bt + (size_t)u.pn * (size_t)(BM * 2) * g.ldb; }
    __device__ __forceinline__ int kt(const Gemm& g, const Unit&) const { return g.K / BK; }
    __device__ __forceinline__ bool last_seg(const Unit&) const { return true; }
    __device__ __forceinline__ void a_ready(const Unit&) const {}
    __device__ __forceinline__ void done(const Unit&) const {}
};

__device__ __forceinline__ unsigned cvt_pk_bf16(float lo, float hi) { unsigned r; asm volatile("v_cvt_pk_bf16_f32 %0, %1, %2" : "=v"(r) : "v"(lo), "v"(hi)); return r; }
typedef float f32x2 __attribute__((ext_vector_type(2)));
__device__ __forceinline__ float silu_f(float z) { return z * __builtin_amdgcn_rcpf(1.0f + __builtin_amdgcn_exp2f(-1.4426950408889634f * z)); }
__device__ __forceinline__ float sigm_f(float z) { return __builtin_amdgcn_rcpf(1.0f + __builtin_amdgcn_exp2f(-1.4426950408889634f * z)); }
struct EpiSwiglu {
    static constexpr bool PERM = true, AFTER_DRAIN = false, SEGMENTED = false;
    bf16_t* O; int ldc; int pm_off;
    __device__ __forceinline__ void operator()(const f32x4 (&acc)[2][2][4][2], const Unit& u, int wr, int wc, int fr, int fq) const {
        const int row0 = (u.pm - pm_off) * BM + wr * 64 + fr, col0 = u.pn * HALF + wc * 32 + 8 * fq;
#pragma unroll
        for (int ai = 0; ai < 2; ++ai)
#pragma unroll
            for (int m = 0; m < 4; ++m) { bf16_t* rowp = O + (size_t)(row0 + ai * HALF + m * 16) * ldc + col0;
                const f32x4 g0 = acc[ai][0][m][0], g1 = acc[ai][0][m][1], u0 = acc[ai][1][m][0], u1 = acc[ai][1][m][1];
                u32x4 w; w.x = cvt_pk_bf16(silu_f(g0[0]) * u0[0], silu_f(g0[1]) * u0[1]); w.y = cvt_pk_bf16(silu_f(g0[2]) * u0[2], silu_f(g0[3]) * u0[3]);
                w.z = cvt_pk_bf16(silu_f(g1[0]) * u1[0], silu_f(g1[1]) * u1[1]); w.w = cvt_pk_bf16(silu_f(g1[2]) * u1[2], silu_f(g1[3]) * u1[3]);
                *(u32x4*)rowp = w; }
    }
};
struct EpiResid {
    static constexpr bool PERM = false, AFTER_DRAIN = false, SEGMENTED = false;
    const float* src; float* dst; const float* gv; int row_off;
    __device__ __forceinline__ void operator()(const f32x4 (&acc)[2][2][4][2], const Unit& u, int wr, int wc, int fr, int fq) const {
        const int rowt = row_off + u.pm * BM, row0 = rowt + wr * 64 + fr, col0 = u.pn * BM + wc * 32 + 4 * fq;
        const float* gp = gv + (size_t)(rowt >> 11) * 6144 + col0;
        f32x4 gg[2][2];
#pragma unroll
        for (int bj = 0; bj < 2; ++bj)
#pragma unroll
            for (int n = 0; n < 2; ++n) gg[bj][n] = *(const f32x4*)(gp + bj * HALF + n * 16);
#pragma unroll
        for (int ai = 0; ai < 2; ++ai) {
            f32x4 sv[4][2][2];
#pragma unroll
            for (int m = 0; m < 4; ++m) { const size_t off = (size_t)(row0 + ai * HALF + m * 16) * 1024 + col0;
#pragma unroll
                for (int bj = 0; bj < 2; ++bj)
#pragma unroll
                    for (int n = 0; n < 2; ++n) sv[m][bj][n] = *(const f32x4*)(src + off + bj * HALF + n * 16); }
            asm volatile("" ::: "memory");
#pragma unroll
            for (int m = 0; m < 4; ++m) { const size_t off = (size_t)(row0 + ai * HALF + m * 16) * 1024 + col0;
#pragma unroll
                for (int bj = 0; bj < 2; ++bj)
#pragma unroll
                    for (int n = 0; n < 2; ++n) *(f32x4*)(dst + off + bj * HALF + n * 16) = sv[m][bj][n] + gg[bj][n] * acc[ai][bj][m][n]; }
            asm volatile("" ::: "memory");
        }
    }
};
struct EpiMoeDown {
    static constexpr bool PERM = true, AFTER_DRAIN = false, SEGMENTED = false;
    bf16_t* O; const float* row_w;
    __device__ __forceinline__ void operator()(const f32x4 (&acc)[2][2][4][2], const Unit& u, int wr, int wc, int fr, int fq) const {
        const int row0 = u.pm * BM + wr * 64 + fr, col0 = u.pn * BM + wc * 32 + 8 * fq;
        float w[2][4];
#pragma unroll
        for (int ai = 0; ai < 2; ++ai)
#pragma unroll
            for (int m = 0; m < 4; ++m) w[ai][m] = row_w[row0 + ai * HALF + m * 16];
#pragma unroll
        for (int ai = 0; ai < 2; ++ai)
#pragma unroll
            for (int m = 0; m < 4; ++m) { bf16_t* rowp = O + (size_t)(row0 + ai * HALF + m * 16) * 1024 + col0; const float ww = w[ai][m];
#pragma unroll
                for (int bj = 0; bj < 2; ++bj) { const f32x4 v0 = acc[ai][bj][m][0] * ww, v1 = acc[ai][bj][m][1] * ww;
                    u32x4 o; o.x = cvt_pk_bf16(v0[0], v0[1]); o.y = cvt_pk_bf16(v0[2], v0[3]); o.z = cvt_pk_bf16(v1[0], v1[1]); o.w = cvt_pk_bf16(v1[2], v1[3]);
                    *(u32x4*)(rowp + bj * HALF) = o; } }
    }
};
struct EpiInProj {
    static constexpr bool PERM = true, AFTER_DRAIN = false, SEGMENTED = false;
    bf16_t* QO; bf16_t* KV; bf16_t* GT;
    __device__ __forceinline__ void operator()(const f32x4 (&acc)[2][2][4][2], const Unit& u, int wr, int wc, int fr, int fq) const {
        const int rowl0 = u.pm * BM + wr * 64 + fr, b = (u.pm * BM) >> 11;
        constexpr float C2 = 0.125f * 1.4426950408889634f;
        constexpr size_t KVB0 = (size_t)8 * 4 * 2 * 2048 * 128, KVC0 = KVB0 + (size_t)8 * 18 * 2 * 2048 * 64;
#pragma unroll
        for (int bj = 0; bj < 2; ++bj) {
            const int hh = 2 * u.pn + bj, c = 32 * wc + 8 * fq; float sc = 1.0f; int s = 0, pitch = 2048; bool sig = false, tokmajor = true; bf16_t* dst;
            if (hh < 4) { dst = QO + 128 * hh + c; sc = C2; }
            else if (hh < 12) { const int kv = hh >= 8, h = hh - (kv ? 8 : 4); dst = KV + (size_t)((b * 4 + h) * 2 + kv) * (2048 * 128) + c; pitch = 128; tokmajor = false; }
            else if (hh < 21) { const int g = (hh - 12) / 3, j = (hh - 12) % 3; dst = QO + 512 + g * 384 + j * 128 + c; s = 2 * g; sc = C2; }
            else if (hh < 39) { const int kv = hh >= 30, x = hh - (kv ? 30 : 21), g = x / 3, j = x % 3, hd = 2 * j + (c >> 6);
                dst = KV + KVB0 + (size_t)(((b * 3 + g) * 6 + hd) * 2 + kv) * (2048 * 64) + (c & 63); pitch = 64; s = 2 * g; tokmajor = false; }
            else if (hh < 42) { dst = QO + 1664 + (hh - 39) * 128 + c; sc = C2; }
            else if (hh < 48) { const int kv = hh >= 45, j = hh - (kv ? 45 : 42), hd = 2 * j + (c >> 6); dst = KV + KVC0 + (size_t)((b * 6 + hd) * 2 + kv) * (2048 * 64) + (c & 63); pitch = 64; tokmajor = false; }
            else { dst = GT + (hh - 48) * 128 + c; pitch = 3072; sig = true; }
#pragma unroll
            for (int ai = 0; ai < 2; ++ai)
#pragma unroll
                for (int m = 0; m < 4; ++m) { const int r = rowl0 + ai * HALF + m * 16, t = r & 2047, tp = ((t & ((1 << s) - 1)) << (11 - s)) | (t >> s), ro = (tokmajor ? (r & ~2047) : 0) | tp;
                    f32x4 v0 = acc[ai][bj][m][0], v1 = acc[ai][bj][m][1];
                    if (sig) { v0[0] = sigm_f(v0[0]); v0[1] = sigm_f(v0[1]); v0[2] = sigm_f(v0[2]); v0[3] = sigm_f(v0[3]); v1[0] = sigm_f(v1[0]); v1[1] = sigm_f(v1[1]); v1[2] = sigm_f(v1[2]); v1[3] = sigm_f(v1[3]); }
                    else { v0 = v0 * sc; v1 = v1 * sc; }
                    u32x4 w; w.x = cvt_pk_bf16(v0[0], v0[1]); w.y = cvt_pk_bf16(v0[2], v0[3]); w.z = cvt_pk_bf16(v1[0], v1[1]); w.w = cvt_pk_bf16(v1[2], v1[3]);
                    *(u32x4*)(dst + (size_t)ro * pitch) = w; }
        }
    }
};
__device__ __forceinline__ float bf_lo(unsigned u) { return __builtin_bit_cast(float, u << 16); }
__device__ __forceinline__ float bf_hi(unsigned u) { return __builtin_bit_cast(float, u & 0xffff0000u); }
template <int BR> struct EpiMerge {
    static constexpr bool PERM = true, AFTER_DRAIN = false, SEGMENTED = false;
    const bf16_t* proj; bf16_t* mg; int ldp;
    __device__ __forceinline__ void operator()(const f32x4 (&acc)[2][2][4][2], const Unit& u, int wr, int wc, int fr, int fq) const {
        const int row0 = u.pm * BM + wr * 64 + fr, col0 = u.pn * BM + wc * 32 + 8 * fq;
#pragma unroll
        for (int ai = 0; ai < 2; ++ai)
#pragma unroll
        for (int mp = 0; mp < 4; ++mp) {
            u32x4 gt[1][2], od[1][2];
#pragma unroll
            for (int mm = 0; mm < 1; ++mm)
#pragma unroll
                for (int bj = 0; bj < 2; ++bj) { const size_t r = (size_t)(row0 + ai * HALF + (mp + mm) * 16);
                    gt[mm][bj] = *(const u32x4*)(proj + r * ldp + 6144 + 1024 * BR + col0 + bj * HALF);
                    if (BR) od[mm][bj] = *(const u32x4*)(mg + r * 1024 + col0 + bj * HALF); else od[mm][bj] = (u32x4){0u, 0u, 0u, 0u}; }
            asm volatile("" ::: "memory");
#pragma unroll
            for (int mm = 0; mm < 1; ++mm)
#pragma unroll
                for (int bj = 0; bj < 2; ++bj) { const int m = mp + mm; const size_t r = (size_t)(row0 + ai * HALF + m * 16); const u32x4 g = gt[mm][bj], o = od[mm][bj]; const f32x4 v0 = acc[ai][bj][m][0], v1 = acc[ai][bj][m][1];
                    u32x4 w; w.x = cvt_pk_bf16(bf_lo(o.x) + bf_lo(g.x) * v0[0], bf_hi(o.x) + bf_hi(g.x) * v0[1]); w.y = cvt_pk_bf16(bf_lo(o.y) + bf_lo(g.y) * v0[2], bf_hi(o.y) + bf_hi(g.y) * v0[3]);
                    w.z = cvt_pk_bf16(bf_lo(o.z) + bf_lo(g.z) * v1[0], bf_hi(o.z) + bf_hi(g.z) * v1[1]); w.w = cvt_pk_bf16(bf_lo(o.w) + bf_lo(g.w) * v1[2], bf_hi(o.w) + bf_hi(g.w) * v1[3]);
                    *(u32x4*)(mg + r * 1024 + col0 + bj * HALF) = w; }
            asm volatile("" ::: "memory");
        }
    }
};
struct EpiMergeS {
    static constexpr bool PERM = true, AFTER_DRAIN = false, SEGMENTED = false;
    const bf16_t* proj; bf16_t* mg; int ldp;
    __device__ __forceinline__ void operator()(const f32x4 (&acc)[2][2][4][2], const Unit& u, int wr, int wc, int fr, int fq) const {
        const int row0 = u.pm * BM + wr * 64 + fr, col0 = u.pn * BM + wc * 32 + 8 * fq; const int s = u.e;
#pragma unroll
        for (int ai = 0; ai < 2; ++ai) {
            u32x4 gt[4][2], od[4][2];
#pragma unroll
            for (int m = 0; m < 4; ++m)
#pragma unroll
                for (int bj = 0; bj < 2; ++bj) { const size_t r = (size_t)(row0 + ai * HALF + m * 16);
                    gt[m][bj] = *(const u32x4*)(proj + r * ldp + 1024 * s + col0 + bj * HALF);     od[m][bj] = *(const u32x4*)(mg + r * 1024 + col0 + bj * HALF); }
            asm volatile("" ::: "memory");
#pragma unroll
            for (int m = 0; m < 4; ++m)
#pragma unroll
                for (int bj = 0; bj < 2; ++bj) { const size_t r = (size_t)(row0 + ai * HALF + m * 16); const u32x4 g = gt[m][bj]; u32x4 o = od[m][bj]; if (s == 0) o = (u32x4){0u, 0u, 0u, 0u};
                    const f32x4 v0 = acc[ai][bj][m][0], v1 = acc[ai][bj][m][1];
                    u32x4 w; w.x = cvt_pk_bf16(bf_lo(o.x) + bf_lo(g.x) * v0[0], bf_hi(o.x) + bf_hi(g.x) * v0[1]); w.y = cvt_pk_bf16(bf_lo(o.y) + bf_lo(g.y) * v0[2], bf_hi(o.y) + bf_hi(g.y) * v0[3]);
                    w.z = cvt_pk_bf16(bf_lo(o.z) + bf_lo(g.z) * v1[0], bf_hi(o.z) + bf_hi(g.z) * v1[1]); w.w = cvt_pk_bf16(bf_lo(o.w) + bf_lo(g.w) * v1[2], bf_hi(o.w) + bf_hi(g.w) * v1[3]);
                    *(u32x4*)(mg + r * 1024 + col0 + bj * HALF) = w; }
            asm volatile("" ::: "memory");
        }
    }
};
struct SegOrder : StaticOrder {
    __device__ __forceinline__ bool next(int i, Unit& u) const { const int ti = i / 3, sg = i - 3 * ti; if (!StaticOrder::next(ti, u)) return false; u.e = sg; return true; }
    __device__ __forceinline__ const char* a_ptr(const Gemm& g, const Unit& u) const { return (const char*)g.A + (size_t)u.pm * (size_t)(BM * 2) * g.lda + (u.e == 0 ? 0 : (u.e == 1 ? 512 * 2 : 1664 * 2)); }
    __device__ __forceinline__ const char* b_ptr(const Gemm& g, const Unit& u) const { return (const char*)g.Bt + (size_t)u.pn * (size_t)(BM * 2) * g.ldb + (u.e == 0 ? 0 : (u.e == 1 ? 512 * 2 : 896 * 2)); }
    __device__ __forceinline__ int kt(const Gemm&, const Unit& u) const { return u.e == 0 ? 8 : 6; }
    __device__ __forceinline__ bool last_seg(const Unit& u) const { return u.e == 2; }
};
template <class Epi, class Sched, bool ALIGN_EPI = false, bool SP2 = false>
__device__ __forceinline__ void gemm_phase(PG8_LAS unsigned char* lds, const Gemm g, const Sched& S, const Epi& E) {
    int tid = threadIdx.x; asm volatile("" : "+v"(tid));
    const int wid = __builtin_amdgcn_readfirstlane(tid >> 6), lane = tid & 63, wr = wid >> 2, wc = wid & 3, fr = lane & 15, fq = lane >> 4;
    const int K = g.K;
    unsigned voffA[2], voffB[2];
#pragma unroll
    for (int i = 0; i < 2; ++i) { int R, C; stage_rc(tid * 16 + i * 8192, R, C); const int Rb = Epi::PERM ? ((R & ~31) + perm32(R & 31)) : R;
        voffA[i] = (unsigned)(R * g.lda + C) * 2u; voffB[i] = (unsigned)(Rb * g.ldb + C) * 2u; }
    const size_t kstep = (size_t)(BK * 2);
    const size_t hstepA = (size_t)HALF * g.lda * 2, hstepB = (size_t)HALF * g.ldb * 2;
    const unsigned ldsw = (unsigned)wid * 1024u;
    const int aoff = lds_byte(wr * 64 + fr, fq * 8), boff = lds_byte(wc * 32 + fr, fq * 8);
#define PG8_SA(b, h) (((b) * 2 + (h)) * HTB)
#define PG8_SB(b, h) ((4 + (b) * 2 + (h)) * HTB)
#define PG8_STAGE(bufoff, gbase, voff) do { _Pragma("unroll") for (int _i = 0; _i < 2; ++_i) \
        __builtin_amdgcn_global_load_lds((const unsigned*)((const char*)(gbase) + (voff)[_i]), (PG8_LAS unsigned*)(lds + (bufoff) + ldsw + _i * 8192), 16, 0, 0); } while (0)
#define PG8_LDA(dst, b, h) do { _Pragma("unroll") for (int m = 0; m < 4; ++m) _Pragma("unroll") for (int k = 0; k < 2; ++k) dst[m][k] = *(const PG8_LAS bf16x8*)(lds + PG8_SA(b, h) + aoff + m * 2048 + k * 1024); } while (0)
#define PG8_LDB(dst, b, h) do { _Pragma("unroll") for (int n = 0; n < 2; ++n) _Pragma("unroll") for (int k = 0; k < 2; ++k) dst[n][k] = *(const PG8_LAS bf16x8*)(lds + PG8_SB(b, h) + boff + n * 2048 + k * 1024); } while (0)
#define PG8_MMA(ai, bj, At, Bt) do { __builtin_amdgcn_s_setprio(1); _Pragma("unroll") for (int m = 0; m < 4; ++m) _Pragma("unroll") for (int n = 0; n < 2; ++n) _Pragma("unroll") for (int k = 0; k < 2; ++k) \
        acc[ai][bj][m][n] = __builtin_amdgcn_mfma_f32_16x16x32_bf16(Bt[n][k], At[m][k], acc[ai][bj][m][n], 0, 0, 0); __builtin_amdgcn_s_setprio(0); } while (0)
#define PG8_WAIT_V(n) asm volatile("s_waitcnt vmcnt(" #n ")" ::: "memory")
#define PG8_WAIT_L(n) asm volatile("s_waitcnt lgkmcnt(" #n ")" ::: "memory")
#define PG8_BAR __builtin_amdgcn_s_barrier()
#define PG8_SCHED __builtin_amdgcn_sched_barrier(0)
    Unit cur, nxt; int ui = 0;
    if (!S.next(0, cur)) return;
    int nt = S.kt(g, cur);
    f32x4 acc[2][2][4][2];
#pragma unroll
    for (int a = 0; a < 2; ++a)
#pragma unroll
        for (int b = 0; b < 2; ++b)
#pragma unroll
            for (int m = 0; m < 4; ++m)
#pragma unroll
                for (int n = 0; n < 2; ++n) acc[a][b][m][n] = (f32x4){0.f, 0.f, 0.f, 0.f};
    bf16x8 At[4][2], B0[2][2], B1[2][2];
    const char* cA = S.a_ptr(g, cur); const char* cB = S.b_ptr(g, cur);
    S.a_ready(cur);
    if constexpr (SP2) {
        PG8_STAGE(PG8_SB(0, 0), cB, voffB); PG8_STAGE(PG8_SB(0, 1), cB + hstepB, voffB); PG8_STAGE(PG8_SA(0, 0), cA, voffA); PG8_STAGE(PG8_SA(0, 1), cA + hstepA, voffA);
        if (wr == 1) PG8_BAR;
        PG8_WAIT_V(2); PG8_BAR;
        PG8_STAGE(PG8_SB(1, 0), cB + kstep, voffB); PG8_STAGE(PG8_SA(1, 0), cA + kstep, voffA); PG8_STAGE(PG8_SB(1, 1), cB + hstepB + kstep, voffB);
        PG8_WAIT_V(6); PG8_BAR;
    } else {
        PG8_STAGE(PG8_SB(0, 0), cB, voffB); PG8_STAGE(PG8_SA(0, 0), cA, voffA); PG8_STAGE(PG8_SB(0, 1), cB + hstepB, voffB); PG8_STAGE(PG8_SA(0, 1), cA + hstepA, voffA);
        if (wr == 1) PG8_BAR;
        PG8_WAIT_V(4); PG8_BAR;
        PG8_STAGE(PG8_SB(1, 0), cB + kstep, voffB); PG8_STAGE(PG8_SA(1, 0), cA + kstep, voffA); PG8_STAGE(PG8_SB(1, 1), cB + hstepB + kstep, voffB);
        PG8_WAIT_V(6); PG8_BAR;
    }
    for (;;) {
        const bool has_next = S.next(ui + 1, nxt);
        const char* nA = has_next ? S.a_ptr(g, nxt) : cA; const char* nB = has_next ? S.b_ptr(g, nxt) : cB;
        for (int t = 0; t < nt; t += 2) {
            const bool last = (t == nt - 2);
            const char* a1 = cA + (size_t)(t + 1) * kstep;
            const char* a2 = last ? nA : cA + (size_t)(t + 2) * kstep; const char* b2 = last ? nB : cB + (size_t)(t + 2) * kstep;
            const char* a3 = a2 + kstep; const char* b3 = b2 + kstep;
            if (last && has_next) S.a_ready(nxt);
            if constexpr (SP2) {
            PG8_LDB(B0, 0, 0); PG8_LDB(B1, 0, 1); PG8_SCHED; PG8_LDA(At, 0, 0); PG8_STAGE(PG8_SA(1, 1), a1 + hstepA, voffA);
            PG8_WAIT_V(8); PG8_WAIT_L(0); PG8_BAR; PG8_MMA(0, 0, At, B0); PG8_MMA(0, 1, At, B1); PG8_BAR; PG8_SCHED;
            PG8_LDA(At, 0, 1); PG8_STAGE(PG8_SB(0, 0), b2, voffB); PG8_STAGE(PG8_SB(0, 1), b2 + hstepB, voffB); PG8_STAGE(PG8_SA(0, 0), a2, voffA);
            PG8_WAIT_V(8); PG8_WAIT_L(0); PG8_BAR; PG8_MMA(1, 0, At, B0); PG8_MMA(1, 1, At, B1); PG8_BAR; PG8_SCHED;
            PG8_LDB(B0, 1, 0); PG8_LDB(B1, 1, 1); PG8_SCHED; PG8_LDA(At, 1, 0); PG8_STAGE(PG8_SA(0, 1), a2 + hstepA, voffA);
            PG8_WAIT_V(8); PG8_WAIT_L(0); PG8_BAR; PG8_MMA(0, 0, At, B0); PG8_MMA(0, 1, At, B1); PG8_BAR; PG8_SCHED;
            PG8_LDA(At, 1, 1); PG8_STAGE(PG8_SB(1, 0), b3, voffB); PG8_STAGE(PG8_SB(1, 1), b3 + hstepB, voffB); PG8_STAGE(PG8_SA(1, 0), a3, voffA);
            PG8_WAIT_V(8); PG8_WAIT_L(0); PG8_BAR; PG8_MMA(1, 0, At, B0); PG8_MMA(1, 1, At, B1); PG8_BAR; PG8_SCHED;
            } else {
            PG8_LDB(B0, 0, 0); PG8_SCHED; PG8_LDA(At, 0, 0); PG8_STAGE(PG8_SA(1, 1), a1 + hstepA, voffA);
            PG8_WAIT_L(8); PG8_BAR; PG8_WAIT_L(0); PG8_MMA(0, 0, At, B0); PG8_BAR; PG8_SCHED;
            PG8_LDB(B1, 0, 1); PG8_STAGE(PG8_SB(0, 0), b2, voffB);
            PG8_BAR; PG8_WAIT_L(0); PG8_MMA(0, 1, At, B1); PG8_BAR;
            PG8_LDA(At, 0, 1); PG8_STAGE(PG8_SA(0, 0), a2, voffA);
            PG8_BAR; PG8_WAIT_L(0); PG8_MMA(1, 0, At, B0); PG8_BAR; PG8_SCHED;
            PG8_STAGE(PG8_SB(0, 1), b2 + hstepB, voffB);
            PG8_WAIT_V(6); PG8_BAR; PG8_MMA(1, 1, At, B1); PG8_BAR;
            PG8_LDB(B0, 1, 0); PG8_SCHED; PG8_LDA(At, 1, 0); PG8_STAGE(PG8_SA(0, 1), a2 + hstepA, voffA);
            PG8_WAIT_L(8); PG8_BAR; PG8_WAIT_L(0); PG8_MMA(0, 0, At, B0); PG8_BAR; PG8_SCHED;
            PG8_LDB(B1, 1, 1); PG8_STAGE(PG8_SB(1, 0), b3, voffB);
            PG8_BAR; PG8_WAIT_L(0); PG8_MMA(0, 1, At, B1); PG8_BAR;
            PG8_LDA(At, 1, 1); PG8_STAGE(PG8_SA(1, 0), a3, voffA);
            PG8_BAR; PG8_WAIT_L(0); PG8_MMA(1, 0, At, B0); PG8_BAR; PG8_SCHED;
            PG8_STAGE(PG8_SB(1, 1), b3 + hstepB, voffB);
            PG8_WAIT_V(6); PG8_BAR; PG8_MMA(1, 1, At, B1); PG8_BAR;
            }
        }
        if constexpr (ALIGN_EPI) { if (wr == 0) PG8_BAR; }
        if constexpr (!Epi::AFTER_DRAIN) { E(acc, cur, wr, wc, fr, fq); S.done(cur); }
        if (!has_next) break;
#pragma unroll
        for (int a = 0; a < 2; ++a)
#pragma unroll
            for (int b = 0; b < 2; ++b)
#pragma unroll
                for (int m = 0; m < 4; ++m)
#pragma unroll
                    for (int n = 0; n < 2; ++n) acc[a][b][m][n] = (f32x4){0.f, 0.f, 0.f, 0.f};
        cur = nxt; cA = nA; cB = nB; ++ui; nt = S.kt(g, cur);
        if constexpr (ALIGN_EPI) { if (wr == 1) PG8_BAR; }
    }
    PG8_WAIT_V(0);
    if constexpr (!ALIGN_EPI) { if (wr == 0) PG8_BAR; }
    PG8_BAR;
    if constexpr (Epi::AFTER_DRAIN) { E.fused(acc, cur, wr, wc, fr, fq, lds, wid, lane); S.done(cur); }
#undef PG8_SA
#undef PG8_SB
#undef PG8_STAGE
#undef PG8_LDA
#undef PG8_LDB
#undef PG8_MMA
#undef PG8_WAIT_V
#undef PG8_WAIT_L
#undef PG8_BAR
#undef PG8_SCHED
}
}

#define LAS __attribute__((address_space(3)))
#define XB_TMO      128
#define XB_XCNT(j)  (256  + 64 * (j))
#define XB_XSUB(j)  (1280 + 64 * (j))
#define XB_XGEN(j)  (2304 + 64 * (j))
#define XB_TOP      3328
#define XB_TOPGEN   3392
#define XCD_BAR_WORDS 3456
#define XB_SPIN_CAP (1u << 18)

__device__ __forceinline__ unsigned xb_ld(unsigned* p)              { return __hip_atomic_load(p, __ATOMIC_RELAXED, __HIP_MEMORY_SCOPE_AGENT); }
__device__ __forceinline__ unsigned xb_add(unsigned* p, unsigned v) { return __hip_atomic_fetch_add(p, v, __ATOMIC_RELAXED, __HIP_MEMORY_SCOPE_AGENT); }
__device__ __forceinline__ unsigned xb_xcc_id() { return (unsigned)__builtin_amdgcn_s_getreg((3 << 11) | 20) & 0xFu; }
#define XB_SPIN(cond, bar) do { unsigned _sp = 0; while (cond) { __builtin_amdgcn_s_sleep(1); \
    if ((++_sp & 255u) == 0u) { if (xb_ld(&(bar)[XB_TMO])) break; if (_sp > XB_SPIN_CAP) { atomicAdd(&(bar)[XB_TMO], 1u); break; } } } } while (0)

struct XcdBarrier {
    unsigned* bar; unsigned x;
    volatile LAS unsigned* st;
};

__device__ __forceinline__ XcdBarrier xcd_barrier_post(unsigned* bar, volatile LAS unsigned* st) {
    XcdBarrier b; b.bar = bar; b.x = xb_xcc_id(); b.st = st;
    if (threadIdx.x == 0) (void)xb_add(&bar[XB_XCNT(b.x)], 1u);
    return b;
}
__device__ __forceinline__ void xcd_barrier_complete(unsigned* bar, unsigned x, unsigned& nloc, unsigned& nx) {
    const unsigned G = gridDim.x * gridDim.y * gridDim.z;
    unsigned sum, cnt, mine, sp = 0u;
    for (;;) {
        sum = 0u; cnt = 0u; mine = 0u;
#pragma unroll
        for (unsigned j = 0; j < 16; ++j) { const unsigned c = xb_ld(&bar[XB_XCNT(j)]); sum += c; cnt += (c > 0u) ? 1u : 0u; mine = (j == x) ? c : mine; }
        if (sum == G) break;
        __builtin_amdgcn_s_sleep(1);
        if ((++sp & 255u) == 0u) { if (xb_ld(&bar[XB_TMO])) break; if (sp > XB_SPIN_CAP) { atomicAdd(&bar[XB_TMO], 1u); break; } }
    }
    nloc = mine > 0u ? mine : 1u; nx = cnt > 0u ? cnt : 1u;
}

__device__ __forceinline__ void xcd_barrier(const XcdBarrier& b) {
    asm volatile("s_waitcnt vmcnt(0)" ::: "memory");
    __syncthreads();
    if (threadIdx.x == 0) {
        unsigned* bar = b.bar;
        __builtin_amdgcn_s_waitcnt(0);
        unsigned nloc = b.st[0], nx = b.st[1];
        if (nloc == 0u) { xcd_barrier_complete(bar, b.x, nloc, nx); b.st[0] = nloc; b.st[1] = nx; }
        const unsigned old = xb_add(&bar[XB_XSUB(b.x)], 1u);
        const unsigned gen = old / nloc;
        if (old + 1u == (gen + 1u) * nloc) {
            __builtin_amdgcn_fence(__ATOMIC_RELEASE, "agent");
            asm volatile("s_waitcnt vmcnt(0)" ::: "memory");
            const unsigned og = xb_add(&bar[XB_TOP], 1u);
            const unsigned tg = og / nx;
            if (og + 1u == (tg + 1u) * nx) xb_add(&bar[XB_TOPGEN], 1u);
            else XB_SPIN(xb_ld(&bar[XB_TOPGEN]) == tg, bar);
            __builtin_amdgcn_fence(__ATOMIC_ACQUIRE, "agent");
            xb_add(&bar[XB_XGEN(b.x)], 1u);
            asm volatile("s_waitcnt vmcnt(0)" ::: "memory");
        } else {
            XB_SPIN(xb_ld(&bar[XB_XGEN(b.x)]) == gen, bar);
            __builtin_amdgcn_fence(__ATOMIC_ACQUIRE, "agent");
            asm volatile("s_waitcnt vmcnt(0)" ::: "memory");
        }
    }
    __syncthreads();
}

namespace mk {
using pg8::bf16_t;
constexpr int NWAVES = 8, NTHR = 512;
constexpr int D = 1024, NB = 16, S = 2048, T = NB * S, NIN = 9222, NP = 9216;
constexpr int DFF = 2816, NE = 8, DFE = 3584;
constexpr float EPS = 1e-6f, LOG2E = 1.4426950408889634f;
constexpr int CH_B = 8, CH_T = CH_B * S;

constexpr size_t WS_CTL = 0, CTL_BYTES = 1u << 20, CTL_ZERO = 64u << 10;
constexpr size_t WS_MOD = WS_CTL + CTL_BYTES;
constexpr size_t WS_MISC = WS_MOD + (size_t)2 * NB * 6 * D * 4;
constexpr size_t WS_WIN = WS_MISC + (8u << 20);
constexpr size_t WS_WBR = WS_WIN + (size_t)2 * NP * D * 2;
constexpr size_t WS_WOUT = WS_WBR + (size_t)2 * 1280 * D * 2;
constexpr size_t WS_WGU0 = WS_WOUT + (size_t)2 * D * D * 2;
constexpr size_t WS_WD0 = WS_WGU0 + (size_t)2 * DFF * D * 2;
constexpr size_t WS_WGU1 = WS_WD0 + (size_t)D * DFF * 2;
constexpr size_t WS_WD1 = WS_WGU1 + (size_t)NE * 2 * DFE * D * 2;
constexpr size_t WS_H = WS_WD1 + (size_t)NE * D * DFE * 2;
constexpr size_t WS_PROJ = WS_H + (size_t)T * D * 2;
constexpr size_t WS_END = WS_PROJ + (size_t)CH_T * NP * 2;
constexpr size_t WS_QO = WS_PROJ;
constexpr size_t WS_KV = WS_QO + (size_t)CH_T * 2048 * 2;
constexpr size_t WS_GATE = WS_KV + (size_t)CH_T * 4096 * 2;
constexpr size_t KVB0 = (size_t)8 * 4 * 2 * 2048 * 128, KVC0 = KVB0 + (size_t)8 * 18 * 2 * 2048 * 64;
static_assert(WS_GATE + (size_t)CH_T * 3072 * 2 == WS_END, "projection buffers");
static_assert(WS_END <= 640000000ull, "d_ws map");
constexpr int MI_LAM = 0;
constexpr int MOE_MAXT = 264, MOE_ROWS = MOE_MAXT * 256;
constexpr int MI_TILE_E = 1024;
constexpr int MI_TOK_E = 4096;
constexpr int MI_TOK_POS = MI_TOK_E + 2 * T;
constexpr int MI_TOK_W = MI_TOK_POS + 2 * T;
constexpr int MI_ROW_W = MI_TOK_W + 2 * T;
constexpr int MI_LOGF = MI_ROW_W + MOE_ROWS;
constexpr int MI_NEGF = MI_LOGF + 8 * T;
constexpr int MI_LSE = MI_NEGF + NB * 6 * S;
constexpr int MI_LUTA = MI_LSE + 3 * CH_T * 8;
constexpr int MI_LUTB = MI_LUTA + 8 * 2240;
constexpr int MI_WF = MI_LUTB + 18 * 384;
constexpr int MI_END = MI_WF + 2 * 1024 * 8;
static_assert(MI_END * 4 <= (8 << 20), "MISC map");
constexpr size_t WS_HS = WS_PROJ;
constexpr size_t WS_ACT1 = WS_PROJ + (size_t)MOE_ROWS * D * 2;
constexpr int MOE_CH = 64;
static_assert(WS_ACT1 + (size_t)72 * 256 * DFE * 2 <= WS_END, "MoE buffers inside the PROJ region");
constexpr int CW_CNT = 64;
constexpr int CW_BAR = 4096;

constexpr int RING_BYTES = 131072, LDS_BYTES = 147456, LDSCTL_OFF = LDS_BYTES - 1024, MISC_OFF = LDSCTL_OFF + 320;

#define GAS __attribute__((address_space(1)))
typedef unsigned v4u __attribute__((ext_vector_type(4)));
typedef unsigned v2u __attribute__((ext_vector_type(2)));
typedef float f32x4 __attribute__((ext_vector_type(4)));
#define LDS_WAIT() asm volatile("s_waitcnt lgkmcnt(0)" ::: "memory")
__device__ __forceinline__ unsigned f2bf(float f) { unsigned u = __builtin_bit_cast(unsigned, f); return (u + 0x7fffu + ((u >> 16) & 1u)) >> 16; }
__device__ __forceinline__ unsigned pk2(float lo, float hi) { return f2bf(lo) | (f2bf(hi) << 16); }
__device__ __forceinline__ float wave_sum(float v) {
#pragma unroll
    for (int o = 1; o < 64; o <<= 1) v += __shfl_xor(v, o);
    return v;
}

struct Params { const float* in[26]; float* out; unsigned char* ws; int lo, hi, li, pad; };

typedef const __attribute__((address_space(4))) Params* CParams;
__device__ __forceinline__ Params load_params() {
#if defined(__HIP_DEVICE_COMPILE__)
    CParams pp = (CParams)__builtin_amdgcn_kernarg_segment_ptr(); asm volatile("" : "+s"(pp));
    Params q;
#pragma unroll
    for (int i = 0; i < 26; ++i) q.in[i] = pp->in[i];
    q.out = pp->out; q.ws = pp->ws; q.lo = pp->lo; q.hi = pp->hi; q.li = pp->li; q.pad = 0; return q;
#else
    return Params{};
#endif
}
constexpr int ST_PRO = 0, LSTEPS = 22, ST_L0 = 1;
constexpr int SO_NORM1 = 0, SO_CHUNK = 1, CSTEPS = 5, SO_NORM2 = 11, SO_FFN = 12;
constexpr int ST_END = ST_L0 + 2 * LSTEPS;

template <bool NT = false> __device__ __forceinline__ void transpose_item(const float* W, int ldw, int K  , bf16_t* WT, int k0, int n0, int drow0, LAS float* scr, int lane) {
    float tv[32];
#pragma unroll
    for (int i = 0; i < 32; ++i) { const float* s_ = W + (size_t)(k0 + 2 * i + (lane >> 5)) * ldw + n0 + (lane & 31); tv[i] = NT ? __builtin_nontemporal_load(s_) : *s_; }
#pragma unroll
    for (int i = 0; i < 32; ++i) scr[(2 * i + (lane >> 5)) * 33 + (lane & 31)] = tv[i];
    LDS_WAIT(); asm volatile("" ::: "memory");
    const int c = lane & 7;
#pragma unroll
    for (int j = 0; j < 4; ++j) { const int n = (lane >> 3) + 8 * j; const LAS float* s = scr + (8 * c) * 33 + n;
        v4u o; o.x = pk2(s[0 * 33], s[1 * 33]); o.y = pk2(s[2 * 33], s[3 * 33]); o.z = pk2(s[4 * 33], s[5 * 33]); o.w = pk2(s[6 * 33], s[7 * 33]);
        if (NT) __builtin_nontemporal_store(o, (GAS v4u*)(WT + (size_t)(drow0 + n) * K + k0 + 8 * c)); else *(GAS v4u*)(WT + (size_t)(drow0 + n) * K + k0 + 8 * c) = o; }
    LDS_WAIT(); asm volatile("" ::: "memory");
}
struct Job { const float* W; bf16_t* WT; int ldw, K, nblk, mode, drow, first, kp, pad; };
constexpr int NJOBS = 2 * 6 + 3 + 3 * NE;
__device__ __forceinline__ void job_set(LAS Job* J, int& nj, int& items, const float* W, int ldw, int K, int ncols, int mode, int drow, bf16_t* WT, int kp = 0) {
    J[nj].kp = kp ? kp : K; J[nj].W = W; J[nj].WT = WT; J[nj].ldw = ldw; J[nj].K = K; J[nj].nblk = ncols / 32; J[nj].mode = mode; J[nj].drow = drow; J[nj].first = items; ++nj; items += (K / 64) * (ncols / 32);
}
constexpr int PRO_SCR = 0, PRO_SC = 8 * 64 * 33 * 4  , PRO_JOB = PRO_SC + NB * D * 4  , PRO_JN = PRO_JOB + 48 * 48;
static_assert(PRO_JN + 64 <= LDSCTL_OFF && sizeof(Job) == 48 && NJOBS <= 48, "prologue LDS map");

__device__ __forceinline__ void build_luts(const Params& p, int tid);
__device__ __forceinline__ void prologue(const Params& p, LAS unsigned char* lds, int tid, int lane, int wave) {
    unsigned char* ws = p.ws;
    LAS Job* J = (LAS Job*)(lds + PRO_JOB);
    LAS int* JN = (LAS int*)(lds + PRO_JN);
    if (tid == 0) {
        int nj = 0, items = 0;
        for (int l = 0; l < 2; ++l) {
            bf16_t* win = (bf16_t*)(ws + WS_WIN) + (size_t)l * NP * D; const float* w_in = p.in[6] + (size_t)l * D * NIN;
            job_set(J, nj, items, w_in, NIN, D, 6144, 0, 0, win);
            job_set(J, nj, items, w_in + 6150, NIN, D, 3072, 0, 6144, win);
            bf16_t* wbr = (bf16_t*)(ws + WS_WBR) + (size_t)l * 1280 * D;
            job_set(J, nj, items, p.in[14] + (size_t)l * 512 * D, D, 512, D, 0, 0, wbr, 1280);
            job_set(J, nj, items, p.in[15] + (size_t)l * 384 * D, D, 384, D, 0, 0, wbr + 512, 1280);
            job_set(J, nj, items, p.in[16] + (size_t)l * 384 * D, D, 384, D, 0, 0, wbr + 896, 1280);
            job_set(J, nj, items, p.in[17] + (size_t)l * D * D, D, D, D, 0, 0, (bf16_t*)(ws + WS_WOUT) + (size_t)l * D * D);
        }
        job_set(J, nj, items, p.in[18], DFF, D, DFF, 1, 0, (bf16_t*)(ws + WS_WGU0));
        job_set(J, nj, items, p.in[19], DFF, D, DFF, 1, 128, (bf16_t*)(ws + WS_WGU0));
        job_set(J, nj, items, p.in[20], D, DFF, D, 0, 0, (bf16_t*)(ws + WS_WD0));
        JN[0] = nj; JN[1] = items;
    }
    LAS float* sc = (LAS float*)(lds + PRO_SC);
    const bool modblk = blockIdx.x < 192;
    if (modblk) for (int i = tid; i < NB * D; i += NTHR) { const float c = p.in[1][i]; sc[i] = c / (1.0f + __expf(-c)); }
    __syncthreads();
    float* misc = (float*)(ws + WS_MISC);
    if (blockIdx.x == 192 && wave < 2) {
        const int l = wave; const float a = wave_sum(p.in[8][l * 64 + lane] * p.in[9][l * 64 + lane]), b = wave_sum(p.in[10][l * 64 + lane] * p.in[11][l * 64 + lane]);
        const float lam_init = 0.8f - 0.6f * __expf(-0.3f * (float)l);
        if (lane == 0) { misc[MI_LAM + l] = __expf(a) - __expf(b) + lam_init; misc[MI_LAM + 8 + l] = lam_init; }
    }
    if (modblk) {
        const int l = blockIdx.x / 96, j = (blockIdx.x % 96) * 64 + lane;
        const float* w = p.in[4] + (size_t)l * D * 6 * D + (size_t)(wave * 128) * 6 * D + j;
        const LAS float* scw = sc + wave * 128;
        float acc[NB];
#pragma unroll
        for (int b = 0; b < NB; ++b) acc[b] = 0.f;
        for (int k0 = 0; k0 < 128; k0 += 16) {
            float wv[16];
#pragma unroll
            for (int i = 0; i < 16; ++i) wv[i] = w[(size_t)(k0 + i) * 6 * D];
#pragma unroll
            for (int i = 0; i < 16; ++i)
#pragma unroll
                for (int b = 0; b < NB; ++b) acc[b] += scw[b * D + k0 + i] * wv[i];
        }
        LAS float* part = (LAS float*)(lds + PRO_SCR) + wave * (64 * 33);
#pragma unroll
        for (int b = 0; b < NB; ++b) part[b * 64 + lane] = acc[b];
    }
    __syncthreads();
    if (modblk) {
        const int l = blockIdx.x / 96, j0 = (blockIdx.x % 96) * 64;
        float* mod = (float*)(ws + WS_MOD) + (size_t)l * NB * 6 * D;
        for (int o = tid; o < NB * 64; o += NTHR) { const int b = o >> 6, jj = o & 63; float sum = p.in[5][l * 6 * D + j0 + jj];
#pragma unroll
            for (int w8 = 0; w8 < NWAVES; ++w8) sum += ((const LAS float*)(lds + PRO_SCR) + w8 * (64 * 33))[b * 64 + jj];
            mod[(size_t)b * 6 * D + j0 + jj] = sum; }
    }
    __syncthreads();
    build_luts(p, tid);
    LAS float* scr = (LAS float*)(lds + PRO_SCR) + wave * (64 * 33);
    const int nj = JN[0], nitems = JN[1];
    const int gw = blockIdx.x * NWAVES + wave, NGW = gridDim.x * NWAVES;
    for (int it = gw; it < nitems; it += NGW) {
        int ji = 0;
        for (int q = 1; q < nj; ++q) if (J[q].first <= it) ji = q;
        const float* jW = J[ji].W; bf16_t* jWT = J[ji].WT; const int jldw = J[ji].ldw, jK = J[ji].kp, jnblk = J[ji].nblk, jmode = J[ji].mode, jdrow = J[ji].drow;
        const int r = it - J[ji].first, kb = r / jnblk, nb = r - kb * jnblk, n0 = 32 * nb;
        const int drow0 = jmode ? jdrow + 256 * (n0 >> 7) + (n0 & 127) : jdrow + n0;
        transpose_item(jW + n0, jldw, jK, jWT, 64 * kb, 0, drow0, scr, lane);
    }
}

constexpr int XI_MAT = 16 * (DFE / 32), XI_EXP = 3 * XI_MAT, XI_ALL = NE * XI_EXP;
static_assert(XI_MAT == (DFE / 64) * (D / 32), "expert item count");
__device__ __forceinline__ void expert_item(const Params& p, int it, LAS float* scr, int lane) {
    const int e = it / XI_EXP, r0 = it - e * XI_EXP, m = r0 / XI_MAT, r = r0 - m * XI_MAT;
    const bool dn = m == 2;
    const int nblk = dn ? D / 32 : DFE / 32, kb = r / nblk, n0 = 32 * (r - kb * nblk);
    const float* wg_ = p.in[22]; const float* wu_ = p.in[23]; const float* wd_ = p.in[24]; asm volatile("" : "+s"(wg_), "+s"(wu_), "+s"(wd_));
    const float* W = (dn ? wd_ : (m == 0 ? wg_ : wu_)) + (size_t)e * D * DFE + n0;
    bf16_t* WT = dn ? (bf16_t*)(p.ws + WS_WD1) + (size_t)e * D * DFE : (bf16_t*)(p.ws + WS_WGU1) + (size_t)e * 2 * DFE * D;
    const int drow0 = dn ? n0 : 128 * m + 256 * (n0 >> 7) + (n0 & 127);
    transpose_item<true>(W, dn ? D : DFE, dn ? DFE : D, WT, 64 * kb, 0, drow0, scr, lane);
}
constexpr int XQ_N = 64, XQ_ITEMS = XI_ALL / XQ_N, XQ_BATCH = 4, XQ_LDS = LDSCTL_OFF + 512;
constexpr size_t XQ_OFF = 32768;
static_assert(XI_ALL % XQ_N == 0 && XQ_ITEMS % XQ_BATCH == 0 && XQ_OFF + XQ_N * 512 <= CTL_ZERO && XQ_LDS + 8 * 16 <= LDS_BYTES, "expert queues");
__device__ __forceinline__ bool expert_steal_one(const Params& p, LAS unsigned char* lds, int lane, int wave) {
    volatile LAS int* st = (volatile LAS int*)(lds + XQ_LDS) + 4 * wave;
    int cur = __builtin_amdgcn_readfirstlane(st[0]); const int end = __builtin_amdgcn_readfirstlane(st[1]);
    if (cur == end) {
        if (__builtin_amdgcn_readfirstlane(st[2])) return false;
        unsigned* qb = (unsigned*)(p.ws + WS_CTL + XQ_OFF);
        const unsigned long long m = __ballot(xb_ld(qb + 128 * lane) < (unsigned)XQ_ITEMS);
        if (m == 0ull) { st[2] = 1; return false; }
        const int h = (int)(blockIdx.x * NWAVES + wave) & (XQ_N - 1);
        const unsigned long long r = h ? ((m >> h) | (m << (64 - h))) : m;
        const int k = (h + (int)__builtin_ctzll(r)) & (XQ_N - 1);
        unsigned v = 0; if (lane == 0) v = xb_add(qb + 128 * k, (unsigned)XQ_BATCH);
        v = (unsigned)__builtin_amdgcn_readfirstlane((int)v);
        if (v >= (unsigned)XQ_ITEMS) return true;
        cur = k * XQ_ITEMS + (int)v; st[1] = cur + XQ_BATCH;
    }
    expert_item(p, cur, (LAS float*)(lds + PRO_SCR) + wave * (64 * 33), lane);
    st[0] = cur + 1;
    return true;
}
__device__ __forceinline__ void expert_mopup(const Params& p, LAS unsigned char* lds, int lane, int wave) {
    while (expert_steal_one(p, lds, lane, wave)) {}
}
__device__ __forceinline__ void xcd_barrier_steal(const XcdBarrier& b, LAS unsigned char* lds) {
    asm volatile("s_waitcnt vmcnt(0)" ::: "memory");
    __syncthreads();
    volatile LAS unsigned* rel = (volatile LAS unsigned*)(lds + MISC_OFF + 48);
    int tid = threadIdx.x; asm volatile("" : "+v"(tid));
    if (tid < 64) {
        if (tid == 0) {
            unsigned* bar = b.bar;
            __builtin_amdgcn_s_waitcnt(0);
            unsigned nloc = b.st[0], nx = b.st[1];
            if (nloc == 0u) { xcd_barrier_complete(bar, b.x, nloc, nx); b.st[0] = nloc; b.st[1] = nx; }
            const unsigned old = xb_add(&bar[XB_XSUB(b.x)], 1u);
            const unsigned gen = old / nloc;
            if (old + 1u == (gen + 1u) * nloc) {
                rel[0] = 2u;
                __builtin_amdgcn_fence(__ATOMIC_RELEASE, "agent");
                asm volatile("s_waitcnt vmcnt(0)" ::: "memory");
                const unsigned og = xb_add(&bar[XB_TOP], 1u);
                const unsigned tg = og / nx;
                if (og + 1u == (tg + 1u) * nx) xb_add(&bar[XB_TOPGEN], 1u);
                else XB_SPIN(xb_ld(&bar[XB_TOPGEN]) == tg, bar);
                __builtin_amdgcn_fence(__ATOMIC_ACQUIRE, "agent");
                xb_add(&bar[XB_XGEN(b.x)], 1u);
                asm volatile("s_waitcnt vmcnt(0)" ::: "memory");
            } else {
                const unsigned stopat = (gen + 1u) * nloc - (nloc >> 3) - 1u;
                bool go = old + 1u < stopat;
                rel[0] = go ? 1u : 2u;
                unsigned sp = 0;
                while (xb_ld(&bar[XB_XGEN(b.x)]) == gen) {
                    if (go && xb_ld(&bar[XB_XSUB(b.x)]) >= stopat) { rel[0] = 2u; go = false; }
                    __builtin_amdgcn_s_sleep(1);
                    if ((++sp & 255u) == 0u) { if (xb_ld(&bar[XB_TMO])) break; if (sp > XB_SPIN_CAP) { atomicAdd(&bar[XB_TMO], 1u); break; } }
                }
                rel[0] = 2u;
                __builtin_amdgcn_fence(__ATOMIC_ACQUIRE, "agent");
                asm volatile("s_waitcnt vmcnt(0)" ::: "memory");
            }
        }
    } else {
        const Params p = load_params();
        const int lane = tid & 63, wave = __builtin_amdgcn_readfirstlane(tid >> 6);
        while (rel[0] == 0u) __builtin_amdgcn_s_sleep(1);
        while (rel[0] == 1u) { if (!expert_steal_one(p, lds, lane, wave)) break; }
        asm volatile("s_waitcnt vmcnt(0)" ::: "memory");
    }
    __syncthreads();
    if (tid == 0) rel[0] = 0u;
}

__device__ __forceinline__ void norm_rows(const float* x, const float* g, const float* sc, const float* sh, bf16_t* h, int t0, int t1, int gw, int NGW, int lane) {
    f32x4 vn[4], vm[4];
    { const int tf = (t0 + gw < t1) ? t0 + gw : 0, tg = (t0 + gw + NGW < t1) ? t0 + gw + NGW : tf; const GAS f32x4* xn = (const GAS f32x4*)(x + (size_t)tf * D) + lane; const GAS f32x4* xm = (const GAS f32x4*)(x + (size_t)tg * D) + lane;
#pragma unroll
      for (int j = 0; j < 4; ++j) { vn[j] = xn[64 * j]; vm[j] = xm[64 * j]; } }
    const int TEND = t1;
    for (int t = t0 + gw; t < t1; t += NGW) {
        const int b = t >> 11;
        f32x4 v[4]; float s = 0.f;
#pragma unroll
        for (int j = 0; j < 4; ++j) { v[j] = vn[j]; vn[j] = vm[j]; s += (v[j].x * v[j].x + v[j].y * v[j].y) + (v[j].z * v[j].z + v[j].w * v[j].w); }
        { const int tn = (t + 2 * NGW < TEND) ? t + 2 * NGW : t; const GAS f32x4* xn = (const GAS f32x4*)(x + (size_t)tn * D) + lane;
#pragma unroll
          for (int j = 0; j < 4; ++j) vm[j] = xn[64 * j]; }
        const float r = 1.0f / sqrtf(wave_sum(s) * (1.0f / D) + EPS);
        GAS v2u* o8 = (GAS v2u*)(h + (size_t)t * D) + lane;
#pragma unroll
        for (int j = 0; j < 4; ++j) { const int d = 4 * lane + 256 * j;
            const f32x4 g4 = *(const f32x4*)(g + d), c4 = *(const f32x4*)(sc + (size_t)b * 6 * D + d), h4 = *(const f32x4*)(sh + (size_t)b * 6 * D + d);
            const f32x4 o = v[j] * r * g4 * (c4 + 1.0f) + h4;
            v2u w; w.x = pk2(o.x, o.y); w.y = pk2(o.z, o.w); o8[64 * j] = w; }
    }
}


typedef float f32x16 __attribute__((ext_vector_type(16)));
typedef short bf16x8 __attribute__((ext_vector_type(8)));
typedef short s16x4 __attribute__((ext_vector_type(4)));
typedef float f32x2_t __attribute__((ext_vector_type(2))); typedef __bf16 bf16x2_t __attribute__((ext_vector_type(2)));
constexpr int QP = 2048;
constexpr int AL_K = 0, AL_V = 49152, AL_LUT = 114688, AL_OST = 65536, AL_XCH = 0;
static_assert(AL_LUT + 2 * 2240 * 4 <= LDSCTL_OFF && AL_OST + 34816 <= AL_LUT && 6 * 8192 <= AL_V && AL_V + 6 * 8192 <= AL_LUT, "attention LDS map");
constexpr int LUTA_N = 2240, LUTB_N = 384;
constexpr float NEG_BIG = -1.0e30f;
__device__ __forceinline__ unsigned cvtpk_s(float lo, float hi) { f32x2_t v = {lo, hi}; bf16x2_t b = __builtin_convertvector(v, bf16x2_t); return __builtin_bit_cast(unsigned, b); }
__device__ __forceinline__ s16x4 vtr(const LAS unsigned char* p) { typedef short v4i16_t __attribute__((ext_vector_type(4))); return __builtin_bit_cast(s16x4, __builtin_amdgcn_ds_read_tr16_b64_v4i16((LAS v4i16_t*)p)); }
__device__ __forceinline__ float xhalf_max(float v) { auto rr = __builtin_amdgcn_permlane32_swap(__float_as_uint(v), __float_as_uint(v), false, false); return fmaxf(__uint_as_float(rr[0]), __uint_as_float(rr[1])); }
__device__ __forceinline__ float xhalf_sum(float v) { auto rr = __builtin_amdgcn_permlane32_swap(__float_as_uint(v), __float_as_uint(v), false, false); return __uint_as_float(rr[0]) + __uint_as_float(rr[1]); }

struct AttnArgs {
    bf16_t* q;
    const bf16_t* k;
    const bf16_t* v;
    int q0;
    const float* tab;
    int seqM;
    float* lse;
    float lam, osc;
    const float* subg;
};
template <int MODE> __device__ __forceinline__ void attn_unit(const AttnArgs& a, LAS unsigned char* lds, int tid_in, int lane_in, int wave) {
    int tid = tid_in; asm volatile("" : "+v"(tid)); const int lane = tid & 63; (void)lane_in;
    constexpr int DV = MODE == 0 ? 128 : 64, NDB = DV / 32, NKL = MODE == 0 ? 2 : 1, NVL = MODE == 0 ? 2 : 1;
    const int r32 = lane & 31, hi = lane >> 5;
    const int map = MODE == 0 ? (wave >> 2) : 0, wq = MODE == 0 ? (wave & 3) : wave;
    const int qrow = a.q0 + 32 * wq;
    constexpr int KP = MODE == 0 ? 128 : 64, VP = KP;
    LAS float* lut = (LAS float*)(lds + AL_LUT);
    { constexpr int NT = MODE == 0 ? 2 * LUTA_N : (MODE == 1 ? 2048 : LUTB_N), NIT = (NT + NTHR - 1) / NTHR;
      const int need = MODE == 1 ? (a.q0 + 256) : NT;
      float tv[NIT];
#pragma unroll
      for (int k = 0; k < NIT; ++k) { const int i = tid + k * NTHR; tv[k] = i < need ? a.tab[i] : 0.f; }
#pragma unroll
      for (int k = 0; k < NIT; ++k) { const int i = tid + k * NTHR; if (i < need) lut[i] = tv[k]; } }
    bf16x8 qr[4];
    { const bf16_t* Qw = a.q + (size_t)(qrow + r32) * QP + map * 64 + hi * 8;
#pragma unroll
      for (int d0 = 0; d0 < 4; ++d0) qr[d0] = *(const bf16x8*)(Qw + d0 * 16); }
    int tlo, thi;
    if (MODE == 0) { tlo = 0; thi = (a.q0 + 128) / 64 - 1; }
    else if (MODE == 1) { tlo = 0; thi = (a.q0 + 256) / 64 - 1; }
    else { const int lo = a.q0 - 128; tlo = lo > 0 ? lo / 64 : 0; thi = (a.q0 + 256) / 64 - 1; }
    const bf16_t* gK = a.k + (size_t)(tid & 63) * KP + (tid >> 6) * 8;
    const bf16_t* gV = a.v + (size_t)(16 * (wave & 3) + (lane >> 2)) * VP + (wave >> 2) * 32 + (lane & 3) * 8;
#define AT_DMA(t_) do { const size_t ro = (size_t)(t_) * 64 * KP; const int ks_ = (MODE == 2 ? ((t_) - tlo) * 8192 : ((t_) % 3) * 16384) + wave * 1024, vs_ = (MODE == 2 ? ((t_) - tlo) * 8192 : ((t_) & 3) * 16384) + wave * 1024; \
        _Pragma("unroll") for (int i_ = 0; i_ < NKL; ++i_) __builtin_amdgcn_global_load_lds((const unsigned*)(gK + ro + i_ * 64), (LAS unsigned*)(lds + AL_K + ks_ + i_ * 8192), 16, 0, 0); \
        _Pragma("unroll") for (int i_ = 0; i_ < NVL; ++i_) __builtin_amdgcn_global_load_lds((const unsigned*)(gV + ro + i_ * 64), (LAS unsigned*)(lds + AL_V + vs_ + i_ * 8192), 16, 0, 0); } while (0)
#define AT_WAITBAR(n_) asm volatile("s_waitcnt vmcnt(" #n_ ") lgkmcnt(0)\n\ts_barrier" ::: "memory")
    constexpr float THR = 6.0f;
    float m_run = 0.f, l_run = 0.f;
    f32x16 negm = f32x16{};
    f32x16 o[NDB];
#pragma unroll
    for (int i = 0; i < NDB; ++i) o[i] = f32x16{};
    const int e0 = qrow + r32 - 4 * hi;
    int imax = 0, seq0 = 0;
    if (MODE == 2) { seq0 = qrow & ~(a.seqM - 1); const int dq = qrow + r32 - seq0; imax = dq < 128 ? dq : 128; }
    bf16x8 pw[4];
    bool pend = false; int pend_vs = 0;
#define AT_PV() do { const unsigned vb = (unsigned)(size_t)(lds + AL_V + pend_vs) + ((lane >> 4) & 1) * 32 + (lane & 3) * 8 + (4 * hi + ((lane & 15) >> 2)) * 64; \
        _Pragma("unroll") for (int dp = 0; dp < NDB; dp += 2) { s16x4 lo_[2][4], hh_[2][4];          \
            _Pragma("unroll") for (int dd = 0; dd < 2; ++dd) _Pragma("unroll") for (int ks = 0; ks < 4; ++ks) { \
                asm volatile("ds_read_b64_tr_b16 %0, %1 offset:%c2" : "=&v"(lo_[dd][ks]) : "v"(vb), "i"((dp + dd) * 4096 + ks * 1024) : "memory"); \
                asm volatile("ds_read_b64_tr_b16 %0, %1 offset:%c2" : "=&v"(hh_[dd][ks]) : "v"(vb), "i"((dp + dd) * 4096 + ks * 1024 + 512) : "memory"); } \
            asm volatile("s_waitcnt lgkmcnt(0)" ::: "memory"); __builtin_amdgcn_sched_barrier(0);     \
            _Pragma("unroll") for (int ks = 0; ks < 4; ++ks) _Pragma("unroll") for (int dd = 0; dd < 2; ++dd) { const bf16x8 vf = __builtin_shufflevector(lo_[dd][ks], hh_[dd][ks], 0, 1, 2, 3, 4, 5, 6, 7); \
                o[dp + dd] = __builtin_amdgcn_mfma_f32_32x32x16_bf16(vf, pw[ks], o[dp + dd], 0, 0, 0); } } } while (0)
#define MX3(a_, b_, c_) __builtin_fmaxf(__builtin_fmaxf((a_), (b_)), (c_))
#define AT_STEP(MASKED, t) do { \
        const int E = e0 - 64 * (t); \
        f32x16 p0, p1; \
        { const LAS unsigned char* kb = lds + AL_K + (MODE == 2 ? ((t) - tlo) * 8192 : ((t) % 3) * 16384) + map * 8192 + hi * 1024 + r32 * 16; bf16x8 kf[8]; \
          _Pragma("unroll") for (int d0 = 0; d0 < 4; ++d0) { kf[2 * d0] = *(const LAS bf16x8*)(kb + d0 * 2048); kf[2 * d0 + 1] = *(const LAS bf16x8*)(kb + d0 * 2048 + 512); }     \
          p0 = __builtin_amdgcn_mfma_f32_32x32x16_bf16(kf[0], qr[0], negm, 0, 0, 0); p1 = __builtin_amdgcn_mfma_f32_32x32x16_bf16(kf[1], qr[0], negm, 0, 0, 0); \
          _Pragma("unroll") for (int d0 = 1; d0 < 4; ++d0) { p0 = __builtin_amdgcn_mfma_f32_32x32x16_bf16(kf[2 * d0], qr[d0], p0, 0, 0, 0); p1 = __builtin_amdgcn_mfma_f32_32x32x16_bf16(kf[2 * d0 + 1], qr[d0], p1, 0, 0, 0); } } \
        if (pend) AT_PV(); \
        if (MODE == 0) __builtin_amdgcn_sched_barrier(0); \
        _Pragma("unroll") for (int hf = 0; hf < 2; ++hf) { f32x16 bb; \
            if (MODE == 1) { const LAS float* nf = lut + 64 * (t) + 4 * hi + 32 * hf; \
                _Pragma("unroll") for (int g = 0; g < 4; ++g) { const f32x4 a0 = *(const LAS f32x4*)(nf + 8 * g); bb[4 * g] = a0.x; bb[4 * g + 1] = a0.y; bb[4 * g + 2] = a0.z; bb[4 * g + 3] = a0.w; } \
            } else { const LAS float* lb = lut + (MODE == 0 ? map * LUTA_N + 2047 - E : 255 - E) + 32 * hf; \
                _Pragma("unroll") for (int r = 0; r < 16; ++r) bb[r] = lb[(r & 3) + 8 * (r >> 2)]; } \
            if (hf == 0) p0 += bb; else p1 += bb; \
            if (MODE == 0) __builtin_amdgcn_sched_barrier(0); } \
        if (MASKED) {   \
            if (MODE == 2) { if (qrow - seq0 < 128) { const int lim = E - imax; _Pragma("unroll") for (int r = 0; r < 16; ++r) { const int c0 = (r & 3) + 8 * (r >> 2), c1 = c0 + 32; \
                if (c0 < lim) p0[r] = -INFINITY; if (c1 < lim) p1[r] = -INFINITY; } } } \
            else if (MODE == 1) { _Pragma("unroll") for (int r = 0; r < 16; ++r) { const int c0 = (r & 3) + 8 * (r >> 2), c1 = c0 + 32; if (c0 > E) p0[r] = -INFINITY; if (c1 > E) p1[r] = -INFINITY; } } } \
        float ta = MX3(p0[0], p0[1], p1[0]), tb = MX3(p0[2], p0[3], p1[1]); ta = MX3(ta, p1[2], p1[3]); \
        _Pragma("unroll") for (int r = 4; r < 16; r += 4) { ta = MX3(ta, p0[r], p0[r + 1]); tb = MX3(tb, p0[r + 2], p0[r + 3]); ta = MX3(ta, p1[r], p1[r + 1]); tb = MX3(tb, p1[r + 2], p1[r + 3]); } \
        const float tm = xhalf_max(__builtin_fmaxf(ta, tb)); \
        bool resc = false; float al = 1.0f; \
        if (__any(tm > THR)) { const float dl = __builtin_fmaxf(tm, 0.f); m_run += dl; al = __builtin_amdgcn_exp2f(-dl); l_run *= al; resc = true; \
            _Pragma("unroll") for (int r = 0; r < 16; ++r) { p0[r] -= dl; p1[r] -= dl; negm[r] -= dl; } } \
        float rs0 = 0.f, rs1 = 0.f; \
        _Pragma("unroll") for (int r = 0; r < 16; ++r) { p0[r] = __builtin_amdgcn_exp2f(p0[r]); p1[r] = __builtin_amdgcn_exp2f(p1[r]); rs0 += p0[r]; rs1 += p1[r]; } \
        l_run += rs0 + rs1; \
        _Pragma("unroll") for (int ks = 0; ks < 4; ++ks) { v4u w; \
            if (ks < 2) { w.x = cvtpk_s(p0[8 * ks], p0[8 * ks + 1]); w.y = cvtpk_s(p0[8 * ks + 2], p0[8 * ks + 3]); w.z = cvtpk_s(p0[8 * ks + 4], p0[8 * ks + 5]); w.w = cvtpk_s(p0[8 * ks + 6], p0[8 * ks + 7]); } \
            else { const int k2 = ks - 2; w.x = cvtpk_s(p1[8 * k2], p1[8 * k2 + 1]); w.y = cvtpk_s(p1[8 * k2 + 2], p1[8 * k2 + 3]); w.z = cvtpk_s(p1[8 * k2 + 4], p1[8 * k2 + 5]); w.w = cvtpk_s(p1[8 * k2 + 6], p1[8 * k2 + 7]); } \
            pw[ks] = __builtin_bit_cast(bf16x8, w); } \
        if (resc) { _Pragma("unroll") for (int i = 0; i < NDB; ++i) _Pragma("unroll") for (int r = 0; r < 16; ++r) o[i][r] *= al; } \
        pend = true; pend_vs = MODE == 2 ? ((t) - tlo) * 8192 : ((t) & 3) * 16384; } while (0)
    constexpr int NPT = NKL + NVL;
#ifdef PROBE_ATT
    unsigned long long pt0_ = 0; const bool pr_ = ((PROBE_ATT >> MODE) & 1) && blockIdx.x == 0 && tid == 0; if (pr_) pt0_ = __builtin_amdgcn_s_memrealtime();
#endif
    asm volatile("s_waitcnt vmcnt(0) lgkmcnt(0)" ::: "memory");
    if (MODE == 2) {
        for (int t = tlo; t <= thi; ++t) AT_DMA(t);
        AT_WAITBAR(0);
        for (int t = tlo; t <= thi; ++t) {
            const int klo = qrow - 128 > seq0 ? qrow - 128 : seq0;
            const bool active = (64 * t <= qrow + 31) && (64 * t + 63 >= klo);
            if (active) AT_STEP(true, t);
        }
    } else {
    AT_DMA(tlo); if (tlo < thi) AT_DMA(tlo + 1);
    if (tlo < thi) { if (NPT == 4) AT_WAITBAR(4); else AT_WAITBAR(2); } else AT_WAITBAR(0);
    const int tband = thi - (MODE == 0 ? 1 : 3);
    int t = tlo;
    for (; t < tband; ++t) {
        AT_DMA(t + 2);
        AT_STEP(false, t);
        if (NPT == 4) AT_WAITBAR(4); else AT_WAITBAR(2);
    }
    for (; t <= thi; ++t) {
        if (t + 2 <= thi) AT_DMA(t + 2);
        const bool active = 64 * t <= qrow + 31;
        if (active) AT_STEP(true, t);
        else if (pend) { AT_PV(); pend = false; }
        if (t + 2 <= thi) { if (NPT == 4) AT_WAITBAR(4); else AT_WAITBAR(2); } else AT_WAITBAR(0);
    }
    }
    if (pend) AT_PV();
#ifdef PROBE_ATT
    if (pr_) { volatile LAS unsigned long long* q_ = (volatile LAS unsigned long long*)(lds + LDSCTL_OFF + 64); q_[1] += __builtin_amdgcn_s_memrealtime() - pt0_; }
#endif
    asm volatile("s_waitcnt lgkmcnt(0)\n\ts_barrier" ::: "memory");
#undef AT_STEP
#undef MX3
#undef AT_PV
#undef AT_DMA
#undef AT_WAITBAR
    const float lt = xhalf_sum(l_run), inv = 1.0f / lt;
#pragma unroll
    for (int i = 0; i < NDB; ++i)
#pragma unroll
        for (int r = 0; r < 16; ++r) o[i][r] *= inv;
    if (MODE == 2) { if (hi == 0) a.lse[(size_t)(qrow + r32) * 8] = m_run + __builtin_amdgcn_logf(lt); }
    bool store = true;
    if (MODE == 0) {
        LAS float* xch = (LAS float*)(lds + AL_XCH) + wq * 4096;
        if (map == 1) {
#pragma unroll
            for (int i = 0; i < NDB; ++i)
#pragma unroll
                for (int r = 0; r < 16; ++r) xch[(i * 16 + r) * 64 + lane] = o[i][r];
        }
        __syncthreads();
        if (map == 0) {
            float ss = 0.f;
#pragma unroll
            for (int i = 0; i < NDB; ++i)
#pragma unroll
                for (int r = 0; r < 16; ++r) { const float v = o[i][r] - a.lam * xch[(i * 16 + r) * 64 + lane]; o[i][r] = v; ss += v * v; }
            ss = xhalf_sum(ss);
            const float rn = (1.0f / sqrtf(ss * (1.0f / 128.0f) + EPS)) * a.osc;
#pragma unroll
            for (int i = 0; i < NDB; ++i)
#pragma unroll
                for (int g = 0; g < 4; ++g) { const f32x4 sg = *(const f32x4*)(a.subg + 32 * i + 8 * g + 4 * hi);
                    o[i][4 * g] *= rn * sg.x; o[i][4 * g + 1] *= rn * sg.y; o[i][4 * g + 2] *= rn * sg.z; o[i][4 * g + 3] *= rn * sg.w; }
        }
        store = map == 0;
    }
    if (store) {
        constexpr int RS = DV * 2 + 16;
        LAS unsigned char* ost = lds + AL_OST + wq * (32 * RS);
#pragma unroll
        for (int i = 0; i < NDB; ++i)
#pragma unroll
            for (int g = 0; g < 4; ++g) { v2u w; w.x = cvtpk_s(o[i][4 * g], o[i][4 * g + 1]); w.y = cvtpk_s(o[i][4 * g + 2], o[i][4 * g + 3]);
                *(LAS v2u*)(ost + r32 * RS + (32 * i + 8 * g + 4 * hi) * 2) = w; }
        LDS_WAIT();
        bf16_t* Ow = a.q + (size_t)qrow * QP;
        constexpr int CPR = DV / 8, RPI = 64 / CPR;
#pragma unroll
        for (int i = 0; i < 32 / RPI; ++i) { const int row = i * RPI + lane / CPR, ch = lane % CPR;
            const v4u v = *(const LAS v4u*)(ost + row * RS + ch * 16); *(GAS v4u*)(Ow + (size_t)row * QP + ch * 8) = v; }
    }
    __syncthreads();
}
__device__ const unsigned short SCHED_AC[256][6] = {
{0,848,1280,65535,65535,65535},
{1,849,1281,65535,65535,65535},
{2,850,1282,65535,65535,65535},
{3,851,1283,65535,65535,65535},
{4,852,1284,65535,65535,65535},
{5,853,1285,65535,65535,65535},
{6,854,1286,65535,65535,65535},
{7,855,1287,65535,65535,65535},
{8,856,1288,65535,65535,65535},
{9,857,1289,65535,65535,65535},
{10,858,1290,65535,65535,65535},
{11,859,1291,65535,65535,65535},
{12,860,1292,65535,65535,65535},
{13,861,1293,65535,65535,65535},
{14,862,1294,65535,65535,65535},
{15,863,1295,65535,65535,65535},
{16,864,1296,65535,65535,65535},
{17,865,1297,65535,65535,65535},
{18,866,1298,65535,65535,65535},
{19,867,1299,65535,65535,65535},
{20,868,1300,65535,65535,65535},
{21,869,1301,65535,65535,65535},
{22,870,1302,65535,65535,65535},
{23,871,1303,65535,65535,65535},
{24,872,1304,65535,65535,65535},
{25,873,1305,65535,65535,65535},
{26,874,1306,65535,65535,65535},
{27,875,1307,65535,65535,65535},
{28,876,1308,65535,65535,65535},
{29,877,1309,65535,65535,65535},
{30,878,1310,65535,65535,65535},
{31,879,1311,65535,65535,65535},
{64,784,1216,1344,65535,65535},
{65,785,1217,1345,65535,65535},
{66,786,1218,1346,65535,65535},
{67,787,1219,1347,65535,65535},
{68,788,1220,1348,65535,65535},
{69,789,1221,1349,65535,65535},
{70,790,1222,1350,65535,65535},
{71,791,1223,1351,65535,65535},
{72,792,1224,1352,65535,65535},
{73,793,1225,1353,65535,65535},
{74,794,1226,1354,65535,65535},
{75,795,1227,1355,65535,65535},
{76,796,1228,1356,65535,65535},
{77,797,1229,1357,65535,65535},
{78,798,1230,1358,65535,65535},
{79,799,1231,1359,65535,65535},
{80,832,1184,65535,65535,65535},
{81,833,1185,65535,65535,65535},
{82,834,1186,65535,65535,65535},
{83,835,1187,65535,65535,65535},
{84,836,1188,65535,65535,65535},
{85,837,1189,65535,65535,65535},
{86,838,1190,65535,65535,65535},
{87,839,1191,65535,65535,65535},
{88,840,1192,65535,65535,65535},
{89,841,1193,65535,65535,65535},
{90,842,1194,65535,65535,65535},
{91,843,1195,65535,65535,65535},
{92,844,1196,65535,65535,65535},
{93,845,1197,65535,65535,65535},
{94,846,1198,65535,65535,65535},
{95,847,1199,65535,65535,65535},
{128,736,1232,1360,65535,65535},
{129,737,1233,1361,65535,65535},
{130,738,1234,1362,65535,65535},
{131,739,1235,1363,65535,65535},
{132,740,1236,1364,65535,65535},
{133,741,1237,1365,65535,65535},
{134,742,1238,1366,65535,65535},
{135,743,1239,1367,65535,65535},
{136,744,1240,1368,65535,65535},
{137,745,1241,1369,65535,65535},
{138,746,1242,1370,65535,65535},
{139,747,1243,1371,65535,65535},
{140,748,1244,1372,65535,65535},
{141,749,1245,1373,65535,65535},
{142,750,1246,1374,65535,65535},
{143,751,1247,1375,65535,65535},
{144,768,1104,1408,65535,65535},
{145,769,1105,1409,65535,65535},
{146,770,1106,1410,65535,65535},
{147,771,1107,1411,65535,65535},
{148,772,1108,1412,65535,65535},
{149,773,1109,1413,65535,65535},
{150,774,1110,1414,65535,65535},
{151,775,1111,1415,65535,65535},
{152,776,1112,1416,65535,65535},
{153,777,1113,1417,65535,65535},
{154,778,1114,1418,65535,65535},
{155,779,1115,1419,65535,65535},
{156,780,1116,1420,65535,65535},
{157,781,1117,1421,65535,65535},
{158,782,1118,1422,65535,65535},
{159,783,1119,1423,65535,65535},
{192,704,1152,1424,65535,65535},
{193,705,1153,1425,65535,65535},
{194,706,1154,1426,65535,65535},
{195,707,1155,1427,65535,65535},
{196,708,1156,1428,65535,65535},
{197,709,1157,1429,65535,65535},
{198,710,1158,1430,65535,65535},
{199,711,1159,1431,65535,65535},
{200,712,1160,1432,65535,65535},
{201,713,1161,1433,65535,65535},
{202,714,1162,1434,65535,65535},
{203,715,1163,1435,65535,65535},
{204,716,1164,1436,65535,65535},
{205,717,1165,1437,65535,65535},
{206,718,1166,1438,65535,65535},
{207,719,1167,1439,65535,65535},
{208,720,1168,1440,65535,65535},
{209,721,1169,1441,65535,65535},
{210,722,1170,1442,65535,65535},
{211,723,1171,1443,65535,65535},
{212,724,1172,1444,65535,65535},
{213,725,1173,1445,65535,65535},
{214,726,1174,1446,65535,65535},
{215,727,1175,1447,65535,65535},
{216,728,1176,1448,65535,65535},
{217,729,1177,1449,65535,65535},
{218,730,1178,1450,65535,65535},
{219,731,1179,1451,65535,65535},
{220,732,1180,1452,65535,65535},
{221,733,1181,1453,65535,65535},
{222,734,1182,1454,65535,65535},
{223,735,1183,1455,65535,65535},
{256,640,896,65535,65535,65535},
{257,641,897,65535,65535,65535},
{258,642,898,65535,65535,65535},
{259,643,899,65535,65535,65535},
{260,644,900,65535,65535,65535},
{261,645,901,65535,65535,65535},
{262,646,902,65535,65535,65535},
{263,647,903,65535,65535,65535},
{264,648,904,65535,65535,65535},
{265,649,905,65535,65535,65535},
{266,650,906,65535,65535,65535},
{267,651,907,65535,65535,65535},
{268,652,908,65535,65535,65535},
{269,653,909,65535,65535,65535},
{270,654,910,65535,65535,65535},
{271,655,911,65535,65535,65535},
{272,656,912,65535,65535,65535},
{273,657,913,65535,65535,65535},
{274,658,914,65535,65535,65535},
{275,659,915,65535,65535,65535},
{276,660,916,65535,65535,65535},
{277,661,917,65535,65535,65535},
{278,662,918,65535,65535,65535},
{279,663,919,65535,65535,65535},
{280,664,920,65535,65535,65535},
{281,665,921,65535,65535,65535},
{282,666,922,65535,65535,65535},
{283,667,923,65535,65535,65535},
{284,668,924,65535,65535,65535},
{285,669,925,65535,65535,65535},
{286,670,926,65535,65535,65535},
{287,671,927,65535,65535,65535},
{320,576,960,65535,65535,65535},
{321,577,961,65535,65535,65535},
{322,578,962,65535,65535,65535},
{323,579,963,65535,65535,65535},
{324,580,964,65535,65535,65535},
{325,581,965,65535,65535,65535},
{326,582,966,65535,65535,65535},
{327,583,967,65535,65535,65535},
{328,584,968,65535,65535,65535},
{329,585,969,65535,65535,65535},
{330,586,970,65535,65535,65535},
{331,587,971,65535,65535,65535},
{332,588,972,65535,65535,65535},
{333,589,973,65535,65535,65535},
{334,590,974,65535,65535,65535},
{335,591,975,65535,65535,65535},
{336,592,976,65535,65535,65535},
{337,593,977,65535,65535,65535},
{338,594,978,65535,65535,65535},
{339,595,979,65535,65535,65535},
{340,596,980,65535,65535,65535},
{341,597,981,65535,65535,65535},
{342,598,982,65535,65535,65535},
{343,599,983,65535,65535,65535},
{344,600,984,65535,65535,65535},
{345,601,985,65535,65535,65535},
{346,602,986,65535,65535,65535},
{347,603,987,65535,65535,65535},
{348,604,988,65535,65535,65535},
{349,605,989,65535,65535,65535},
{350,606,990,65535,65535,65535},
{351,607,991,65535,65535,65535},
{384,512,992,65535,65535,65535},
{385,513,993,65535,65535,65535},
{386,514,994,65535,65535,65535},
{387,515,995,65535,65535,65535},
{388,516,996,65535,65535,65535},
{389,517,997,65535,65535,65535},
{390,518,998,65535,65535,65535},
{391,519,999,65535,65535,65535},
{392,520,1000,65535,65535,65535},
{393,521,1001,65535,65535,65535},
{394,522,1002,65535,65535,65535},
{395,523,1003,65535,65535,65535},
{396,524,1004,65535,65535,65535},
{397,525,1005,65535,65535,65535},
{398,526,1006,65535,65535,65535},
{399,527,1007,65535,65535,65535},
{400,528,1024,1472,65535,65535},
{401,529,1025,1473,65535,65535},
{402,530,1026,1474,65535,65535},
{403,531,1027,1475,65535,65535},
{404,532,1028,1476,65535,65535},
{405,533,1029,1477,65535,65535},
{406,534,1030,1478,65535,65535},
{407,535,1031,1479,65535,65535},
{408,536,1032,1480,65535,65535},
{409,537,1033,1481,65535,65535},
{410,538,1034,1482,65535,65535},
{411,539,1035,1483,65535,65535},
{412,540,1036,1484,65535,65535},
{413,541,1037,1485,65535,65535},
{414,542,1038,1486,65535,65535},
{415,543,1039,1487,65535,65535},
{416,544,1040,1488,65535,65535},
{417,545,1041,1489,65535,65535},
{418,546,1042,1490,65535,65535},
{419,547,1043,1491,65535,65535},
{420,548,1044,1492,65535,65535},
{421,549,1045,1493,65535,65535},
{422,550,1046,1494,65535,65535},
{423,551,1047,1495,65535,65535},
{424,552,1048,1496,65535,65535},
{425,553,1049,1497,65535,65535},
{426,554,1050,1498,65535,65535},
{427,555,1051,1499,65535,65535},
{428,556,1052,1500,65535,65535},
{429,557,1053,1501,65535,65535},
{430,558,1054,1502,65535,65535},
{431,559,1055,1503,65535,65535},
{448,464,1088,1312,65535,65535},
{449,465,1089,1313,65535,65535},
{450,466,1090,1314,65535,65535},
{451,467,1091,1315,65535,65535},
{452,468,1092,1316,65535,65535},
{453,469,1093,1317,65535,65535},
{454,470,1094,1318,65535,65535},
{455,471,1095,1319,65535,65535},
{456,472,1096,1320,65535,65535},
{457,473,1097,1321,65535,65535},
{458,474,1098,1322,65535,65535},
{459,475,1099,1323,65535,65535},
{460,476,1100,1324,65535,65535},
{461,477,1101,1325,65535,65535},
{462,478,1102,1326,65535,65535},
{463,479,1103,1327,65535,65535}
};

static_assert(LUTA_N == 2240 && LUTB_N == 384, "table sizes vs the MISC map");
__device__ __forceinline__ int t5_bucket(int n) {
    if (n < 16) return n < 0 ? 0 : n;
    int b = 16;
    b += n >= 22; b += n >= 30; b += n >= 40; b += n >= 54; b += n >= 73; b += n >= 99; b += n >= 134; b += n >= 182; b += n >= 246; b += n >= 332; b += n >= 450; b += n >= 609; b += n >= 825; b += n >= 1117; b += n >= 1513;
    return b;
}
__device__ __forceinline__ void build_luts(const Params& p, int tid) {
    float* misc = (float*)(p.ws + WS_MISC); const float* rb = p.in[13];
    for (int i = blockIdx.x * NTHR + tid; i < 2 * D * 8; i += gridDim.x * NTHR) { const int l = i >> 13, d = (i >> 3) & 1023, e = i & 7; misc[MI_WF + i] = e < 6 ? p.in[6][(size_t)l * D * NIN + (size_t)d * NIN + 6144 + e] : 0.f; }
    for (int i = blockIdx.x * NTHR + tid; i < 8 * LUTA_N + 18 * LUTB_N; i += gridDim.x * NTHR) {
        if (i < 8 * LUTA_N) { const int hm = i / LUTA_N, j = i % LUTA_N, d = 2047 - j; misc[MI_LUTA + i] = d >= 0 ? rb[t5_bucket(d) * 26 + hm] * LOG2E : -INFINITY; }
        else { const int k = i - 8 * LUTA_N, gh = k / LUTB_N, j = k % LUTB_N, ii = 255 - j, g = gh / 6; misc[MI_LUTB + k] = (ii >= 0 && ii <= 128) ? rb[t5_bucket(ii << (2 * g)) * 26 + 8 + gh] * LOG2E : -INFINITY; }
    }
}
__device__ __forceinline__ void norm_logf(const Params& p, int L, const float* x, const float* g, const float* sc, const float* sh, bf16_t* h, LAS unsigned char* lds, int tid, int lane, int wave) {
    LAS float* wf = (LAS float*)lds;
    const float* w_in = p.in[6] + (size_t)L * D * NIN;
    { const float* src = (const float*)(p.ws + WS_MISC) + MI_WF + L * D * 8; f32x4 tv[4];
#pragma unroll
      for (int k = 0; k < 4; ++k) tv[k] = *(const GAS f32x4*)(src + (tid + k * NTHR) * 4);
#pragma unroll
      for (int k = 0; k < 4; ++k) *(LAS f32x4*)(wf + (tid + k * NTHR) * 4) = tv[k]; }
    (void)w_in;
    __syncthreads();
    const int gw = blockIdx.x * NWAVES + wave, NGW = gridDim.x * NWAVES;
    float* logf = (float*)(p.ws + WS_MISC) + MI_LOGF;
    const float bfv = lane < 6 ? p.in[7][L * 6 + lane] : 0.f;
    f32x4 vn[4], vm[4];
    { const int tf = (gw < T) ? gw : 0, tg = (gw + NGW < T) ? gw + NGW : tf; const GAS f32x4* xn = (const GAS f32x4*)(x + (size_t)tf * D) + lane; const GAS f32x4* xm = (const GAS f32x4*)(x + (size_t)tg * D) + lane;
#pragma unroll
      for (int j = 0; j < 4; ++j) { vn[j] = xn[64 * j]; vm[j] = xm[64 * j]; } }
    constexpr int TEND = T;
    for (int t = gw; t < T; t += NGW) {
        const int b = t >> 11;
        f32x4 v[4]; float s = 0.f;
#pragma unroll
        for (int j = 0; j < 4; ++j) { v[j] = vn[j]; vn[j] = vm[j]; s += (v[j].x * v[j].x + v[j].y * v[j].y) + (v[j].z * v[j].z + v[j].w * v[j].w); }
        { const int tn = (t + 2 * NGW < TEND) ? t + 2 * NGW : t; const GAS f32x4* xn = (const GAS f32x4*)(x + (size_t)tn * D) + lane;
#pragma unroll
          for (int j = 0; j < 4; ++j) vm[j] = xn[64 * j]; }
        const float r = 1.0f / sqrtf(wave_sum(s) * (1.0f / D) + EPS);
        GAS v2u* o8 = (GAS v2u*)(h + (size_t)t * D) + lane;
        float lg[8];
#pragma unroll
        for (int e = 0; e < 8; ++e) lg[e] = 0.f;
#pragma unroll
        for (int j = 0; j < 4; ++j) { const int d = 4 * lane + 256 * j;
            const f32x4 g4 = *(const f32x4*)(g + d), c4 = *(const f32x4*)(sc + (size_t)b * 6 * D + d), h4 = *(const f32x4*)(sh + (size_t)b * 6 * D + d);
            const f32x4 o = v[j] * r * g4 * (c4 + 1.0f) + h4;
            v2u w; w.x = pk2(o.x, o.y); w.y = pk2(o.z, o.w); o8[64 * j] = w;
#pragma unroll
            for (int cc = 0; cc < 4; ++cc) { const f32x4 w0 = *(const LAS f32x4*)(wf + (d + cc) * 8), w1 = *(const LAS f32x4*)(wf + (d + cc) * 8 + 4); const float ov = o[cc];
                lg[0] += ov * w0.x; lg[1] += ov * w0.y; lg[2] += ov * w0.z; lg[3] += ov * w0.w; lg[4] += ov * w1.x; lg[5] += ov * w1.y; } }
        float mine = 0.f;
#pragma unroll
        for (int e = 0; e < 6; ++e) { const float sm = wave_sum(lg[e]); if (lane == e) mine = sm; }
        if (lane < 6) { const float z = mine + bfv; logf[(size_t)t * 8 + lane] = fminf(z, 0.f) - log1pf(__expf(-fabsf(z))); }
    }
}
__device__ __forceinline__ void negf_cumsum(const Params& p, int b, int hh, int lane) {
    const float* logf = (const float*)(p.ws + WS_MISC) + MI_LOGF + (size_t)b * S * 8 + hh;
    float* nf = (float*)(p.ws + WS_MISC) + MI_NEGF + (size_t)(b * 6 + hh) * S;
    float run = 0.f; float loc[32];
#pragma unroll
    for (int i = 0; i < 32; ++i) { run += logf[(size_t)(lane * 32 + i) * 8]; loc[i] = run; }
    float incl = run;
#pragma unroll
    for (int o = 1; o < 64; o <<= 1) { const float u = __shfl_up(incl, o); if (lane >= o) incl += u; }
    const float excl = incl - run;
#pragma unroll
    for (int i = 0; i < 32; ++i) nf[lane * 32 + i] = -(excl + loc[i]) * LOG2E;
}
__device__ __forceinline__ void merge_b(const Params& p, int lane, int wave) {
    bf16_t* proj = (bf16_t*)(p.ws + WS_QO); const float* lse = (const float*)(p.ws + WS_MISC) + MI_LSE;
    const int gw = blockIdx.x * NWAVES + wave, NGW = gridDim.x * NWAVES;
    for (int r = gw; r < CH_T; r += NGW) {
        if (lane < 48) {
            const int t = r & 2047, base = r & ~2047, h = lane >> 3;
            const int r1 = base | ((t & 3) << 9) | (t >> 2), r2 = base | ((t & 15) << 7) | (t >> 4);
            const float l0 = lse[(size_t)r * 8 + h], l1 = lse[(size_t)(CH_T + r1) * 8 + h], l2 = lse[(size_t)(2 * CH_T + r2) * 8 + h];
            const float mx = fmaxf(l0, fmaxf(l1, l2));
            float a0 = __builtin_amdgcn_exp2f(l0 - mx), a1 = __builtin_amdgcn_exp2f(l1 - mx), a2 = __builtin_amdgcn_exp2f(l2 - mx);
            const float is = 1.0f / (a0 + a1 + a2); a0 *= is; a1 *= is; a2 *= is;
            const v4u o0 = *(const GAS v4u*)(proj + (size_t)r * QP + 512 + lane * 8), o1 = *(const GAS v4u*)(proj + (size_t)r1 * QP + 512 + 384 + lane * 8), o2 = *(const GAS v4u*)(proj + (size_t)r2 * QP + 512 + 768 + lane * 8);
            v4u w;
            w.x = pk2(a0 * pg8::bf_lo(o0.x) + a1 * pg8::bf_lo(o1.x) + a2 * pg8::bf_lo(o2.x), a0 * pg8::bf_hi(o0.x) + a1 * pg8::bf_hi(o1.x) + a2 * pg8::bf_hi(o2.x));
            w.y = pk2(a0 * pg8::bf_lo(o0.y) + a1 * pg8::bf_lo(o1.y) + a2 * pg8::bf_lo(o2.y), a0 * pg8::bf_hi(o0.y) + a1 * pg8::bf_hi(o1.y) + a2 * pg8::bf_hi(o2.y));
            w.z = pk2(a0 * pg8::bf_lo(o0.z) + a1 * pg8::bf_lo(o1.z) + a2 * pg8::bf_lo(o2.z), a0 * pg8::bf_hi(o0.z) + a1 * pg8::bf_hi(o1.z) + a2 * pg8::bf_hi(o2.z));
            w.w = pk2(a0 * pg8::bf_lo(o0.w) + a1 * pg8::bf_lo(o1.w) + a2 * pg8::bf_lo(o2.w), a0 * pg8::bf_hi(o0.w) + a1 * pg8::bf_hi(o1.w) + a2 * pg8::bf_hi(o2.w));
            *(GAS v4u*)(proj + (size_t)r * QP + 512 + lane * 8) = w;
        }
    }
}
__device__ __forceinline__ void attn_b_phase(const Params& p, LAS unsigned char* lds, int tid, int lane, int wave) {
    const float* misc = (const float*)(p.ws + WS_MISC);
    for (int L = blockIdx.x; L < CH_B * 3 * 6 * 8; L += gridDim.x) {
        const int blk = L & 7, h = (L >> 3) % 6; int g, b; if (L < 768) { g = (L / 48) & 1; b = L / 96; } else { g = 2; b = (L - 768) / 48; }
        AttnArgs a; a.q0 = blk * 256; a.q = (bf16_t*)(p.ws + WS_QO) + (size_t)(b * S) * QP + 512 + g * 384 + h * 64;
        a.k = (const bf16_t*)(p.ws + WS_KV) + KVB0 + (size_t)(((b * 3 + g) * 6 + h) * 2) * (2048 * 64); a.v = a.k + 2048 * 64;
        a.tab = misc + MI_LUTB + (g * 6 + h) * LUTB_N; a.seqM = S >> (2 * g); a.lse = (float*)(p.ws + WS_MISC) + MI_LSE + ((size_t)g * CH_T + (size_t)b * S) * 8 + h; a.lam = 0.f; a.osc = 0.f; a.subg = nullptr;
        attn_unit<2>(a, lds, tid, lane, wave);
    }
}
__device__ __forceinline__ void attn_ac_phase(const Params& p, int L, int c, LAS unsigned char* lds, int tid, int lane, int wave) {
    const float* misc = (const float*)(p.ws + WS_MISC);
    constexpr unsigned char CTYPE[24] = {0,0,0,0,0,0,1,0,1,0,0,1,0,1,0,1,0,0,1,0,1,0,1,0}, CQB[24] = {15,14,13,12,11,10,7,9,6,8,7,5,6,4,5,3,4,3,2,2,1,1,0,0};
    constexpr unsigned short CFIRST[25] = {0,32,64,96,128,160,192,240,272,320,352,384,432,464,512,544,592,624,656,704,736,784,816,864,896};
    const bool lpt = gridDim.x == 256;
#pragma unroll 1
    for (int i = 0; ; ++i) {
        int cls, k;
        if (lpt) { if (i >= 6) break; const unsigned e = SCHED_AC[blockIdx.x][i]; if (e == 0xFFFFu) break; cls = (int)(e >> 6); k = (int)(e & 63u); }
        else { const int j = i * (int)gridDim.x + (int)blockIdx.x; if (j >= 896) break; cls = 0; for (int q = 1; q < 24; ++q) if ((int)CFIRST[q] <= j) cls = q; k = j - (int)CFIRST[cls]; }
        cls = __builtin_amdgcn_readfirstlane(cls); k = __builtin_amdgcn_readfirstlane(k);
        if (CTYPE[cls] != 0) continue;
        const int qb = CQB[cls], b = k >> 2, h = k & 3;
        AttnArgs a; a.seqM = 0; a.lse = nullptr; a.q0 = qb * 128; a.q = (bf16_t*)(p.ws + WS_QO) + (size_t)(b * S) * QP + h * 128;
        a.k = (const bf16_t*)(p.ws + WS_KV) + (size_t)((b * 4 + h) * 2) * (2048 * 128); a.v = a.k + 2048 * 128;
        a.tab = misc + MI_LUTA + 2 * h * LUTA_N; a.lam = misc[MI_LAM + L]; a.osc = 1.0f - misc[MI_LAM + 8 + L]; a.subg = p.in[12] + L * 128;
        attn_unit<0>(a, lds, tid, lane, wave);
    }
#pragma unroll 1
    for (int i = 0; ; ++i) {
        int cls, k;
        if (lpt) { if (i >= 6) break; const unsigned e = SCHED_AC[blockIdx.x][i]; if (e == 0xFFFFu) break; cls = (int)(e >> 6); k = (int)(e & 63u); }
        else { const int j = i * (int)gridDim.x + (int)blockIdx.x; if (j >= 896) break; cls = 0; for (int q = 1; q < 24; ++q) if ((int)CFIRST[q] <= j) cls = q; k = j - (int)CFIRST[cls]; }
        cls = __builtin_amdgcn_readfirstlane(cls); k = __builtin_amdgcn_readfirstlane(k);
        if (CTYPE[cls] != 1) continue;
        const int qb = CQB[cls], b = k / 6, h = k % 6;
        AttnArgs a; a.seqM = 0; a.lse = nullptr; a.q0 = qb * 256; a.q = (bf16_t*)(p.ws + WS_QO) + (size_t)(b * S) * QP + 1664 + h * 64;
        a.k = (const bf16_t*)(p.ws + WS_KV) + KVC0 + (size_t)((b * 6 + h) * 2) * (2048 * 64); a.v = a.k + 2048 * 64;
        a.tab = misc + MI_NEGF + (size_t)((c * CH_B + b) * 6 + h) * S; a.lam = 0.f; a.osc = 0.f; a.subg = nullptr;
        attn_unit<1>(a, lds, tid, lane, wave);
    }
    merge_b(p, lane, wave);
}

constexpr int RT_WR = 0, RT_CNT = D * NE * 4, RT_REC = RT_CNT + 64, RT_RECW = 64;
__device__ __forceinline__ void norm_route(const Params& p, const float* g, const float* sc, const float* sh, bf16_t* h, LAS unsigned char* lds, int tid, int lane, int wave) {
    LAS float* wr = (LAS float*)(lds + RT_WR); LAS unsigned* lcnt = (LAS unsigned*)(lds + RT_CNT); LAS unsigned* lbase = lcnt + 8;
    LAS int* rec = (LAS int*)(lds + RT_REC) + wave * (RT_RECW * 8);
    { f32x4 tv[4];
#pragma unroll
      for (int k = 0; k < 4; ++k) tv[k] = *(const GAS f32x4*)(p.in[21] + (tid + k * NTHR) * 4);
#pragma unroll
      for (int k = 0; k < 4; ++k) *(LAS f32x4*)(wr + (tid + k * NTHR) * 4) = tv[k]; }
    if (tid < 16) lcnt[tid] = 0u;
    __syncthreads();
    const int gw = blockIdx.x * NWAVES + wave, NGW = gridDim.x * NWAVES;
    const float* x = p.out;
    int k = 0;
    f32x4 vn[4], vm[4];
    { const int tf = (gw < T) ? gw : 0, tg = (gw + NGW < T) ? gw + NGW : tf; const GAS f32x4* xn = (const GAS f32x4*)(x + (size_t)tf * D) + lane; const GAS f32x4* xm = (const GAS f32x4*)(x + (size_t)tg * D) + lane;
#pragma unroll
      for (int j = 0; j < 4; ++j) { vn[j] = xn[64 * j]; vm[j] = xm[64 * j]; } }
    constexpr int TEND = T;
    for (int t = gw; t < T && k < RT_RECW; t += NGW, ++k) {
        const int b = t >> 11;
        f32x4 v[4]; float s = 0.f;
#pragma unroll
        for (int j = 0; j < 4; ++j) { v[j] = vn[j]; vn[j] = vm[j]; s += (v[j].x * v[j].x + v[j].y * v[j].y) + (v[j].z * v[j].z + v[j].w * v[j].w); }
        { const int tn = (t + 2 * NGW < TEND) ? t + 2 * NGW : t; const GAS f32x4* xn = (const GAS f32x4*)(x + (size_t)tn * D) + lane;
#pragma unroll
          for (int j = 0; j < 4; ++j) vm[j] = xn[64 * j]; }
        const float r = 1.0f / sqrtf(wave_sum(s) * (1.0f / D) + EPS);
        GAS v2u* o8 = (GAS v2u*)(h + (size_t)t * D) + lane;
        float lg[NE];
#pragma unroll
        for (int e = 0; e < NE; ++e) lg[e] = 0.f;
#pragma unroll
        for (int j = 0; j < 4; ++j) { const int d = 4 * lane + 256 * j;
            const f32x4 g4 = *(const f32x4*)(g + d), c4 = *(const f32x4*)(sc + (size_t)b * 6 * D + d), h4 = *(const f32x4*)(sh + (size_t)b * 6 * D + d);
            const f32x4 o = v[j] * r * g4 * (c4 + 1.0f) + h4;
            v2u w; w.x = pk2(o.x, o.y); w.y = pk2(o.z, o.w); o8[64 * j] = w;
#pragma unroll
            for (int cc = 0; cc < 4; ++cc) { const f32x4 w0 = *(const LAS f32x4*)(wr + (d + cc) * NE), w1 = *(const LAS f32x4*)(wr + (d + cc) * NE + 4); const float ov = o[cc];
                lg[0] += ov * w0.x; lg[1] += ov * w0.y; lg[2] += ov * w0.z; lg[3] += ov * w0.w; lg[4] += ov * w1.x; lg[5] += ov * w1.y; lg[6] += ov * w1.z; lg[7] += ov * w1.w; } }
#pragma unroll
        for (int e = 0; e < NE; ++e) lg[e] = wave_sum(lg[e]);
        if (lane == 0) {
            int e0 = 0; float v0 = lg[0];
#pragma unroll
            for (int e = 1; e < NE; ++e) if (lg[e] > v0) { v0 = lg[e]; e0 = e; }
            int e1 = e0 == 0 ? 1 : 0; float v1 = lg[e1];
#pragma unroll
            for (int e = 0; e < NE; ++e) if (e != e0 && lg[e] > v1) { v1 = lg[e]; e1 = e; }
            const float w1 = 1.0f / (1.0f + __expf(v0 - v1)), w0 = 1.0f - w1;
            const unsigned lp0 = __hip_atomic_fetch_add(lcnt + e0, 1u, __ATOMIC_RELAXED, __HIP_MEMORY_SCOPE_WORKGROUP), lp1 = __hip_atomic_fetch_add(lcnt + e1, 1u, __ATOMIC_RELAXED, __HIP_MEMORY_SCOPE_WORKGROUP);
            LAS int* rc = rec + k * 8; rc[0] = t; rc[1] = e0; rc[2] = e1; rc[3] = (int)lp0; rc[4] = (int)lp1; rc[5] = (int)__float_as_uint(w0); rc[6] = (int)__float_as_uint(w1);
        }
    }
    __syncthreads();
    unsigned* ctl = (unsigned*)(p.ws + WS_CTL);
    if (tid < NE) lbase[tid] = __hip_atomic_fetch_add(ctl + CW_CNT + tid, lcnt[tid], __ATOMIC_RELAXED, __HIP_MEMORY_SCOPE_AGENT);
    __syncthreads();
    unsigned* misc = (unsigned*)(p.ws + WS_MISC);
    if (lane < k) { const LAS int* rc = rec + lane * 8; const int t = rc[0], e0 = rc[1], e1 = rc[2];
        misc[MI_TOK_E + 2 * t] = (unsigned)e0; misc[MI_TOK_E + 2 * t + 1] = (unsigned)e1;
        misc[MI_TOK_POS + 2 * t] = lbase[e0] + (unsigned)rc[3]; misc[MI_TOK_POS + 2 * t + 1] = lbase[e1] + (unsigned)rc[4];
        misc[MI_TOK_W + 2 * t] = (unsigned)rc[5]; misc[MI_TOK_W + 2 * t + 1] = (unsigned)rc[6]; }
}
__device__ __forceinline__ void moe_scan_gather(const Params& p, LAS unsigned char* lds, int tid, int lane, int wave) {
    LAS unsigned* sseg = (LAS unsigned*)lds;
    unsigned* ctl = (unsigned*)(p.ws + WS_CTL); unsigned* misc = (unsigned*)(p.ws + WS_MISC);
    if (tid == 0) { unsigned a = 0u;
        for (int e = 0; e < NE; ++e) { const unsigned c = __hip_atomic_load(ctl + CW_CNT + e, __ATOMIC_RELAXED, __HIP_MEMORY_SCOPE_AGENT); sseg[e] = a; sseg[16 + e] = c; a += (c + 255u) & ~255u; }
        sseg[8] = a; }
    __syncthreads();
    const unsigned ntile = sseg[8] >> 8;
    if (blockIdx.x == 0) {
        if (tid < MOE_MAXT) { unsigned e = 0u; for (int q = 1; q < NE; ++q) if (sseg[q] <= 256u * (unsigned)tid) e = (unsigned)q; misc[MI_TILE_E + tid] = e; }
        if (tid == 0) misc[MI_TILE_E + 500] = ntile;
    }
    const bf16_t* h = (const bf16_t*)(p.ws + WS_H); bf16_t* hs = (bf16_t*)(p.ws + WS_HS);
    const int gw = blockIdx.x * NWAVES + wave, NGW = gridDim.x * NWAVES;
    const int nk = (T - gw + NGW - 1) / NGW;
    unsigned mr0 = 0u, mr1 = 0u;
    if (lane < nk) { const int t = gw + lane * NGW;
        const v2u ee = *(const GAS v2u*)(misc + MI_TOK_E + 2 * t), pp = *(const GAS v2u*)(misc + MI_TOK_POS + 2 * t), ww = *(const GAS v2u*)(misc + MI_TOK_W + 2 * t);
        mr0 = sseg[ee.x] + pp.x; mr1 = sseg[ee.y] + pp.y;
        misc[MI_ROW_W + mr0] = ww.x; misc[MI_ROW_W + mr1] = ww.y;
        v2u rr; rr.x = mr0; rr.y = mr1; *(GAS v2u*)(misc + MI_TOK_POS + 2 * t) = rr; }
    for (int k0 = 0; k0 < nk; k0 += 8) {
        v4u a[8], c[8];
#pragma unroll
        for (int i = 0; i < 8; ++i) { const int k = k0 + i < nk ? k0 + i : nk - 1; const int t = gw + k * NGW;
            a[i] = *(const GAS v4u*)(h + (size_t)t * D + lane * 8); c[i] = *(const GAS v4u*)(h + (size_t)t * D + 512 + lane * 8); }
#pragma unroll
        for (int i = 0; i < 8; ++i) { if (k0 + i < nk) { const unsigned r0 = (unsigned)__shfl((int)mr0, k0 + i), r1 = (unsigned)__shfl((int)mr1, k0 + i);
            *(GAS v4u*)(hs + (size_t)r0 * D + lane * 8) = a[i]; *(GAS v4u*)(hs + (size_t)r0 * D + 512 + lane * 8) = c[i];
            *(GAS v4u*)(hs + (size_t)r1 * D + lane * 8) = a[i]; *(GAS v4u*)(hs + (size_t)r1 * D + 512 + lane * 8) = c[i]; } }
    }
    if (blockIdx.x < NE) {
        const unsigned e = blockIdx.x, p0 = sseg[e] + sseg[16 + e], p1 = sseg[e + 1];
        for (unsigned r = p0 + (unsigned)wave; r < p1; r += NWAVES) { const v4u z = {0u, 0u, 0u, 0u};
            *(GAS v4u*)(hs + (size_t)r * D + lane * 8) = z; *(GAS v4u*)(hs + (size_t)r * D + 512 + lane * 8) = z; if (lane == 0) misc[MI_ROW_W + r] = 0u; }
    }
}
struct GroupedOrder {
    const unsigned* tile_e; int t0, t1, nN, G, c, a_pm_off; size_t bstride;
    __device__ __forceinline__ bool next(int i, pg8::Unit& u) const {
        const long L = (long)i * G + c; if (L >= (long)(t1 - t0) * nN) return false;
        u.pm = t0 + (int)(L / nN); u.pn = (int)(L % nN); u.e = __builtin_amdgcn_readfirstlane((int)tile_e[u.pm]); u.aux = 0; return true;
    }
    __device__ __forceinline__ const char* a_ptr(const pg8::Gemm& g, const pg8::Unit& u) const { return (const char*)g.A + (size_t)(u.pm - a_pm_off) * (size_t)(pg8::BM * 2) * g.lda; }
    __device__ __forceinline__ const char* b_ptr(const pg8::Gemm& g, const pg8::Unit& u) const { return (const char*)g.Bt + ((size_t)u.e * bstride + (size_t)u.pn * pg8::BM * g.K) * 2; }
    __device__ __forceinline__ int kt(const pg8::Gemm& g, const pg8::Unit&) const { return g.K / pg8::BK; }
    __device__ __forceinline__ bool last_seg(const pg8::Unit&) const { return true; }
    __device__ __forceinline__ void a_ready(const pg8::Unit&) const {}
    __device__ __forceinline__ void done(const pg8::Unit&) const {}
};
__device__ __forceinline__ void moe_combine_final(const Params& p, const float* g2, int lane, int wave) {
    const unsigned* misc = (const unsigned*)(p.ws + WS_MISC); const bf16_t* y = (const bf16_t*)(p.ws + WS_HS);
    const int gw = blockIdx.x * NWAVES + wave, NGW = gridDim.x * NWAVES;
    const int nk = (T - gw + NGW - 1) / NGW;
    unsigned mr0 = 0u, mr1 = 0u;
    if (lane < nk) { const v2u rr = *(const GAS v2u*)(misc + MI_TOK_POS + 2 * (gw + lane * NGW)); mr0 = rr.x; mr1 = rr.y; }
    f32x4 xv[4]; v2u ya[4], yc[4];
#define CMB_LOAD(k_) do { const int t_ = gw + (k_) * NGW; const unsigned r0_ = (unsigned)__shfl((int)mr0, (k_)), r1_ = (unsigned)__shfl((int)mr1, (k_)); \
        _Pragma("unroll") for (int j = 0; j < 4; ++j) { const int d = 4 * lane + 256 * j; xv[j] = *(const GAS f32x4*)(p.out + (size_t)t_ * D + d); \
            ya[j] = *(const GAS v2u*)(y + (size_t)r0_ * D + d); yc[j] = *(const GAS v2u*)(y + (size_t)r1_ * D + d); } } while (0)
    if (nk > 0) CMB_LOAD(0);
    for (int k = 0; k < nk; ++k) {
        const int t = gw + k * NGW, b = t >> 11;
        GAS f32x4* xr = (GAS f32x4*)(p.out + (size_t)t * D) + lane;
        f32x4 v[4]; float s = 0.f;
#pragma unroll
        for (int j = 0; j < 4; ++j) { const int d = 4 * lane + 256 * j; const v2u a = ya[j], c = yc[j];
            f32x4 fa, fc; fa.x = __uint_as_float(a.x << 16); fa.y = __uint_as_float(a.x & 0xffff0000u); fa.z = __uint_as_float(a.y << 16); fa.w = __uint_as_float(a.y & 0xffff0000u);
            fc.x = __uint_as_float(c.x << 16); fc.y = __uint_as_float(c.x & 0xffff0000u); fc.z = __uint_as_float(c.y << 16); fc.w = __uint_as_float(c.y & 0xffff0000u);
            const f32x4 g4 = *(const f32x4*)(g2 + (size_t)b * 6 * D + d);
            v[j] = xv[j] + g4 * (fa + fc); s += (v[j].x * v[j].x + v[j].y * v[j].y) + (v[j].z * v[j].z + v[j].w * v[j].w); }
        if (k + 1 < nk) CMB_LOAD(k + 1);
        const float r = 1.0f / sqrtf(wave_sum(s) * (1.0f / D) + EPS);
#pragma unroll
        for (int j = 0; j < 4; ++j) { const f32x4 f4 = *(const f32x4*)(p.in[25] + 4 * lane + 256 * j); xr[64 * j] = v[j] * r * f4; }
    }
#undef CMB_LOAD
}

#ifdef PROBE_CATS
#ifndef PROBE_MULT
#define PROBE_MULT 4
#endif
struct Probe { int unused; };
__device__ __forceinline__ int step_cat(int id) {
    if (id == 0) return 0;
    const int l = (id - 1) / LSTEPS, o = (id - 1) % LSTEPS;
    if (o == 0) return 1; if (o <= 10) return 2 + (o - 1) % 5; if (o == 11) return l == 0 ? 7 : 10;
    if (l == 0) return o == 12 ? 8 : 9;
    if (o == 12) return 11; if (o == 21) return 14; return (o & 1) ? 12 : 13;
}
__device__ __forceinline__ bool probe_tick_lds(LAS unsigned char* lds, int id) {
    int t_ = threadIdx.x; asm volatile("" : "+v"(t_));
    if (blockIdx.x == 0 && t_ == 0) {
        volatile LAS unsigned long long* q = (volatile LAS unsigned long long*)(lds + LDSCTL_OFF + 64);
        const unsigned long long now = __builtin_amdgcn_s_memrealtime();
        if (q[2]) q[1] += now - q[0];
        q[0] = now; q[2] = ((id >= 0) && ((PROBE_CATS >> step_cat(id)) & 1)) ? 1ull : 0ull;
    }
    return true;
}
#define probe_tick(pr, id) probe_tick_lds(lds, (id))
#else
struct Probe { int unused; };
__device__ __forceinline__ bool probe_tick(Probe&, int) { return true; }
#endif
#define STEP(id) if (p0.lo <= (id) && (id) < p0.hi && (first ? (first = false, true) : (xcd_barrier(bar), true)) && probe_tick(pr, (id)))
#define STEP_S(id) if (p0.lo <= (id) && (id) < p0.hi && (first ? (first = false, true) : (xcd_barrier_steal(bar, lds), true)) && probe_tick(pr, (id)))
#define IDS const Params p = load_params(); int tid = threadIdx.x; asm volatile("" : "+v"(tid)); const int lane = tid & 63, wave = __builtin_amdgcn_readfirstlane(tid >> 6); (void)lane; (void)wave; const int G = gridDim.x, NGW = G * NWAVES; (void)NGW; unsigned char* ws = p.ws; const float* mod_ = (const float*)(ws + WS_MOD); (void)mod_;
template <int L, int c> __device__ __forceinline__ void chunk_steps(const Params& p0, LAS unsigned char* lds, const XcdBarrier& bar, bool& first, Probe& pr) {
    constexpr int sb = ST_L0 + L * LSTEPS;
        constexpr int cs = sb + SO_CHUNK + CSTEPS * c;
#define CHP bf16_t* hc = (bf16_t*)(ws + WS_H) + (size_t)c * CH_T * D; bf16_t* proj = (bf16_t*)(ws + WS_PROJ); (void)hc; (void)proj;
        STEP(cs + 0) { IDS CHP
            if (blockIdx.x < CH_B * 6 && wave == 0) negf_cumsum(p, c * CH_B + (int)blockIdx.x / 6, (int)blockIdx.x % 6, lane);
            if constexpr (c == 1) {
                pg8::Gemm g{(const bf16_t*)(ws + WS_H), (const bf16_t*)(ws + WS_WOUT) + (size_t)L * D * D, CH_T, D, D, D, D}; pg8::StaticOrder S; S.init(CH_T, D, G, (int)blockIdx.x);
                pg8::EpiResid E{L == 0 ? p.in[0] : p.out, p.out, (mod_ + (size_t)L * NB * 6 * D) + 2 * D, 0};
                pg8::gemm_phase<pg8::EpiResid, pg8::StaticOrder, true, true>(lds, g, S, E);
            }
            pg8::Gemm g{hc, (const bf16_t*)(ws + WS_WIN) + (size_t)L * NP * D, CH_T, NP, D, D, D}; pg8::StaticOrder S; S.init(CH_T, NP, G, (int)blockIdx.x);
            pg8::EpiInProj E{(bf16_t*)(ws + WS_QO), (bf16_t*)(ws + WS_KV), (bf16_t*)(ws + WS_GATE)};
            pg8::gemm_phase<pg8::EpiInProj, pg8::StaticOrder, true, true>(lds, g, S, E);
        }
        STEP(cs + 1) { IDS attn_b_phase(p, lds, tid, lane, wave); }
        STEP_S(cs + 2) { IDS attn_ac_phase(p, L, c, lds, tid, lane, wave); }
        STEP_S(cs + 3) { IDS CHP
            const bf16_t* wbr = (const bf16_t*)(ws + WS_WBR) + (size_t)L * 1280 * D;
            pg8::SegOrder S; S.init(CH_T, D, G, (int)blockIdx.x);
            pg8::Gemm g{(const bf16_t*)(ws + WS_QO), wbr, CH_T, D, 1280, 2048, 1280}; pg8::EpiMergeS E{(const bf16_t*)(ws + WS_GATE), hc, 3072};
            pg8::gemm_phase<pg8::EpiMergeS, pg8::SegOrder, true, true>(lds, g, S, E);
        }
        if constexpr (c == 1) STEP(cs + 4) { IDS CHP
            pg8::Gemm g{hc, (const bf16_t*)(ws + WS_WOUT) + (size_t)L * D * D, CH_T, D, D, D, D}; pg8::StaticOrder S; S.init(CH_T, D, G, (int)blockIdx.x);
            pg8::EpiResid E{L == 0 ? p.in[0] : p.out, p.out, (mod_ + (size_t)L * NB * 6 * D) + 2 * D, c * CH_T};
            pg8::gemm_phase<pg8::EpiResid, pg8::StaticOrder, true, true>(lds, g, S, E);
        }
    }
template <int L> __device__ __forceinline__ void layer_steps(const Params& p0, LAS unsigned char* lds, const XcdBarrier& bar, bool& first, Probe& pr) {
    constexpr int sb = ST_L0 + L * LSTEPS;
    STEP(sb + SO_NORM1) { IDS norm_logf(p, L, L == 0 ? p.in[0] : p.out, p.in[2] + L * D, (mod_ + (size_t)L * NB * 6 * D) + D, (mod_ + (size_t)L * NB * 6 * D), (bf16_t*)(ws + WS_H), lds, tid, lane, wave); }
    chunk_steps<L, 0>(p0, lds, bar, first, pr);
    chunk_steps<L, 1>(p0, lds, bar, first, pr);
    STEP(sb + SO_NORM2) { IDS
        if constexpr (L == 0) norm_rows(p.out, p.in[3] + L * D, (mod_ + (size_t)L * NB * 6 * D) + 4 * D, (mod_ + (size_t)L * NB * 6 * D) + 3 * D, (bf16_t*)(ws + WS_H), 0, T, (int)blockIdx.x * NWAVES + wave, NGW, lane);
        else norm_route(p, p.in[3] + L * D, (mod_ + (size_t)L * NB * 6 * D) + 4 * D, (mod_ + (size_t)L * NB * 6 * D) + 3 * D, (bf16_t*)(ws + WS_H), lds, tid, lane, wave);
    }
    if constexpr (L == 0) {
        STEP(sb + SO_FFN) { IDS
            pg8::Gemm g{(const bf16_t*)(ws + WS_H), (const bf16_t*)(ws + WS_WGU0), T, 2 * DFF, D, D, D}; pg8::StaticOrder S; S.init(T, 2 * DFF, G, (int)blockIdx.x);
            pg8::EpiSwiglu E{(bf16_t*)(ws + WS_PROJ), DFF, 0};
            pg8::gemm_phase<pg8::EpiSwiglu, pg8::StaticOrder, true, true>(lds, g, S, E);
        }
        STEP(sb + SO_FFN + 1) { IDS
            pg8::Gemm g{(const bf16_t*)(ws + WS_PROJ), (const bf16_t*)(ws + WS_WD0), T, D, DFF, DFF, DFF}; pg8::StaticOrder S; S.init(T, D, G, (int)blockIdx.x);
            pg8::EpiResid E{p.out, p.out, (mod_ + (size_t)L * NB * 6 * D) + 5 * D, 0};
            pg8::gemm_phase<pg8::EpiResid, pg8::StaticOrder, true, true>(lds, g, S, E);
        }
    } else {
        STEP(sb + SO_FFN) { IDS moe_scan_gather(p, lds, tid, lane, wave); __syncthreads(); expert_mopup(p, lds, lane, wave); }
#pragma unroll 1
        for (int ch = 0; ch < 4; ++ch) {
            STEP(sb + SO_FFN + 1 + 2 * ch) { IDS const unsigned* misc = (const unsigned*)(ws + WS_MISC);
                const int ntile = (int)misc[MI_TILE_E + 500], t0 = ch * MOE_CH, t1 = ch == 3 ? ntile : (ch + 1) * MOE_CH;
                pg8::Gemm g{(const bf16_t*)(ws + WS_HS), (const bf16_t*)(ws + WS_WGU1), MOE_ROWS, 2 * DFE, D, D, D};
                GroupedOrder S{misc + MI_TILE_E, t0, t1, 2 * DFE / 256, G, (int)blockIdx.x, 0, (size_t)2 * DFE * D};
                pg8::EpiSwiglu E{(bf16_t*)(ws + WS_ACT1), DFE, t0};
                pg8::gemm_phase<pg8::EpiSwiglu, GroupedOrder, true, true>(lds, g, S, E);
            }
            STEP(sb + SO_FFN + 2 + 2 * ch) { IDS const unsigned* misc = (const unsigned*)(ws + WS_MISC);
                const int ntile = (int)misc[MI_TILE_E + 500], t0 = ch * MOE_CH, t1 = ch == 3 ? ntile : (ch + 1) * MOE_CH;
                pg8::Gemm g{(const bf16_t*)(ws + WS_ACT1), (const bf16_t*)(ws + WS_WD1), MOE_ROWS, D, DFE, DFE, DFE};
                GroupedOrder S{misc + MI_TILE_E, t0, t1, D / 256, G, (int)blockIdx.x, t0, (size_t)D * DFE};
                pg8::EpiMoeDown E{(bf16_t*)(ws + WS_HS), (const float*)(misc + MI_ROW_W)};
                pg8::gemm_phase<pg8::EpiMoeDown, GroupedOrder, true, true>(lds, g, S, E);
            }
        }
        STEP(sb + SO_FFN + 9) { IDS moe_combine_final(p, (mod_ + (size_t)L * NB * 6 * D) + 5 * D, lane, wave); }
    }
}

__global__ void __launch_bounds__(NTHR, 2) mk_fwd(Params p0) {
    extern __shared__ __attribute__((aligned(16))) unsigned char lds_raw[];
    LAS unsigned char* lds = (LAS unsigned char*)lds_raw;
    for (int u = threadIdx.x; u < (LDS_BYTES - LDSCTL_OFF) / 4; u += NTHR) ((LAS unsigned*)(lds + LDSCTL_OFF))[u] = 0u;
    __syncthreads();
    const XcdBarrier bar = xcd_barrier_post((unsigned*)(p0.ws + WS_CTL) + CW_BAR + p0.li * XCD_BAR_WORDS, (volatile LAS unsigned*)(lds + MISC_OFF) + 8);
    bool first = true; Probe pr{};
    STEP(ST_PRO) { IDS prologue(p, lds, tid, lane, wave); }
    layer_steps<0>(p0, lds, bar, first, pr);
    layer_steps<1>(p0, lds, bar, first, pr);
#ifdef PROBE_CATS
    probe_tick(pr, -1);
    int t_ = threadIdx.x; asm volatile("" : "+v"(t_));
    if (blockIdx.x == 0 && t_ == 0) { const unsigned long long t1 = __builtin_amdgcn_s_memrealtime(), want = ((volatile LAS unsigned long long*)(lds + LDSCTL_OFF + 64))[1] * PROBE_MULT; while (__builtin_amdgcn_s_memrealtime() - t1 < want) __builtin_amdgcn_s_sleep(32); }
#endif
}
#undef STEP
#undef STEP_S
}

extern "C" void kernel_launch(void* const* d_in, const int* in_sizes, int n_in, void* d_out, int out_size, void* d_ws, size_t ws_size, hipStream_t stream) {
    static int grid = 0;
    if (grid == 0) {
        int dev = 0, cus = 0;
        (void)hipGetDevice(&dev); (void)hipDeviceGetAttribute(&cus, hipDeviceAttributeMultiprocessorCount, dev);
        if (hipFuncSetAttribute((const void*)mk::mk_fwd, hipFuncAttributeMaxDynamicSharedMemorySize, mk::LDS_BYTES) != hipSuccess) fprintf(stderr, "kernel_launch: hipFuncSetAttribute failed\n");
        (void)hipGetLastError();
        grid = cus > 0 ? cus : 256;
        if (ws_size < mk::WS_END) fprintf(stderr, "kernel_launch: workspace too small: %zu < %zu\n", ws_size, (size_t)mk::WS_END);
    }
    (void)in_sizes; (void)n_in; (void)out_size;
    (void)hipMemsetAsync((char*)d_ws + mk::WS_CTL, 0, mk::CTL_ZERO, stream);
    mk::Params p{};
    for (int i = 0; i < 26; ++i) p.in[i] = (const float*)d_in[i];
    p.out = (float*)d_out; p.ws = (unsigned char*)d_ws; p.lo = 0; p.hi = mk::ST_END; p.li = 0; p.pad = 0;
    hipLaunchKernelGGL(mk::mk_fwd, dim3(grid), dim3(mk::NTHR), mk::LDS_BYTES, stream, p);
}
```

```cpp
#include <hip/hip_runtime.h>
#include <cstdint>
#include <cstdio>

namespace pg8 {
#define PG8_LAS __attribute__((address_space(3)))
typedef unsigned short bf16_t;
typedef short bf16x8 __attribute__((ext_vector_type(8)));
typedef float f32x4 __attribute__((ext_vector_type(4)));
typedef unsigned u32x4 __attribute__((ext_vector_type(4)));
constexpr int BM = 256, BK = 64, HALF = 128, HTB = HALF * BK * 2  , STAGE_BYTES = 8 * HTB, NXCD = 8, WGM = 8;

__host__ __device__ __forceinline__ int lds_byte(int r, int c) { const int st = (r >> 4) * 2 + (c >> 5), rr = r & 15, cc = c & 31, ob = rr * 64 + cc * 2; return st * 1024 + (ob ^ (((ob >> 9) & 1) << 5)); }
__host__ __device__ __forceinline__ void stage_rc(int b, int& R, int& C) { const int st = b / 1024, sb = b % 1024, swz = sb ^ (((sb >> 9) & 1) << 5); R = (st >> 1) * 16 + swz / 64; C = (st & 1) * 32 + (swz % 64) / 2; }
__host__ __device__ __forceinline__ int perm32(int rho) { const int n = rho >> 4, i = rho & 15; return 8 * (i >> 2) + 4 * n + (i & 3); }

struct Unit { int pm, pn, e, aux; };
struct Gemm { const bf16_t* A; const bf16_t* Bt; int M, N, K, lda, ldb; };

struct StaticOrder {
    int nM, nN, nwg, G, c;
    __host__ __device__ void init(int M, int N, int G_, int c_) { nM = M / BM; nN = N / BM; nwg = nM * nN; G = G_; c = c_; }
    __host__ __device__ bool next(int i, Unit& u) const {
        const long L = (long)i * G + c; if (L >= nwg) return false;
        int wgid = (int)L; { const int q = nwg / NXCD, r = nwg % NXCD, xcd = wgid % NXCD, off = wgid / NXCD; wgid = (xcd < r ? xcd * (q + 1) : r * (q + 1) + (xcd - r) * q) + off; }
        const int nig = WGM * nN, gid = wgid / nig, fm = gid * WGM, gsz = (nM - fm) < WGM ? (nM - fm) : WGM;
        u.pm = fm + ((wgid % nig) % gsz); u.pn = (wgid % nig) / gsz; u.e = 0; u.aux = 0; return true;
    }
    __device__ __forceinline__ const char* a_ptr(const Gemm& g, const Unit& u) const { return (const char*)g.A + (size_t)u.pm * (size_t)(BM * 2) * g.lda; }
    __device__ __forceinline__ const char* b_ptr(const Gemm& g, const Unit& u) const { return (const char*)g.Bt + (size_t)u.pn * (size_t)(BM * 2) * g.ldb; }
    __device__ __forceinline__ int kt(const Gemm& g, const Unit&) const { return g.K / BK; }
    __device__ __forceinline__ bool last_seg(const Unit&) const { return true; }
    __device__ __forceinline__ void a_ready(const Unit&) const {}
    __device__ __forceinline__ void done(const Unit&) const {}
};

__device__ __forceinline__ unsigned cvt_pk_bf16(float lo, float hi) { unsigned r; asm volatile("v_cvt_pk_bf16_f32 %0, %1, %2" : "=v"(r) : "v"(lo), "v"(hi)); return r; }
typedef float f32x2 __attribute__((ext_vector_type(2)));
__device__ __forceinline__ float silu_f(float z) { return z * __builtin_amdgcn_rcpf(1.0f + __builtin_amdgcn_exp2f(-1.4426950408889634f * z)); }
__device__ __forceinline__ float sigm_f(float z) { return __builtin_amdgcn_rcpf(1.0f + __builtin_amdgcn_exp2f(-1.4426950408889634f * z)); }
struct EpiSwiglu {
    static constexpr bool PERM = true, AFTER_DRAIN = false, SEGMENTED = false;
    bf16_t* O; int ldc; int pm_off;
    __device__ __forceinline__ void operator()(const f32x4 (&acc)[2][2][4][2], const Unit& u, int wr, int wc, int fr, int fq) const {
        const int row0 = (u.pm - pm_off) * BM + wr * 64 + fr, col0 = u.pn * HALF + wc * 32 + 8 * fq;
#pragma unroll
        for (int ai = 0; ai < 2; ++ai)
#pragma unroll
            for (int m = 0; m < 4; ++m) { bf16_t* rowp = O + (size_t)(row0 + ai * HALF + m * 16) * ldc + col0;
                const f32x4 g0 = acc[ai][0][m][0], g1 = acc[ai][0][m][1], u0 = acc[ai][1][m][0], u1 = acc[ai][1][m][1];
                u32x4 w; w.x = cvt_pk_bf16(silu_f(g0[0]) * u0[0], silu_f(g0[1]) * u0[1]); w.y = cvt_pk_bf16(silu_f(g0[2]) * u0[2], silu_f(g0[3]) * u0[3]);
                w.z = cvt_pk_bf16(silu_f(g1[0]) * u1[0], silu_f(g1[1]) * u1[1]); w.w = cvt_pk_bf16(silu_f(g1[2]) * u1[2], silu_f(g1[3]) * u1[3]);
                *(u32x4*)rowp = w; }
    }
};
struct EpiResid {
    static constexpr bool PERM = false, AFTER_DRAIN = false, SEGMENTED = false;
    const float* src; float* dst; const float* gv; int row_off;
    __device__ __forceinline__ void operator()(const f32x4 (&acc)[2][2][4][2], const Unit& u, int wr, int wc, int fr, int fq) const {
        const int rowt = row_off + u.pm * BM, row0 = rowt + wr * 64 + fr, col0 = u.pn * BM + wc * 32 + 4 * fq;
        const float* gp = gv + (size_t)(rowt >> 11) * 6144 + col0;
        f32x4 gg[2][2];
#pragma unroll
        for (int bj = 0; bj < 2; ++bj)
#pragma unroll
            for (int n = 0; n < 2; ++n) gg[bj][n] = *(const f32x4*)(gp + bj * HALF + n * 16);
#pragma unroll
        for (int ai = 0; ai < 2; ++ai) {
            f32x4 sv[4][2][2];
#pragma unroll
            for (int m = 0; m < 4; ++m) { const size_t off = (size_t)(row0 + ai * HALF + m * 16) * 1024 + col0;
#pragma unroll
                for (int bj = 0; bj < 2; ++bj)
#pragma unroll
                    for (int n = 0; n < 2; ++n) sv[m][bj][n] = *(const f32x4*)(src + off + bj * HALF + n * 16); }
            asm volatile("" ::: "memory");
#pragma unroll
            for (int m = 0; m < 4; ++m) { const size_t off = (size_t)(row0 + ai * HALF + m * 16) * 1024 + col0;
#pragma unroll
                for (int bj = 0; bj < 2; ++bj)
#pragma unroll
                    for (int n = 0; n < 2; ++n) *(f32x4*)(dst + off + bj * HALF + n * 16) = sv[m][bj][n] + gg[bj][n] * acc[ai][bj][m][n]; }
            asm volatile("" ::: "memory");
        }
    }
};
struct EpiMoeDown {
    static constexpr bool PERM = true, AFTER_DRAIN = false, SEGMENTED = false;
    bf16_t* O; const float* row_w;
    __device__ __forceinline__ void operator()(const f32x4 (&acc)[2][2][4][2], const Unit& u, int wr, int wc, int fr, int fq) const {
        const int row0 = u.pm * BM + wr * 64 + fr, col0 = u.pn * BM + wc * 32 + 8 * fq;
        float w[2][4];
#pragma unroll
        for (int ai = 0; ai < 2; ++ai)
#pragma unroll
            for (int m = 0; m < 4; ++m) w[ai][m] = row_w[row0 + ai * HALF + m * 16];
#pragma unroll
        for (int ai = 0; ai < 2; ++ai)
#pragma unroll
            for (int m = 0; m < 4; ++m) { bf16_t* rowp = O + (size_t)(row0 + ai * HALF + m * 16) * 1024 + col0; const float ww = w[ai][m];
#pragma unroll
                for (int bj = 0; bj < 2; ++bj) { const f32x4 v0 = acc[ai][bj][m][0] * ww, v1 = acc[ai][bj][m][1] * ww;
                    u32x4 o; o.x = cvt_pk_bf16(v0[0], v0[1]); o.y = cvt_pk_bf16(v0[2], v0[3]); o.z = cvt_pk_bf16(v1[0], v1[1]); o.w = cvt_pk_bf16(v1[2], v1[3]);
                    *(u32x4*)(rowp + bj * HALF) = o; } }
    }
};
struct EpiInProj {
    static constexpr bool PERM = true, AFTER_DRAIN = false, SEGMENTED = false;
    bf16_t* QO; bf16_t* KV; bf16_t* GT;
    __device__ __forceinline__ void operator()(const f32x4 (&acc)[2][2][4][2], const Unit& u, int wr, int wc, int fr, int fq) const {
        const int rowl0 = u.pm * BM + wr * 64 + fr, b = (u.pm * BM) >> 11;
        constexpr float C2 = 0.125f * 1.4426950408889634f;
        constexpr size_t KVB0 = (size_t)8 * 4 * 2 * 2048 * 128, KVC0 = KVB0 + (size_t)8 * 18 * 2 * 2048 * 64;
#pragma unroll
        for (int bj = 0; bj < 2; ++bj) {
            const int hh = 2 * u.pn + bj, c = 32 * wc + 8 * fq; float sc = 1.0f; int s = 0, pitch = 2048; bool sig = false, tokmajor = true; bf16_t* dst;
            if (hh < 4) { dst = QO + 128 * hh + c; sc = C2; }
            else if (hh < 12) { const int kv = hh >= 8, h = hh - (kv ? 8 : 4); dst = KV + (size_t)((b * 4 + h) * 2 + kv) * (2048 * 128) + c; pitch = 128; tokmajor = false; }
            else if (hh < 21) { const int g = (hh - 12) / 3, j = (hh - 12) % 3; dst = QO + 512 + g * 384 + j * 128 + c; s = 2 * g; sc = C2; }
            else if (hh < 39) { const int kv = hh >= 30, x = hh - (kv ? 30 : 21), g = x / 3, j = x % 3, hd = 2 * j + (c >> 6);
                dst = KV + KVB0 + (size_t)(((b * 3 + g) * 6 + hd) * 2 + kv) * (2048 * 64) + (c & 63); pitch = 64; s = 2 * g; tokmajor = false; }
            else if (hh < 42) { dst = QO + 1664 + (hh - 39) * 128 + c; sc = C2; }
            else if (hh < 48) { const int kv = hh >= 45, j = hh - (kv ? 45 : 42), hd = 2 * j + (c >> 6); dst = KV + KVC0 + (size_t)((b * 6 + hd) * 2 + kv) * (2048 * 64) + (c & 63); pitch = 64; tokmajor = false; }
            else { dst = GT + (hh - 48) * 128 + c; pitch = 3072; sig = true; }
#pragma unroll
            for (int ai = 0; ai < 2; ++ai)
#pragma unroll
                for (int m = 0; m < 4; ++m) { const int r = rowl0 + ai * HALF + m * 16, t = r & 2047, tp = ((t & ((1 << s) - 1)) << (11 - s)) | (t >> s), ro = (tokmajor ? (r & ~2047) : 0) | tp;
                    f32x4 v0 = acc[ai][bj][m][0], v1 = acc[ai][bj][m][1];
                    if (sig) { v0[0] = sigm_f(v0[0]); v0[1] = sigm_f(v0[1]); v0[2] = sigm_f(v0[2]); v0[3] = sigm_f(v0[3]); v1[0] = sigm_f(v1[0]); v1[1] = sigm_f(v1[1]); v1[2] = sigm_f(v1[2]); v1[3] = sigm_f(v1[3]); }
                    else { v0 = v0 * sc; v1 = v1 * sc; }
                    u32x4 w; w.x = cvt_pk_bf16(v0[0], v0[1]); w.y = cvt_pk_bf16(v0[2], v0[3]); w.z = cvt_pk_bf16(v1[0], v1[1]); w.w = cvt_pk_bf16(v1[2], v1[3]);
                    *(u32x4*)(dst + (size_t)ro * pitch) = w; }
        }
    }
};
__device__ __forceinline__ float bf_lo(unsigned u) { return __builtin_bit_cast(float, u << 16); }
__device__ __forceinline__ float bf_hi(unsigned u) { return __builtin_bit_cast(float, u & 0xffff0000u); }
template <int BR> struct EpiMerge {
    static constexpr bool PERM = true, AFTER_DRAIN = false, SEGMENTED = false;
    const bf16_t* proj; bf16_t* mg; int ldp;
    __device__ __forceinline__ void operator()(const f32x4 (&acc)[2][2][4][2], const Unit& u, int wr, int wc, int fr, int fq) const {
        const int row0 = u.pm * BM + wr * 64 + fr, col0 = u.pn * BM + wc * 32 + 8 * fq;
#pragma unroll
        for (int ai = 0; ai < 2; ++ai)
#pragma unroll
        for (int mp = 0; mp < 4; ++mp) {
            u32x4 gt[1][2], od[1][2];
#pragma unroll
            for (int mm = 0; mm < 1; ++mm)
#pragma unroll
                for (int bj = 0; bj < 2; ++bj) { const size_t r = (size_t)(row0 + ai * HALF + (mp + mm) * 16);
                    gt[mm][bj] = *(const u32x4*)(proj + r * ldp + 6144 + 1024 * BR + col0 + bj * HALF);
                    if (BR) od[mm][bj] = *(const u32x4*)(mg + r * 1024 + col0 + bj * HALF); else od[mm][bj] = (u32x4){0u, 0u, 0u, 0u}; }
            asm volatile("" ::: "memory");
#pragma unroll
            for (int mm = 0; mm < 1; ++mm)
#pragma unroll
                for (int bj = 0; bj < 2; ++bj) { const int m = mp + mm; const size_t r = (size_t)(row0 + ai * HALF + m * 16); const u32x4 g = gt[mm][bj], o = od[mm][bj]; const f32x4 v0 = acc[ai][bj][m][0], v1 = acc[ai][bj][m][1];
                    u32x4 w; w.x = cvt_pk_bf16(bf_lo(o.x) + bf_lo(g.x) * v0[0], bf_hi(o.x) + bf_hi(g.x) * v0[1]); w.y = cvt_pk_bf16(bf_lo(o.y) + bf_lo(g.y) * v0[2], bf_hi(o.y) + bf_hi(g.y) * v0[3]);
                    w.z = cvt_pk_bf16(bf_lo(o.z) + bf_lo(g.z) * v1[0], bf_hi(o.z) + bf_hi(g.z) * v1[1]); w.w = cvt_pk_bf16(bf_lo(o.w) + bf_lo(g.w) * v1[2], bf_hi(o.w) + bf_hi(g.w) * v1[3]);
                    *(u32x4*)(mg + r * 1024 + col0 + bj * HALF) = w; }
            asm volatile("" ::: "memory");
        }
    }
};
struct EpiMergeS {
    static constexpr bool PERM = true, AFTER_DRAIN = false, SEGMENTED = false;
    const bf16_t* proj; bf16_t* mg; int ldp;
    __device__ __forceinline__ void operator()(const f32x4 (&acc)[2][2][4][2], const Unit& u, int wr, int wc, int fr, int fq) const {
        const int row0 = u.pm * BM + wr * 64 + fr, col0 = u.pn * BM + wc * 32 + 8 * fq; const int s = u.e;
#pragma unroll
        for (int ai = 0; ai < 2; ++ai) {
            u32x4 gt[4][2], od[4][2];
#pragma unroll
            for (int m = 0; m < 4; ++m)
#pragma unroll
                for (int bj = 0; bj < 2; ++bj) { const size_t r = (size_t)(row0 + ai * HALF + m * 16);
                    gt[m][bj] = *(const u32x4*)(proj + r * ldp + 1024 * s + col0 + bj * HALF);     od[m][bj] = *(const u32x4*)(mg + r * 1024 + col0 + bj * HALF); }
            asm volatile("" ::: "memory");
#pragma unroll
            for (int m = 0; m < 4; ++m)
#pragma unroll
                for (int bj = 0; bj < 2; ++bj) { const size_t r = (size_t)(row0 + ai * HALF + m * 16); const u32x4 g = gt[m][bj]; u32x4 o = od[m][bj]; if (s == 0) o = (u32x4){0u, 0u, 0u, 0u};
                    const f32x4 v0 = acc[ai][bj][m][0], v1 = acc[ai][bj][m][1];
                    u32x4 w; w.x = cvt_pk_bf16(bf_lo(o.x) + bf_lo(g.x) * v0[0], bf_hi(o.x) + bf_hi(g.x) * v0[1]); w.y = cvt_pk_bf16(bf_lo(o.y) + bf_lo(g.y) * v0[2], bf_hi(o.y) + bf_hi(g.y) * v0[3]);
                    w.z = cvt_pk_bf16(bf_lo(o.z) + bf_lo(g.z) * v1[0], bf_hi(o.z) + bf_hi(g.z) * v1[1]); w.w = cvt_pk_bf16(bf_lo(o.w) + bf_lo(g.w) * v1[2], bf_hi(o.w) + bf_hi(g.w) * v1[3]);
                    *(u32x4*)(mg + r * 1024 + col0 + bj * HALF) = w; }
            asm volatile("" ::: "memory");
        }
    }
};
struct SegOrder : StaticOrder {
    __device__ __forceinline__ bool next(int i, Unit& u) const { const int ti = i / 3, sg = i - 3 * ti; if (!StaticOrder::next(ti, u)) return false; u.e = sg; return true; }
    __device__ __forceinline__ const char* a_ptr(const Gemm& g, const Unit& u) const { return (const char*)g.A + (size_t)u.pm * (size_t)(BM * 2) * g.lda + (u.e == 0 ? 0 : (u.e == 1 ? 512 * 2 : 1664 * 2)); }
    __device__ __forceinline__ const char* b_ptr(const Gemm& g, const Unit& u) const { return (const char*)g.Bt + (size_t)u.pn * (size_t)(BM * 2) * g.ldb + (u.e == 0 ? 0 : (u.e == 1 ? 512 * 2 : 896 * 2)); }
    __device__ __forceinline__ int kt(const Gemm&, const Unit& u) const { return u.e == 0 ? 8 : 6; }
    __device__ __forceinline__ bool last_seg(const Unit& u) const { return u.e == 2; }
};
template <class Epi, class Sched, bool ALIGN_EPI = false, bool SP2 = false>
__device__ __forceinline__ void gemm_phase(PG8_LAS unsigned char* lds, const Gemm g, const Sched& S, const Epi& E) {
    int tid = threadIdx.x; asm volatile("" : "+v"(tid));
    const int wid = __builtin_amdgcn_readfirstlane(tid >> 6), lane = tid & 63, wr = wid >> 2, wc = wid & 3, fr = lane & 15, fq = lane >> 4;
    const int K = g.K;
    unsigned voffA[2], voffB[2];
#pragma unroll
    for (int i = 0; i < 2; ++i) { int R, C; stage_rc(tid * 16 + i * 8192, R, C); const int Rb = Epi::PERM ? ((R & ~31) + perm32(R & 31)) : R;
        voffA[i] = (unsigned)(R * g.lda + C) * 2u; voffB[i] = (unsigned)(Rb * g.ldb + C) * 2u; }
    const size_t kstep = (size_t)(BK * 2);
    const size_t hstepA = (size_t)HALF * g.lda * 2, hstepB = (size_t)HALF * g.ldb * 2;
    const unsigned ldsw = (unsigned)wid * 1024u;
    const int aoff = lds_byte(wr * 64 + fr, fq * 8), boff = lds_byte(wc * 32 + fr, fq * 8);
#define PG8_SA(b, h) (((b) * 2 + (h)) * HTB)
#define PG8_SB(b, h) ((4 + (b) * 2 + (h)) * HTB)
#define PG8_STAGE(bufoff, gbase, voff) do { _Pragma("unroll") for (int _i = 0; _i < 2; ++_i) \
        __builtin_amdgcn_global_load_lds((const unsigned*)((const char*)(gbase) + (voff)[_i]), (PG8_LAS unsigned*)(lds + (bufoff) + ldsw + _i * 8192), 16, 0, 0); } while (0)
#define PG8_LDA(dst, b, h) do { _Pragma("unroll") for (int m = 0; m < 4; ++m) _Pragma("unroll") for (int k = 0; k < 2; ++k) dst[m][k] = *(const PG8_LAS bf16x8*)(lds + PG8_SA(b, h) + aoff + m * 2048 + k * 1024); } while (0)
#define PG8_LDB(dst, b, h) do { _Pragma("unroll") for (int n = 0; n < 2; ++n) _Pragma("unroll") for (int k = 0; k < 2; ++k) dst[n][k] = *(const PG8_LAS bf16x8*)(lds + PG8_SB(b, h) + boff + n * 2048 + k * 1024); } while (0)
#define PG8_MMA(ai, bj, At, Bt) do { __builtin_amdgcn_s_setprio(1); _Pragma("unroll") for (int m = 0; m < 4; ++m) _Pragma("unroll") for (int n = 0; n < 2; ++n) _Pragma("unroll") for (int k = 0; k < 2; ++k) \
        acc[ai][bj][m][n] = __builtin_amdgcn_mfma_f32_16x16x32_bf16(Bt[n][k], At[m][k], acc[ai][bj][m][n], 0, 0, 0); __builtin_amdgcn_s_setprio(0); } while (0)
#define PG8_WAIT_V(n) asm volatile("s_waitcnt vmcnt(" #n ")" ::: "memory")
#define PG8_WAIT_L(n) asm volatile("s_waitcnt lgkmcnt(" #n ")" ::: "memory")
#define PG8_BAR __builtin_amdgcn_s_barrier()
#define PG8_SCHED __builtin_amdgcn_sched_barrier(0)
    Unit cur, nxt; int ui = 0;
    if (!S.next(0, cur)) return;
    int nt = S.kt(g, cur);
    f32x4 acc[2][2][4][2];
#pragma unroll
    for (int a = 0; a < 2; ++a)
#pragma unroll
        for (int b = 0; b < 2; ++b)
#pragma unroll
            for (int m = 0; m < 4; ++m)
#pragma unroll
                for (int n = 0; n < 2; ++n) acc[a][b][m][n] = (f32x4){0.f, 0.f, 0.f, 0.f};
    bf16x8 At[4][2], B0[2][2], B1[2][2];
    const char* cA = S.a_ptr(g, cur); const char* cB = S.b_ptr(g, cur);
    S.a_ready(cur);
    if constexpr (SP2) {
        PG8_STAGE(PG8_SB(0, 0), cB, voffB); PG8_STAGE(PG8_SB(0, 1), cB + hstepB, voffB); PG8_STAGE(PG8_SA(0, 0), cA, voffA); PG8_STAGE(PG8_SA(0, 1), cA + hstepA, voffA);
        if (wr == 1) PG8_BAR;
        PG8_WAIT_V(2); PG8_BAR;
        PG8_STAGE(PG8_SB(1, 0), cB + kstep, voffB); PG8_STAGE(PG8_SA(1, 0), cA + kstep, voffA); PG8_STAGE(PG8_SB(1, 1), cB + hstepB + kstep, voffB);
        PG8_WAIT_V(6); PG8_BAR;
    } else {
        PG8_STAGE(PG8_SB(0, 0), cB, voffB); PG8_STAGE(PG8_SA(0, 0), cA, voffA); PG8_STAGE(PG8_SB(0, 1), cB + hstepB, voffB); PG8_STAGE(PG8_SA(0, 1), cA + hstepA, voffA);
        if (wr == 1) PG8_BAR;
        PG8_WAIT_V(4); PG8_BAR;
        PG8_STAGE(PG8_SB(1, 0), cB + kstep, voffB); PG8_STAGE(PG8_SA(1, 0), cA + kstep, voffA); PG8_STAGE(PG8_SB(1, 1), cB + hstepB + kstep, voffB);
        PG8_WAIT_V(6); PG8_BAR;
    }
    for (;;) {
        const bool has_next = S.next(ui + 1, nxt);
        const char* nA = has_next ? S.a_ptr(g, nxt) : cA; const char* nB = has_next ? S.b_ptr(g, nxt) : cB;
        for (int t = 0; t < nt; t += 2) {
            const bool last = (t == nt - 2);
            const char* a1 = cA + (size_t)(t + 1) * kstep;
            const char* a2 = last ? nA : cA + (size_t)(t + 2) * kstep; const char* b2 = last ? nB : cB + (size_t)(t + 2) * kstep;
            const char* a3 = a2 + kstep; const char* b3 = b2 + kstep;
            if (last && has_next) S.a_ready(nxt);
            if constexpr (SP2) {
            PG8_LDB(B0, 0, 0); PG8_LDB(B1, 0, 1); PG8_SCHED; PG8_LDA(At, 0, 0); PG8_STAGE(PG8_SA(1, 1), a1 + hstepA, voffA);
            PG8_WAIT_V(8); PG8_WAIT_L(0); PG8_BAR; PG8_MMA(0, 0, At, B0); PG8_MMA(0, 1, At, B1); PG8_BAR; PG8_SCHED;
            PG8_LDA(At, 0, 1); PG8_STAGE(PG8_SB(0, 0), b2, voffB); PG8_STAGE(PG8_SB(0, 1), b2 + hstepB, voffB); PG8_STAGE(PG8_SA(0, 0), a2, voffA);
            PG8_WAIT_V(8); PG8_WAIT_L(0); PG8_BAR; PG8_MMA(1, 0, At, B0); PG8_MMA(1, 1, At, B1); PG8_BAR; PG8_SCHED;
            PG8_LDB(B0, 1, 0); PG8_LDB(B1, 1, 1); PG8_SCHED; PG8_LDA(At, 1, 0); PG8_STAGE(PG8_SA(0, 1), a2 + hstepA, voffA);
            PG8_WAIT_V(8); PG8_WAIT_L(0); PG8_BAR; PG8_MMA(0, 0, At, B0); PG8_MMA(0, 1, At, B1); PG8_BAR; PG8_SCHED;
            PG8_LDA(At, 1, 1); PG8_STAGE(PG8_SB(1, 0), b3, voffB); PG8_STAGE(PG8_SB(1, 1), b3 + hstepB, voffB); PG8_STAGE(PG8_SA(1, 0), a3, voffA);
            PG8_WAIT_V(8); PG8_WAIT_L(0); PG8_BAR; PG8_MMA(1, 0, At, B0); PG8_MMA(1, 1, At, B1); PG8_BAR; PG8_SCHED;
            } else {
            PG8_LDB(B0, 0, 0); PG8_SCHED; PG8_LDA(At, 0, 0); PG8_STAGE(PG8_SA(1, 1), a1 + hstepA, voffA);
            PG8_WAIT_L(8); PG8_BAR; PG8_WAIT_L(0); PG8_MMA(0, 0, At, B0); PG8_BAR; PG8_SCHED;
            PG8_LDB(B1, 0, 1); PG8_STAGE(PG8_SB(0, 0), b2, voffB);
            PG8_BAR; PG8_WAIT_L(0); PG8_MMA(0, 1, At, B1); PG8_BAR;
            PG8_LDA(At, 0, 1); PG8_STAGE(PG8_SA(0, 0), a2, voffA);
            PG8_BAR; PG8_WAIT_L(0); PG8_MMA(1, 0, At, B0); PG8_BAR; PG8_SCHED;
            PG8_STAGE(PG8_SB(0, 1), b2 + hstepB, voffB);
            PG8_WAIT_V(6); PG8_BAR; PG8_MMA(1, 1, At, B1); PG8_BAR;
            PG8_LDB(B0, 1, 0); PG8_SCHED; PG8_LDA(At, 1, 0); PG8_STAGE(PG8_SA(0, 1), a2 + hstepA, voffA);
            PG8_WAIT_L(8); PG8_BAR; PG8_WAIT_L(0); PG8_MMA(0, 0, At, B0); PG8_BAR; PG8_SCHED;
            PG8_LDB(B1, 1, 1); PG8_STAGE(PG8_SB(1, 0), b3, voffB);
            PG8_BAR; PG8_WAIT_L(0); PG8_MMA(0, 1, At, B1); PG8_BAR;
            PG8_LDA(At, 1, 1); PG8_STAGE(PG8_SA(1, 0), a3, voffA);
            PG8_BAR; PG8_WAIT_L(0); PG8_MMA(1, 0, At, B0); PG8_BAR; PG8_SCHED;
            PG8_STAGE(PG8_SB(1, 1), b3 + hstepB, voffB);
            PG8_WAIT_V(6); PG8_BAR; PG8_MMA(1, 1, At, B1); PG8_BAR;
            }
        }
        if constexpr (ALIGN_EPI) { if (wr == 0) PG8_BAR; }
        if constexpr (!Epi::AFTER_DRAIN) { E(acc, cur, wr, wc, fr, fq); S.done(cur); }
        if (!has_next) break;
#pragma unroll
        for (int a = 0; a < 2; ++a)
#pragma unroll
            for (int b = 0; b < 2; ++b)
#pragma unroll
                for (int m = 0; m < 4; ++m)
#pragma unroll
                    for (int n = 0; n < 2; ++n) acc[a][b][m][n] = (f32x4){0.f, 0.f, 0.f, 0.f};
        cur = nxt; cA = nA; cB = nB; ++ui; nt = S.kt(g, cur);
        if constexpr (ALIGN_EPI) { if (wr == 1) PG8_BAR; }
    }
    PG8_WAIT_V(0);
    if constexpr (!ALIGN_EPI) { if (wr == 0) PG8_BAR; }
    PG8_BAR;
    if constexpr (Epi::AFTER_DRAIN) { E.fused(acc, cur, wr, wc, fr, fq, lds, wid, lane); S.done(cur); }
#undef PG8_SA
#undef PG8_SB
#undef PG8_STAGE
#undef PG8_LDA
#undef PG8_LDB
#undef PG8_MMA
#undef PG8_WAIT_V
#undef PG8_WAIT_L
#undef PG8_BAR
#undef PG8_SCHED
}
}

#define LAS __attribute__((address_space(3)))
#define XB_TMO      128
#define XB_XCNT(j)  (256  + 64 * (j))
#define XB_XSUB(j)  (1280 + 64 * (j))
#define XB_XGEN(j)  (2304 + 64 * (j))
#define XB_TOP      3328
#define XB_TOPGEN   3392
#define XCD_BAR_WORDS 3456
#define XB_SPIN_CAP (1u << 18)

__device__ __forceinline__ unsigned xb_ld(unsigned* p)              { return __hip_atomic_load(p, __ATOMIC_RELAXED, __HIP_MEMORY_SCOPE_AGENT); }
__device__ __forceinline__ unsigned xb_add(unsigned* p, unsigned v) { return __hip_atomic_fetch_add(p, v, __ATOMIC_RELAXED, __HIP_MEMORY_SCOPE_AGENT); }
__device__ __forceinline__ unsigned xb_xcc_id() { return (unsigned)__builtin_amdgcn_s_getreg((3 << 11) | 20) & 0xFu; }
#define XB_SPIN(cond, bar) do { unsigned _sp = 0; while (cond) { __builtin_amdgcn_s_sleep(1); \
    if ((++_sp & 255u) == 0u) { if (xb_ld(&(bar)[XB_TMO])) break; if (_sp > XB_SPIN_CAP) { atomicAdd(&(bar)[XB_TMO], 1u); break; } } } } while (0)

struct XcdBarrier {
    unsigned* bar; unsigned x;
    volatile LAS unsigned* st;
};

__device__ __forceinline__ XcdBarrier xcd_barrier_post(unsigned* bar, volatile LAS unsigned* st) {
    XcdBarrier b; b.bar = bar; b.x = xb_xcc_id(); b.st = st;
    if (threadIdx.x == 0) (void)xb_add(&bar[XB_XCNT(b.x)], 1u);
    return b;
}
__device__ __forceinline__ void xcd_barrier_complete(unsigned* bar, unsigned x, unsigned& nloc, unsigned& nx) {
    const unsigned G = gridDim.x * gridDim.y * gridDim.z;
    unsigned sum, cnt, mine, sp = 0u;
    for (;;) {
        sum = 0u; cnt = 0u; mine = 0u;
#pragma unroll
        for (unsigned j = 0; j < 16; ++j) { const unsigned c = xb_ld(&bar[XB_XCNT(j)]); sum += c; cnt += (c > 0u) ? 1u : 0u; mine = (j == x) ? c : mine; }
        if (sum == G) break;
        __builtin_amdgcn_s_sleep(1);
        if ((++sp & 255u) == 0u) { if (xb_ld(&bar[XB_TMO])) break; if (sp > XB_SPIN_CAP) { atomicAdd(&bar[XB_TMO], 1u); break; } }
    }
    nloc = mine > 0u ? mine : 1u; nx = cnt > 0u ? cnt : 1u;
}

__device__ __forceinline__ void xcd_barrier(const XcdBarrier& b) {
    asm volatile("s_waitcnt vmcnt(0)" ::: "memory");
    __syncthreads();
    if (threadIdx.x == 0) {
        unsigned* bar = b.bar;
        __builtin_amdgcn_s_waitcnt(0);
        unsigned nloc = b.st[0], nx = b.st[1];
        if (nloc == 0u) { xcd_barrier_complete(bar, b.x, nloc, nx); b.st[0] = nloc; b.st[1] = nx; }
        const unsigned old = xb_add(&bar[XB_XSUB(b.x)], 1u);
        const unsigned gen = old / nloc;
        if (old + 1u == (gen + 1u) * nloc) {
            __builtin_amdgcn_fence(__ATOMIC_RELEASE, "agent");
            asm volatile("s_waitcnt vmcnt(0)" ::: "memory");
            const unsigned og = xb_add(&bar[XB_TOP], 1u);
            const unsigned tg = og / nx;
            if (og + 1u == (tg + 1u) * nx) xb_add(&bar[XB_TOPGEN], 1u);
            else XB_SPIN(xb_ld(&bar[XB_TOPGEN]) == tg, bar);
            __builtin_amdgcn_fence(__ATOMIC_ACQUIRE, "agent");
            xb_add(&bar[XB_XGEN(b.x)], 1u);
            asm volatile("s_waitcnt vmcnt(0)" ::: "memory");
        } else {
            XB_SPIN(xb_ld(&bar[XB_XGEN(b.x)]) == gen, bar);
            __builtin_amdgcn_fence(__ATOMIC_ACQUIRE, "agent");
            asm volatile("s_waitcnt vmcnt(0)" ::: "memory");
        }
    }
    __syncthreads();
}

namespace mk {
using pg8::bf16_t;
constexpr int NWAVES = 8, NTHR = 512;
constexpr int D = 1024, NB = 16, S = 2048, T = NB * S, NIN = 9222, NP = 9216;
constexpr int DFF = 2816, NE = 8, DFE = 3584;
constexpr float EPS = 1e-6f, LOG2E = 1.4426950408889634f;
constexpr int CH_B = 8, CH_T = CH_B * S;

constexpr size_t WS_CTL = 0, CTL_BYTES = 1u << 20, CTL_ZERO = 64u << 10;
constexpr size_t WS_MOD = WS_CTL + CTL_BYTES;
constexpr size_t WS_MISC = WS_MOD + (size_t)2 * NB * 6 * D * 4;
constexpr size_t WS_WIN = WS_MISC + (8u << 20);
constexpr size_t WS_WBR = WS_WIN + (size_t)2 * NP * D * 2;
constexpr size_t WS_WOUT = WS_WBR + (size_t)2 * 1280 * D * 2;
constexpr size_t WS_WGU0 = WS_WOUT + (size_t)2 * D * D * 2;
constexpr size_t WS_WD0 = WS_WGU0 + (size_t)2 * DFF * D * 2;
constexpr size_t WS_WGU1 = WS_WD0 + (size_t)D * DFF * 2;
constexpr size_t WS_WD1 = WS_WGU1 + (size_t)NE * 2 * DFE * D * 2;
constexpr size_t WS_H = WS_WD1 + (size_t)NE * D * DFE * 2;
constexpr size_t WS_PROJ = WS_H + (size_t)T * D * 2;
constexpr size_t WS_END = WS_PROJ + (size_t)CH_T * NP * 2;
constexpr size_t WS_QO = WS_PROJ;
constexpr size_t WS_KV = WS_QO + (size_t)CH_T * 2048 * 2;
constexpr size_t WS_GATE = WS_KV + (size_t)CH_T * 4096 * 2;
constexpr size_t KVB0 = (size_t)8 * 4 * 2 * 2048 * 128, KVC0 = KVB0 + (size_t)8 * 18 * 2 * 2048 * 64;
static_assert(WS_GATE + (size_t)CH_T * 3072 * 2 == WS_END, "projection buffers");
static_assert(WS_END <= 640000000ull, "d_ws map");
constexpr int MI_LAM = 0;
constexpr int MOE_MAXT = 264, MOE_ROWS = MOE_MAXT * 256;
constexpr int MI_TILE_E = 1024;
constexpr int MI_TOK_E = 4096;
constexpr int MI_TOK_POS = MI_TOK_E + 2 * T;
constexpr int MI_TOK_W = MI_TOK_POS + 2 * T;
constexpr int MI_ROW_W = MI_TOK_W + 2 * T;
constexpr int MI_LOGF = MI_ROW_W + MOE_ROWS;
constexpr int MI_NEGF = MI_LOGF + 8 * T;
constexpr int MI_LSE = MI_NEGF + NB * 6 * S;
constexpr int MI_LUTA = MI_LSE + 3 * CH_T * 8;
constexpr int MI_LUTB = MI_LUTA + 8 * 2240;
constexpr int MI_WF = MI_LUTB + 18 * 384;
constexpr int MI_END = MI_WF + 2 * 1024 * 8;
static_assert(MI_END * 4 <= (8 << 20), "MISC map");
constexpr size_t WS_HS = WS_PROJ;
constexpr size_t WS_ACT1 = WS_PROJ + (size_t)MOE_ROWS * D * 2;
constexpr int MOE_CH = 64;
static_assert(WS_ACT1 + (size_t)72 * 256 * DFE * 2 <= WS_END, "MoE buffers inside the PROJ region");
constexpr int CW_CNT = 64;
constexpr int CW_BAR = 4096;

constexpr int RING_BYTES = 131072, LDS_BYTES = 147456, LDSCTL_OFF = LDS_BYTES - 1024, MISC_OFF = LDSCTL_OFF + 320;

#define GAS __attribute__((address_space(1)))
typedef unsigned v4u __attribute__((ext_vector_type(4)));
typedef unsigned v2u __attribute__((ext_vector_type(2)));
typedef float f32x4 __attribute__((ext_vector_type(4)));
#define LDS_WAIT() asm volatile("s_waitcnt lgkmcnt(0)" ::: "memory")
__device__ __forceinline__ unsigned f2bf(float f) { unsigned u = __builtin_bit_cast(unsigned, f); return (u + 0x7fffu + ((u >> 16) & 1u)) >> 16; }
__device__ __forceinline__ unsigned pk2(float lo, float hi) { return f2bf(lo) | (f2bf(hi) << 16); }
__device__ __forceinline__ float wave_sum(float v) {
#pragma unroll
    for (int o = 1; o < 64; o <<= 1) v += __shfl_xor(v, o);
    return v;
}

struct Params { const float* in[26]; float* out; unsigned char* ws; int lo, hi, li, pad; };

typedef const __attribute__((address_space(4))) Params* CParams;
__device__ __forceinline__ Params load_params() {
#if defined(__HIP_DEVICE_COMPILE__)
    CParams pp = (CParams)__builtin_amdgcn_kernarg_segment_ptr(); asm volatile("" : "+s"(pp));
    Params q;
#pragma unroll
    for (int i = 0; i < 26; ++i) q.in[i] = pp->in[i];
    q.out = pp->out; q.ws = pp->ws; q.lo = pp->lo; q.hi = pp->hi; q.li = pp->li; q.pad = 0; return q;
#else
    return Params{};
#endif
}
constexpr int ST_PRO = 0, LSTEPS = 22, ST_L0 = 1;
constexpr int SO_NORM1 = 0, SO_CHUNK = 1, CSTEPS = 5, SO_NORM2 = 11, SO_FFN = 12;
constexpr int ST_END = ST_L0 + 2 * LSTEPS;

template <bool NT = false> __device__ __forceinline__ void transpose_item(const float* W, int ldw, int K  , bf16_t* WT, int k0, int n0, int drow0, LAS float* scr, int lane) {
    float tv[32];
#pragma unroll
    for (int i = 0; i < 32; ++i) { const float* s_ = W + (size_t)(k0 + 2 * i + (lane >> 5)) * ldw + n0 + (lane & 31); tv[i] = NT ? __builtin_nontemporal_load(s_) : *s_; }
#pragma unroll
    for (int i = 0; i < 32; ++i) scr[(2 * i + (lane >> 5)) * 33 + (lane & 31)] = tv[i];
    LDS_WAIT(); asm volatile("" ::: "memory");
    const int c = lane & 7;
#pragma unroll
    for (int j = 0; j < 4; ++j) { const int n = (lane >> 3) + 8 * j; const LAS float* s = scr + (8 * c) * 33 + n;
        v4u o; o.x = pk2(s[0 * 33], s[1 * 33]); o.y = pk2(s[2 * 33], s[3 * 33]); o.z = pk2(s[4 * 33], s[5 * 33]); o.w = pk2(s[6 * 33], s[7 * 33]);
        if (NT) __builtin_nontemporal_store(o, (GAS v4u*)(WT + (size_t)(drow0 + n) * K + k0 + 8 * c)); else *(GAS v4u*)(WT + (size_t)(drow0 + n) * K + k0 + 8 * c) = o; }
    LDS_WAIT(); asm volatile("" ::: "memory");
}
struct Job { const float* W; bf16_t* WT; int ldw, K, nblk, mode, drow, first, kp, pad; };
constexpr int NJOBS = 2 * 6 + 3 + 3 * NE;
__device__ __forceinline__ void job_set(LAS Job* J, int& nj, int& items, const float* W, int ldw, int K, int ncols, int mode, int drow, bf16_t* WT, int kp = 0) {
    J[nj].kp = kp ? kp : K; J[nj].W = W; J[nj].WT = WT; J[nj].ldw = ldw; J[nj].K = K; J[nj].nblk = ncols / 32; J[nj].mode = mode; J[nj].drow = drow; J[nj].first = items; ++nj; items += (K / 64) * (ncols / 32);
}
constexpr int PRO_SCR = 0, PRO_SC = 8 * 64 * 33 * 4  , PRO_JOB = PRO_SC + NB * D * 4  , PRO_JN = PRO_JOB + 48 * 48;
static_assert(PRO_JN + 64 <= LDSCTL_OFF && sizeof(Job) == 48 && NJOBS <= 48, "prologue LDS map");

__device__ __forceinline__ void build_luts(const Params& p, int tid);
__device__ __forceinline__ void prologue(const Params& p, LAS unsigned char* lds, int tid, int lane, int wave) {
    unsigned char* ws = p.ws;
    LAS Job* J = (LAS Job*)(lds + PRO_JOB);
    LAS int* JN = (LAS int*)(lds + PRO_JN);
    if (tid == 0) {
        int nj = 0, items = 0;
        for (int l = 0; l < 2; ++l) {
            bf16_t* win = (bf16_t*)(ws + WS_WIN) + (size_t)l * NP * D; const float* w_in = p.in[6] + (size_t)l * D * NIN;
            job_set(J, nj, items, w_in, NIN, D, 6144, 0, 0, win);
            job_set(J, nj, items, w_in + 6150, NIN, D, 3072, 0, 6144, win);
            bf16_t* wbr = (bf16_t*)(ws + WS_WBR) + (size_t)l * 1280 * D;
            job_set(J, nj, items, p.in[14] + (size_t)l * 512 * D, D, 512, D, 0, 0, wbr, 1280);
            job_set(J, nj, items, p.in[15] + (size_t)l * 384 * D, D, 384, D, 0, 0, wbr + 512, 1280);
            job_set(J, nj, items, p.in[16] + (size_t)l * 384 * D, D, 384, D, 0, 0, wbr + 896, 1280);
            job_set(J, nj, items, p.in[17] + (size_t)l * D * D, D, D, D, 0, 0, (bf16_t*)(ws + WS_WOUT) + (size_t)l * D * D);
        }
        job_set(J, nj, items, p.in[18], DFF, D, DFF, 1, 0, (bf16_t*)(ws + WS_WGU0));
        job_set(J, nj, items, p.in[19], DFF, D, DFF, 1, 128, (bf16_t*)(ws + WS_WGU0));
        job_set(J, nj, items, p.in[20], D, DFF, D, 0, 0, (bf16_t*)(ws + WS_WD0));
        JN[0] = nj; JN[1] = items;
    }
    LAS float* sc = (LAS float*)(lds + PRO_SC);
    const bool modblk = blockIdx.x < 192;
    if (modblk) for (int i = tid; i < NB * D; i += NTHR) { const float c = p.in[1][i]; sc[i] = c / (1.0f + __expf(-c)); }
    __syncthreads();
    float* misc = (float*)(ws + WS_MISC);
    if (blockIdx.x == 192 && wave < 2) {
        const int l = wave; const float a = wave_sum(p.in[8][l * 64 + lane] * p.in[9][l * 64 + lane]), b = wave_sum(p.in[10][l * 64 + lane] * p.in[11][l * 64 + lane]);
        const float lam_init = 0.8f - 0.6f * __expf(-0.3f * (float)l);
        if (lane == 0) { misc[MI_LAM + l] = __expf(a) - __expf(b) + lam_init; misc[MI_LAM + 8 + l] = lam_init; }
    }
    if (modblk) {
        const int l = blockIdx.x / 96, j = (blockIdx.x % 96) * 64 + lane;
        const float* w = p.in[4] + (size_t)l * D * 6 * D + (size_t)(wave * 128) * 6 * D + j;
        const LAS float* scw = sc + wave * 128;
        float acc[NB];
#pragma unroll
        for (int b = 0; b < NB; ++b) acc[b] = 0.f;
        for (int k0 = 0; k0 < 128; k0 += 16) {
            float wv[16];
#pragma unroll
            for (int i = 0; i < 16; ++i) wv[i] = w[(size_t)(k0 + i) * 6 * D];
#pragma unroll
            for (int i = 0; i < 16; ++i)
#pragma unroll
                for (int b = 0; b < NB; ++b) acc[b] += scw[b * D + k0 + i] * wv[i];
        }
        LAS float* part = (LAS float*)(lds + PRO_SCR) + wave * (64 * 33);
#pragma unroll
        for (int b = 0; b < NB; ++b) part[b * 64 + lane] = acc[b];
    }
    __syncthreads();
    if (modblk) {
        const int l = blockIdx.x / 96, j0 = (blockIdx.x % 96) * 64;
        float* mod = (float*)(ws + WS_MOD) + (size_t)l * NB * 6 * D;
        for (int o = tid; o < NB * 64; o += NTHR) { const int b = o >> 6, jj = o & 63; float sum = p.in[5][l * 6 * D + j0 + jj];
#pragma unroll
            for (int w8 = 0; w8 < NWAVES; ++w8) sum += ((const LAS float*)(lds + PRO_SCR) + w8 * (64 * 33))[b * 64 + jj];
            mod[(size_t)b * 6 * D + j0 + jj] = sum; }
    }
    __syncthreads();
    build_luts(p, tid);
    LAS float* scr = (LAS float*)(lds + PRO_SCR) + wave * (64 * 33);
    const int nj = JN[0], nitems = JN[1];
    const int gw = blockIdx.x * NWAVES + wave, NGW = gridDim.x * NWAVES;
    for (int it = gw; it < nitems; it += NGW) {
        int ji = 0;
        for (int q = 1; q < nj; ++q) if (J[q].first <= it) ji = q;
        const float* jW = J[ji].W; bf16_t* jWT = J[ji].WT; const int jldw = J[ji].ldw, jK = J[ji].kp, jnblk = J[ji].nblk, jmode = J[ji].mode, jdrow = J[ji].drow;
        const int r = it - J[ji].first, kb = r / jnblk, nb = r - kb * jnblk, n0 = 32 * nb;
        const int drow0 = jmode ? jdrow + 256 * (n0 >> 7) + (n0 & 127) : jdrow + n0;
        transpose_item(jW + n0, jldw, jK, jWT, 64 * kb, 0, drow0, scr, lane);
    }
}

constexpr int XI_MAT = 16 * (DFE / 32), XI_EXP = 3 * XI_MAT, XI_ALL = NE * XI_EXP;
static_assert(XI_MAT == (DFE / 64) * (D / 32), "expert item count");
__device__ __forceinline__ void expert_item(const Params& p, int it, LAS float* scr, int lane) {
    const int e = it / XI_EXP, r0 = it - e * XI_EXP, m = r0 / XI_MAT, r = r0 - m * XI_MAT;
    const bool dn = m == 2;
    const int nblk = dn ? D / 32 : DFE / 32, kb = r / nblk, n0 = 32 * (r - kb * nblk);
    const float* wg_ = p.in[22]; const float* wu_ = p.in[23]; const float* wd_ = p.in[24]; asm volatile("" : "+s"(wg_), "+s"(wu_), "+s"(wd_));
    const float* W = (dn ? wd_ : (m == 0 ? wg_ : wu_)) + (size_t)e * D * DFE + n0;
    bf16_t* WT = dn ? (bf16_t*)(p.ws + WS_WD1) + (size_t)e * D * DFE : (bf16_t*)(p.ws + WS_WGU1) + (size_t)e * 2 * DFE * D;
    const int drow0 = dn ? n0 : 128 * m + 256 * (n0 >> 7) + (n0 & 127);
    transpose_item<true>(W, dn ? D : DFE, dn ? DFE : D, WT, 64 * kb, 0, drow0, scr, lane);
}
constexpr int XQ_N = 64, XQ_ITEMS = XI_ALL / XQ_N, XQ_BATCH = 4, XQ_LDS = LDSCTL_OFF + 512;
constexpr size_t XQ_OFF = 32768;
static_assert(XI_ALL % XQ_N == 0 && XQ_ITEMS % XQ_BATCH == 0 && XQ_OFF + XQ_N * 512 <= CTL_ZERO && XQ_LDS + 8 * 16 <= LDS_BYTES, "expert queues");
__device__ __forceinline__ bool expert_steal_one(const Params& p, LAS unsigned char* lds, int lane, int wave) {
    volatile LAS int* st = (volatile LAS int*)(lds + XQ_LDS) + 4 * wave;
    int cur = __builtin_amdgcn_readfirstlane(st[0]); const int end = __builtin_amdgcn_readfirstlane(st[1]);
    if (cur == end) {
        if (__builtin_amdgcn_readfirstlane(st[2])) return false;
        unsigned* qb = (unsigned*)(p.ws + WS_CTL + XQ_OFF);
        const unsigned long long m = __ballot(xb_ld(qb + 128 * lane) < (unsigned)XQ_ITEMS);
        if (m == 0ull) { st[2] = 1; return false; }
        const int h = (int)(blockIdx.x * NWAVES + wave) & (XQ_N - 1);
        const unsigned long long r = h ? ((m >> h) | (m << (64 - h))) : m;
        const int k = (h + (int)__builtin_ctzll(r)) & (XQ_N - 1);
        unsigned v = 0; if (lane == 0) v = xb_add(qb + 128 * k, (unsigned)XQ_BATCH);
        v = (unsigned)__builtin_amdgcn_readfirstlane((int)v);
        if (v >= (unsigned)XQ_ITEMS) return true;
        cur = k * XQ_ITEMS + (int)v; st[1] = cur + XQ_BATCH;
    }
    expert_item(p, cur, (LAS float*)(lds + PRO_SCR) + wave * (64 * 33), lane);
    st[0] = cur + 1;
    return true;
}
__device__ __forceinline__ void expert_mopup(const Params& p, LAS unsigned char* lds, int lane, int wave) {
    while (expert_steal_one(p, lds, lane, wave)) {}
}
__device__ __forceinline__ void xcd_barrier_steal(const XcdBarrier& b, LAS unsigned char* lds) {
    asm volatile("s_waitcnt vmcnt(0)" ::: "memory");
    __syncthreads();
    volatile LAS unsigned* rel = (volatile LAS unsigned*)(lds + MISC_OFF + 48);
    int tid = threadIdx.x; asm volatile("" : "+v"(tid));
    if (tid < 64) {
        if (tid == 0) {
            unsigned* bar = b.bar;
            __builtin_amdgcn_s_waitcnt(0);
            unsigned nloc = b.st[0], nx = b.st[1];
            if (nloc == 0u) { xcd_barrier_complete(bar, b.x, nloc, nx); b.st[0] = nloc; b.st[1] = nx; }
            const unsigned old = xb_add(&bar[XB_XSUB(b.x)], 1u);
            const unsigned gen = old / nloc;
            if (old + 1u == (gen + 1u) * nloc) {
                rel[0] = 2u;
                __builtin_amdgcn_fence(__ATOMIC_RELEASE, "agent");
                asm volatile("s_waitcnt vmcnt(0)" ::: "memory");
                const unsigned og = xb_add(&bar[XB_TOP], 1u);
                const unsigned tg = og / nx;
                if (og + 1u == (tg + 1u) * nx) xb_add(&bar[XB_TOPGEN], 1u);
                else XB_SPIN(xb_ld(&bar[XB_TOPGEN]) == tg, bar);
                __builtin_amdgcn_fence(__ATOMIC_ACQUIRE, "agent");
                xb_add(&bar[XB_XGEN(b.x)], 1u);
                asm volatile("s_waitcnt vmcnt(0)" ::: "memory");
            } else {
                const unsigned stopat = (gen + 1u) * nloc - (nloc >> 3) - 1u;
                bool go = old + 1u < stopat;
                rel[0] = go ? 1u : 2u;
                unsigned sp = 0;
                while (xb_ld(&bar[XB_XGEN(b.x)]) == gen) {
                    if (go && xb_ld(&bar[XB_XSUB(b.x)]) >= stopat) { rel[0] = 2u; go = false; }
                    __builtin_amdgcn_s_sleep(1);
                    if ((++sp & 255u) == 0u) { if (xb_ld(&bar[XB_TMO])) break; if (sp > XB_SPIN_CAP) { atomicAdd(&bar[XB_TMO], 1u); break; } }
                }
                rel[0] = 2u;
                __builtin_amdgcn_fence(__ATOMIC_ACQUIRE, "agent");
                asm volatile("s_waitcnt vmcnt(0)" ::: "memory");
            }
        }
    } else {
        const Params p = load_params();
        const int lane = tid & 63, wave = __builtin_amdgcn_readfirstlane(tid >> 6);
        while (rel[0] == 0u) __builtin_amdgcn_s_sleep(1);
        while (rel[0] == 1u) { if (!expert_steal_one(p, lds, lane, wave)) break; }
        asm volatile("s_waitcnt vmcnt(0)" ::: "memory");
    }
    __syncthreads();
    if (tid == 0) rel[0] = 0u;
}

__device__ __forceinline__ void norm_rows(const float* x, const float* g, const float* sc, const float* sh, bf16_t* h, int t0, int t1, int gw, int NGW, int lane) {
    f32x4 vn[4], vm[4];
    { const int tf = (t0 + gw < t1) ? t0 + gw : 0, tg = (t0 + gw + NGW < t1) ? t0 + gw + NGW : tf; const GAS f32x4* xn = (const GAS f32x4*)(x + (size_t)tf * D) + lane; const GAS f32x4* xm = (const GAS f32x4*)(x + (size_t)tg * D) + lane;
#pragma unroll
      for (int j = 0; j < 4; ++j) { vn[j] = xn[64 * j]; vm[j] = xm[64 * j]; } }
    const int TEND = t1;
    for (int t = t0 + gw; t < t1; t += NGW) {
        const int b = t >> 11;
        f32x4 v[4]; float s = 0.f;
#pragma unroll
        for (int j = 0; j < 4; ++j) { v[j] = vn[j]; vn[j] = vm[j]; s += (v[j].x * v[j].x + v[j].y * v[j].y) + (v[j].z * v[j].z + v[j].w * v[j].w); }
        { const int tn = (t + 2 * NGW < TEND) ? t + 2 * NGW : t; const GAS f32x4* xn = (const GAS f32x4*)(x + (size_t)tn * D) + lane;
#pragma unroll
          for (int j = 0; j < 4; ++j) vm[j] = xn[64 * j]; }
        const float r = 1.0f / sqrtf(wave_sum(s) * (1.0f / D) + EPS);
        GAS v2u* o8 = (GAS v2u*)(h + (size_t)t * D) + lane;
#pragma unroll
        for (int j = 0; j < 4; ++j) { const int d = 4 * lane + 256 * j;
            const f32x4 g4 = *(const f32x4*)(g + d), c4 = *(const f32x4*)(sc + (size_t)b * 6 * D + d), h4 = *(const f32x4*)(sh + (size_t)b * 6 * D + d);
            const f32x4 o = v[j] * r * g4 * (c4 + 1.0f) + h4;
            v2u w; w.x = pk2(o.x, o.y); w.y = pk2(o.z, o.w); o8[64 * j] = w; }
    }
}


typedef float f32x16 __attribute__((ext_vector_type(16)));
typedef short bf16x8 __attribute__((ext_vector_type(8)));
typedef short s16x4 __attribute__((ext_vector_type(4)));
typedef float f32x2_t __attribute__((ext_vector_type(2))); typedef __bf16 bf16x2_t __attribute__((ext_vector_type(2)));
constexpr int QP = 2048;
constexpr int AL_K = 0, AL_V = 49152, AL_LUT = 114688, AL_OST = 65536, AL_XCH = 0;
static_assert(AL_LUT + 2 * 2240 * 4 <= LDSCTL_OFF && AL_OST + 34816 <= AL_LUT && 6 * 8192 <= AL_V && AL_V + 6 * 8192 <= AL_LUT, "attention LDS map");
constexpr int LUTA_N = 2240, LUTB_N = 384;
constexpr float NEG_BIG = -1.0e30f;
__device__ __forceinline__ unsigned cvtpk_s(float lo, float hi) { f32x2_t v = {lo, hi}; bf16x2_t b = __builtin_convertvector(v, bf16x2_t); return __builtin_bit_cast(unsigned, b); }
__device__ __forceinline__ s16x4 vtr(const LAS unsigned char* p) { typedef short v4i16_t __attribute__((ext_vector_type(4))); return __builtin_bit_cast(s16x4, __builtin_amdgcn_ds_read_tr16_b64_v4i16((LAS v4i16_t*)p)); }
__device__ __forceinline__ float xhalf_max(float v) { auto rr = __builtin_amdgcn_permlane32_swap(__float_as_uint(v), __float_as_uint(v), false, false); return fmaxf(__uint_as_float(rr[0]), __uint_as_float(rr[1])); }
__device__ __forceinline__ float xhalf_sum(float v) { auto rr = __builtin_amdgcn_permlane32_swap(__float_as_uint(v), __float_as_uint(v), false, false); return __uint_as_float(rr[0]) + __uint_as_float(rr[1]); }

struct AttnArgs {
    bf16_t* q;
    const bf16_t* k;
    const bf16_t* v;
    int q0;
    const float* tab;
    int seqM;
    float* lse;
    float lam, osc;
    const float* subg;
};
template <int MODE> __device__ __forceinline__ void attn_unit(const AttnArgs& a, LAS unsigned char* lds, int tid_in, int lane_in, int wave) {
    int tid = tid_in; asm volatile("" : "+v"(tid)); const int lane = tid & 63; (void)lane_in;
    constexpr int DV = MODE == 0 ? 128 : 64, NDB = DV / 32, NKL = MODE == 0 ? 2 : 1, NVL = MODE == 0 ? 2 : 1;
    const int r32 = lane & 31, hi = lane >> 5;
    const int map = MODE == 0 ? (wave >> 2) : 0, wq = MODE == 0 ? (wave & 3) : wave;
    const int qrow = a.q0 + 32 * wq;
    constexpr int KP = MODE == 0 ? 128 : 64, VP = KP;
    LAS float* lut = (LAS float*)(lds + AL_LUT);
    { constexpr int NT = MODE == 0 ? 2 * LUTA_N : (MODE == 1 ? 2048 : LUTB_N), NIT = (NT + NTHR - 1) / NTHR;
      const int need = MODE == 1 ? (a.q0 + 256) : NT;
      float tv[NIT];
#pragma unroll
      for (int k = 0; k < NIT; ++k) { const int i = tid + k * NTHR; tv[k] = i < need ? a.tab[i] : 0.f; }
#pragma unroll
      for (int k = 0; k < NIT; ++k) { const int i = tid + k * NTHR; if (i < need) lut[i] = tv[k]; } }
    bf16x8 qr[4];
    { const bf16_t* Qw = a.q + (size_t)(qrow + r32) * QP + map * 64 + hi * 8;
#pragma unroll
      for (int d0 = 0; d0 < 4; ++d0) qr[d0] = *(const bf16x8*)(Qw + d0 * 16); }
    int tlo, thi;
    if (MODE == 0) { tlo = 0; thi = (a.q0 + 128) / 64 - 1; }
    else if (MODE == 1) { tlo = 0; thi = (a.q0 + 256) / 64 - 1; }
    else { const int lo = a.q0 - 128; tlo = lo > 0 ? lo / 64 : 0; thi = (a.q0 + 256) / 64 - 1; }
    const bf16_t* gK = a.k + (size_t)(tid & 63) * KP + (tid >> 6) * 8;
    const bf16_t* gV = a.v + (size_t)(16 * (wave & 3) + (lane >> 2)) * VP + (wave >> 2) * 32 + (lane & 3) * 8;
#define AT_DMA(t_) do { const size_t ro = (size_t)(t_) * 64 * KP; const int ks_ = (MODE == 2 ? ((t_) - tlo) * 8192 : ((t_) % 3) * 16384) + wave * 1024, vs_ = (MODE == 2 ? ((t_) - tlo) * 8192 : ((t_) & 3) * 16384) + wave * 1024; \
        _Pragma("unroll") for (int i_ = 0; i_ < NKL; ++i_) __builtin_amdgcn_global_load_lds((const unsigned*)(gK + ro + i_ * 64), (LAS unsigned*)(lds + AL_K + ks_ + i_ * 8192), 16, 0, 0); \
        _Pragma("unroll") for (int i_ = 0; i_ < NVL; ++i_) __builtin_amdgcn_global_load_lds((const unsigned*)(gV + ro + i_ * 64), (LAS unsigned*)(lds + AL_V + vs_ + i_ * 8192), 16, 0, 0); } while (0)
#define AT_WAITBAR(n_) asm volatile("s_waitcnt vmcnt(" #n_ ") lgkmcnt(0)\n\ts_barrier" ::: "memory")
    constexpr float THR = 6.0f;
    float m_run = 0.f, l_run = 0.f;
    f32x16 negm = f32x16{};
    f32x16 o[NDB];
#pragma unroll
    for (int i = 0; i < NDB; ++i) o[i] = f32x16{};
    const int e0 = qrow + r32 - 4 * hi;
    int imax = 0, seq0 = 0;
    if (MODE == 2) { seq0 = qrow & ~(a.seqM - 1); const int dq = qrow + r32 - seq0; imax = dq < 128 ? dq : 128; }
    bf16x8 pw[4];
    bool pend = false; int pend_vs = 0;
#define AT_PV() do { const unsigned vb = (unsigned)(size_t)(lds + AL_V + pend_vs) + ((lane >> 4) & 1) * 32 + (lane & 3) * 8 + (4 * hi + ((lane & 15) >> 2)) * 64; \
        _Pragma("unroll") for (int dp = 0; dp < NDB; dp += 2) { s16x4 lo_[2][4], hh_[2][4];          \
            _Pragma("unroll") for (int dd = 0; dd < 2; ++dd) _Pragma("unroll") for (int ks = 0; ks < 4; ++ks) { \
                asm volatile("ds_read_b64_tr_b16 %0, %1 offset:%c2" : "=&v"(lo_[dd][ks]) : "v"(vb), "i"((dp + dd) * 4096 + ks * 1024) : "memory"); \
                asm volatile("ds_read_b64_tr_b16 %0, %1 offset:%c2" : "=&v"(hh_[dd][ks]) : "v"(vb), "i"((dp + dd) * 4096 + ks * 1024 + 512) : "memory"); } \
            asm volatile("s_waitcnt lgkmcnt(0)" ::: "memory"); __builtin_amdgcn_sched_barrier(0);     \
            _Pragma("unroll") for (int ks = 0; ks < 4; ++ks) _Pragma("unroll") for (int dd = 0; dd < 2; ++dd) { const bf16x8 vf = __builtin_shufflevector(lo_[dd][ks], hh_[dd][ks], 0, 1, 2, 3, 4, 5, 6, 7); \
                o[dp + dd] = __builtin_amdgcn_mfma_f32_32x32x16_bf16(vf, pw[ks], o[dp + dd], 0, 0, 0); } } } while (0)
#define MX3(a_, b_, c_) __builtin_fmaxf(__builtin_fmaxf((a_), (b_)), (c_))
#define AT_STEP(MASKED, t) do { \
        const int E = e0 - 64 * (t); \
        f32x16 p0, p1; \
        { const LAS unsigned char* kb = lds + AL_K + (MODE == 2 ? ((t) - tlo) * 8192 : ((t) % 3) * 16384) + map * 8192 + hi * 1024 + r32 * 16; bf16x8 kf[8]; \
          _Pragma("unroll") for (int d0 = 0; d0 < 4; ++d0) { kf[2 * d0] = *(const LAS bf16x8*)(kb + d0 * 2048); kf[2 * d0 + 1] = *(const LAS bf16x8*)(kb + d0 * 2048 + 512); }     \
          p0 = __builtin_amdgcn_mfma_f32_32x32x16_bf16(kf[0], qr[0], negm, 0, 0, 0); p1 = __builtin_amdgcn_mfma_f32_32x32x16_bf16(kf[1], qr[0], negm, 0, 0, 0); \
          _Pragma("unroll") for (int d0 = 1; d0 < 4; ++d0) { p0 = __builtin_amdgcn_mfma_f32_32x32x16_bf16(kf[2 * d0], qr[d0], p0, 0, 0, 0); p1 = __builtin_amdgcn_mfma_f32_32x32x16_bf16(kf[2 * d0 + 1], qr[d0], p1, 0, 0, 0); } } \
        if (pend) AT_PV(); \
        if (MODE == 0) __builtin_amdgcn_sched_barrier(0); \
        _Pragma("unroll") for (int hf = 0; hf < 2; ++hf) { f32x16 bb; \
            if (MODE == 1) { const LAS float* nf = lut + 64 * (t) + 4 * hi + 32 * hf; \
                _Pragma("unroll") for (int g = 0; g < 4; ++g) { const f32x4 a0 = *(const LAS f32x4*)(nf + 8 * g); bb[4 * g] = a0.x; bb[4 * g + 1] = a0.y; bb[4 * g + 2] = a0.z; bb[4 * g + 3] = a0.w; } \
            } else { const LAS float* lb = lut + (MODE == 0 ? map * LUTA_N + 2047 - E : 255 - E) + 32 * hf; \
                _Pragma("unroll") for (int r = 0; r < 16; ++r) bb[r] = lb[(r & 3) + 8 * (r >> 2)]; } \
            if (hf == 0) p0 += bb; else p1 += bb; \
            if (MODE == 0) __builtin_amdgcn_sched_barrier(0); } \
        if (MASKED) {   \
            if (MODE == 2) { if (qrow - seq0 < 128) { const int lim = E - imax; _Pragma("unroll") for (int r = 0; r < 16; ++r) { const int c0 = (r & 3) + 8 * (r >> 2), c1 = c0 + 32; \
                if (c0 < lim) p0[r] = -INFINITY; if (c1 < lim) p1[r] = -INFINITY; } } } \
            else if (MODE == 1) { _Pragma("unroll") for (int r = 0; r < 16; ++r) { const int c0 = (r & 3) + 8 * (r >> 2), c1 = c0 + 32; if (c0 > E) p0[r] = -INFINITY; if (c1 > E) p1[r] = -INFINITY; } } } \
        float ta = MX3(p0[0], p0[1], p1[0]), tb = MX3(p0[2], p0[3], p1[1]); ta = MX3(ta, p1[2], p1[3]); \
        _Pragma("unroll") for (int r = 4; r < 16; r += 4) { ta = MX3(ta, p0[r], p0[r + 1]); tb = MX3(tb, p0[r + 2], p0[r + 3]); ta = MX3(ta, p1[r], p1[r + 1]); tb = MX3(tb, p1[r + 2], p1[r + 3]); } \
        const float tm = xhalf_max(__builtin_fmaxf(ta, tb)); \
        bool resc = false; float al = 1.0f; \
        if (__any(tm > THR)) { const float dl = __builtin_fmaxf(tm, 0.f); m_run += dl; al = __builtin_amdgcn_exp2f(-dl); l_run *= al; resc = true; \
            _Pragma("unroll") for (int r = 0; r < 16; ++r) { p0[r] -= dl; p1[r] -= dl; negm[r] -= dl; } } \
        float rs0 = 0.f, rs1 = 0.f; \
        _Pragma("unroll") for (int r = 0; r < 16; ++r) { p0[r] = __builtin_amdgcn_exp2f(p0[r]); p1[r] = __builtin_amdgcn_exp2f(p1[r]); rs0 += p0[r]; rs1 += p1[r]; } \
        l_run += rs0 + rs1; \
        _Pragma("unroll") for (int ks = 0; ks < 4; ++ks) { v4u w; \
            if (ks < 2) { w.x = cvtpk_s(p0[8 * ks], p0[8 * ks + 1]); w.y = cvtpk_s(p0[8 * ks + 2], p0[8 * ks + 3]); w.z = cvtpk_s(p0[8 * ks + 4], p0[8 * ks + 5]); w.w = cvtpk_s(p0[8 * ks + 6], p0[8 * ks + 7]); } \
            else { const int k2 = ks - 2; w.x = cvtpk_s(p1[8 * k2], p1[8 * k2 + 1]); w.y = cvtpk_s(p1[8 * k2 + 2], p1[8 * k2 + 3]); w.z = cvtpk_s(p1[8 * k2 + 4], p1[8 * k2 + 5]); w.w = cvtpk_s(p1[8 * k2 + 6], p1[8 * k2 + 7]); } \
            pw[ks] = __builtin_bit_cast(bf16x8, w); } \
        if (resc) { _Pragma("unroll") for (int i = 0; i < NDB; ++i) _Pragma("unroll") for (int r = 0; r < 16; ++r) o[i][r] *= al; } \
        pend = true; pend_vs = MODE == 2 ? ((t) - tlo) * 8192 : ((t) & 3) * 16384; } while (0)
    constexpr int NPT = NKL + NVL;
#ifdef PROBE_ATT
    unsigned long long pt0_ = 0; const bool pr_ = ((PROBE_ATT >> MODE) & 1) && blockIdx.x == 0 && tid == 0; if (pr_) pt0_ = __builtin_amdgcn_s_memrealtime();
#endif
    asm volatile("s_waitcnt vmcnt(0) lgkmcnt(0)" ::: "memory");
    if (MODE == 2) {
        for (int t = tlo; t <= thi; ++t) AT_DMA(t);
        AT_WAITBAR(0);
        for (int t = tlo; t <= thi; ++t) {
            const int klo = qrow - 128 > seq0 ? qrow - 128 : seq0;
            const bool active = (64 * t <= qrow + 31) && (64 * t + 63 >= klo);
            if (active) AT_STEP(true, t);
        }
    } else {
    AT_DMA(tlo); if (tlo < thi) AT_DMA(tlo + 1);
    if (tlo < thi) { if (NPT == 4) AT_WAITBAR(4); else AT_WAITBAR(2); } else AT_WAITBAR(0);
    const int tband = thi - (MODE == 0 ? 1 : 3);
    int t = tlo;
    for (; t < tband; ++t) {
        AT_DMA(t + 2);
        AT_STEP(false, t);
        if (NPT == 4) AT_WAITBAR(4); else AT_WAITBAR(2);
    }
    for (; t <= thi; ++t) {
        if (t + 2 <= thi) AT_DMA(t + 2);
        const bool active = 64 * t <= qrow + 31;
        if (active) AT_STEP(true, t);
        else if (pend) { AT_PV(); pend = false; }
        if (t + 2 <= thi) { if (NPT == 4) AT_WAITBAR(4); else AT_WAITBAR(2); } else AT_WAITBAR(0);
    }
    }
    if (pend) AT_PV();
#ifdef PROBE_ATT
    if (pr_) { volatile LAS unsigned long long* q_ = (volatile LAS unsigned long long*)(lds + LDSCTL_OFF + 64); q_[1] += __builtin_amdgcn_s_memrealtime() - pt0_; }
#endif
    asm volatile("s_waitcnt lgkmcnt(0)\n\ts_barrier" ::: "memory");
#undef AT_STEP
#undef MX3
#undef AT_PV
#undef AT_DMA
#undef AT_WAITBAR
    const float lt = xhalf_sum(l_run), inv = 1.0f / lt;
#pragma unroll
    for (int i = 0; i < NDB; ++i)
#pragma unroll
        for (int r = 0; r < 16; ++r) o[i][r] *= inv;
    if (MODE == 2) { if (hi == 0) a.lse[(size_t)(qrow + r32) * 8] = m_run + __builtin_amdgcn_logf(lt); }
    bool store = true;
    if (MODE == 0) {
        LAS float* xch = (LAS float*)(lds + AL_XCH) + wq * 4096;
        if (map == 1) {
#pragma unroll
            for (int i = 0; i < NDB; ++i)
#pragma unroll
                for (int r = 0; r < 16; ++r) xch[(i * 16 + r) * 64 + lane] = o[i][r];
        }
        __syncthreads();
        if (map == 0) {
            float ss = 0.f;
#pragma unroll
            for (int i = 0; i < NDB; ++i)
#pragma unroll
                for (int r = 0; r < 16; ++r) { const float v = o[i][r] - a.lam * xch[(i * 16 + r) * 64 + lane]; o[i][r] = v; ss += v * v; }
            ss = xhalf_sum(ss);
            const float rn = (1.0f / sqrtf(ss * (1.0f / 128.0f) + EPS)) * a.osc;
#pragma unroll
            for (int i = 0; i < NDB; ++i)
#pragma unroll
                for (int g = 0; g < 4; ++g) { const f32x4 sg = *(const f32x4*)(a.subg + 32 * i + 8 * g + 4 * hi);
                    o[i][4 * g] *= rn * sg.x; o[i][4 * g + 1] *= rn * sg.y; o[i][4 * g + 2] *= rn * sg.z; o[i][4 * g + 3] *= rn * sg.w; }
        }
        store = map == 0;
    }
    if (store) {
        constexpr int RS = DV * 2 + 16;
        LAS unsigned char* ost = lds + AL_OST + wq * (32 * RS);
#pragma unroll
        for (int i = 0; i < NDB; ++i)
#pragma unroll
            for (int g = 0; g < 4; ++g) { v2u w; w.x = cvtpk_s(o[i][4 * g], o[i][4 * g + 1]); w.y = cvtpk_s(o[i][4 * g + 2], o[i][4 * g + 3]);
                *(LAS v2u*)(ost + r32 * RS + (32 * i + 8 * g + 4 * hi) * 2) = w; }
        LDS_WAIT();
        bf16_t* Ow = a.q + (size_t)qrow * QP;
        constexpr int CPR = DV / 8, RPI = 64 / CPR;
#pragma unroll
        for (int i = 0; i < 32 / RPI; ++i) { const int row = i * RPI + lane / CPR, ch = lane % CPR;
            const v4u v = *(const LAS v4u*)(ost + row * RS + ch * 16); *(GAS v4u*)(Ow + (size_t)row * QP + ch * 8) = v; }
    }
    __syncthreads();
}
__device__ const unsigned short SCHED_AC[256][6] = {
{0,848,1280,65535,65535,65535},
{1,849,1281,65535,65535,65535},
{2,850,1282,65535,65535,65535},
{3,851,1283,65535,65535,65535},
{4,852,1284,65535,65535,65535},
{5,853,1285,65535,65535,65535},
{6,854,1286,65535,65535,65535},
{7,855,1287,65535,65535,65535},
{8,856,1288,65535,65535,65535},
{9,857,1289,65535,65535,65535},
{10,858,1290,65535,65535,65535},
{11,859,1291,65535,65535,65535},
{12,860,1292,65535,65535,65535},
{13,861,1293,65535,65535,65535},
{14,862,1294,65535,65535,65535},
{15,863,1295,65535,65535,65535},
{16,864,1296,65535,65535,65535},
{17,865,1297,65535,65535,65535},
{18,866,1298,65535,65535,65535},
{19,867,1299,65535,65535,65535},
{20,868,1300,65535,65535,65535},
{21,869,1301,65535,65535,65535},
{22,870,1302,65535,65535,65535},
{23,871,1303,65535,65535,65535},
{24,872,1304,65535,65535,65535},
{25,873,1305,65535,65535,65535},
{26,874,1306,65535,65535,65535},
{27,875,1307,65535,65535,65535},
{28,876,1308,65535,65535,65535},
{29,877,1309,65535,65535,65535},
{30,878,1310,65535,65535,65535},
{31,879,1311,65535,65535,65535},
{64,784,1216,1344,65535,65535},
{65,785,1217,1345,65535,65535},
{66,786,1218,1346,65535,65535},
{67,787,1219,1347,65535,65535},
{68,788,1220,1348,65535,65535},
{69,789,1221,1349,65535,65535},
{70,790,1222,1350,65535,65535},
{71,791,1223,1351,65535,65535},
{72,792,1224,1352,65535,65535},
{73,793,1225,1353,65535,65535},
{74,794,1226,1354,65535,65535},
{75,795,1227,1355,65535,65535},
{76,796,1228,1356,65535,65535},
{77,797,1229,1357,65535,65535},
{78,798,1230,1358,65535,65535},
{79,799,1231,1359,65535,65535},
{80,832,1184,65535,65535,65535},
{81,833,1185,65535,65535,65535},
{82,834,1186,65535,65535,65535},
{83,835,1187,65535,65535,65535},
{84,836,1188,65535,65535,65535},
{85,837,1189,65535,65535,65535},
{86,838,1190,65535,65535,65535},
{87,839,1191,65535,65535,65535},
{88,840,1192,65535,65535,65535},
{89,841,1193,65535,65535,65535},
{90,842,1194,65535,65535,65535},
{91,843,1195,65535,65535,65535},
{92,844,1196,65535,65535,65535},
{93,845,1197,65535,65535,65535},
{94,846,1198,65535,65535,65535},
{95,847,1199,65535,65535,65535},
{128,736,1232,1360,65535,65535},
{129,737,1233,1361,65535,65535},
{130,738,1234,1362,65535,65535},
{131,739,1235,1363,65535,65535},
{132,740,1236,1364,65535,65535},
{133,741,1237,1365,65535,65535},
{134,742,1238,1366,65535,65535},
{135,743,1239,1367,65535,65535},
{136,744,1240,1368,65535,65535},
{137,745,1241,1369,65535,65535},
{138,746,1242,1370,65535,65535},
{139,747,1243,1371,65535,65535},
{140,748,1244,1372,65535,65535},
{141,749,1245,1373,65535,65535},
{142,750,1246,1374,65535,65535},
{143,751,1247,1375,65535,65535},
{144,768,1104,1408,65535,65535},
{145,769,1105,1409,65535,65535},
{146,770,1106,1410,65535,65535},
{147,771,1107,1411,65535,65535},
{148,772,1108,1412,65535,65535},
{149,773,1109,1413,65535,65535},
{150,774,1110,1414,65535,65535},
{151,775,1111,1415,65535,65535},
{152,776,1112,1416,65535,65535},
{153,777,1113,1417,65535,65535},
{154,778,1114,1418,65535,65535},
{155,779,1115,1419,65535,65535},
{156,780,1116,1420,65535,65535},
{157,781,1117,1421,65535,65535},
{158,782,1118,1422,65535,65535},
{159,783,1119,1423,65535,65535},
{192,704,1152,1424,65535,65535},
{193,705,1153,1425,65535,65535},
{194,706,1154,1426,65535,65535},
{195,707,1155,1427,65535,65535},
{196,708,1156,1428,65535,65535},
{197,709,1157,1429,65535,65535},
{198,710,1158,1430,65535,65535},
{199,711,1159,1431,65535,65535},
{200,712,1160,1432,65535,65535},
{201,713,1161,1433,65535,65535},
{202,714,1162,1434,65535,65535},
{203,715,1163,1435,65535,65535},
{204,716,1164,1436,65535,65535},
{205,717,1165,1437,65535,65535},
{206,718,1166,1438,65535,65535},
{207,719,1167,1439,65535,65535},
{208,720,1168,1440,65535,65535},
{209,721,1169,1441,65535,65535},
{210,722,1170,1442,65535,65535},
{211,723,1171,1443,65535,65535},
{212,724,1172,1444,65535,65535},
{213,725,1173,1445,65535,65535},
{214,726,1174,1446,65535,65535},
{215,727,1175,1447,65535,65535},
{216,728,1176,1448,65535,65535},
{217,729,1177,1449,65535,65535},
{218,730,1178,1450,65535,65535},
{219,731,1179,1451,65535,65535},
{220,732,1180,1452,65535,65535},
{221,733,1181,1453,65535,65535},
{222,734,1182,1454,65535,65535},
{223,735,1183,1455,65535,65535},
{256,640,896,65535,65535,65535},
{257,641,897,65535,65535,65535},
{258,642,898,65535,65535,65535},
{259,643,899,65535,65535,65535},
{260,644,900,65535,65535,65535},
{261,645,901,65535,65535,65535},
{262,646,902,65535,65535,65535},
{263,647,903,65535,65535,65535},
{264,648,904,65535,65535,65535},
{265,649,905,65535,65535,65535},
{266,650,906,65535,65535,65535},
{267,651,907,65535,65535,65535},
{268,652,908,65535,65535,65535},
{269,653,909,65535,65535,65535},
{270,654,910,65535,65535,65535},
{271,655,911,65535,65535,65535},
{272,656,912,65535,65535,65535},
{273,657,913,65535,65535,65535},
{274,658,914,65535,65535,65535},
{275,659,915,65535,65535,65535},
{276,660,916,65535,65535,65535},
{277,661,917,65535,65535,65535},
{278,662,918,65535,65535,65535},
{279,663,919,65535,65535,65535},
{280,664,920,65535,65535,65535},
{281,665,921,65535,65535,65535},
{282,666,922,65535,65535,65535},
{283,667,923,65535,65535,65535},
{284,668,924,65535,65535,65535},
{285,669,925,65535,65535,65535},
{286,670,926,65535,65535,65535},
{287,671,927,65535,65535,65535},
{320,576,960,65535,65535,65535},
{321,577,961,65535,65535,65535},
{322,578,962,65535,65535,65535},
{323,579,963,65535,65535,65535},
{324,580,964,65535,65535,65535},
{325,581,965,65535,65535,65535},
{326,582,966,65535,65535,65535},
{327,583,967,65535,65535,65535},
{328,584,968,65535,65535,65535},
{329,585,969,65535,65535,65535},
{330,586,970,65535,65535,65535},
{331,587,971,65535,65535,65535},
{332,588,972,65535,65535,65535},
{333,589,973,65535,65535,65535},
{334,590,974,65535,65535,65535},
{335,591,975,65535,65535,65535},
{336,592,976,65535,65535,65535},
{337,593,977,65535,65535,65535},
{338,594,978,65535,65535,65535},
{339,595,979,65535,65535,65535},
{340,596,980,65535,65535,65535},
{341,597,981,65535,65535,65535},
{342,598,982,65535,65535,65535},
{343,599,983,65535,65535,65535},
{344,600,984,65535,65535,65535},
{345,601,985,65535,65535,65535},
{346,602,986,65535,65535,65535},
{347,603,987,65535,65535,65535},
{348,604,988,65535,65535,65535},
{349,605,989,65535,65535,65535},
{350,606,990,65535,65535,65535},
{351,607,991,65535,65535,65535},
{384,512,992,65535,65535,65535},
{385,513,993,65535,65535,65535},
{386,514,994,65535,65535,65535},
{387,515,995,65535,65535,65535},
{388,516,996,65535,65535,65535},
{389,517,997,65535,65535,65535},
{390,518,998,65535,65535,65535},
{391,519,999,65535,65535,65535},
{392,520,1000,65535,65535,65535},
{393,521,1001,65535,65535,65535},
{394,522,1002,65535,65535,65535},
{395,523,1003,65535,65535,65535},
{396,524,1004,65535,65535,65535},
{397,525,1005,65535,65535,65535},
{398,526,1006,65535,65535,65535},
{399,527,1007,65535,65535,65535},
{400,528,1024,1472,65535,65535},
{401,529,1025,1473,65535,65535},
{402,530,1026,1474,65535,65535},
{403,531,1027,1475,65535,65535},
{404,532,1028,1476,65535,65535},
{405,533,1029,1477,65535,65535},
{406,534,1030,1478,65535,65535},
{407,535,1031,1479,65535,65535},
{408,536,1032,1480,65535,65535},
{409,537,1033,1481,65535,65535},
{410,538,1034,1482,65535,65535},
{411,539,1035,1483,65535,65535},
{412,540,1036,1484,65535,65535},
{413,541,1037,1485,65535,65535},
{414,542,1038,1486,65535,65535},
{415,543,1039,1487,65535,65535},
{416,544,1040,1488,65535,65535},
{417,545,1041,1489,65535,65535},
{418,546,1042,1490,65535,65535},
{419,547,1043,1491,65535,65535},
{420,548,1044,1492,65535,65535},
{421,549,1045,1493,65535,65535},
{422,550,1046,1494,65535,65535},
{423,551,1047,1495,65535,65535},
{424,552,1048,1496,65535,65535},
{425,553,1049,1497,65535,65535},
{426,554,1050,1498,65535,65535},
{427,555,1051,1499,65535,65535},
{428,556,1052,1500,65535,65535},
{429,557,1053,1501,65535,65535},
{430,558,1054,1502,65535,65535},
{431,559,1055,1503,65535,65535},
{448,464,1088,1312,65535,65535},
{449,465,1089,1313,65535,65535},
{450,466,1090,1314,65535,65535},
{451,467,1091,1315,65535,65535},
{452,468,1092,1316,65535,65535},
{453,469,1093,1317,65535,65535},
{454,470,1094,1318,65535,65535},
{455,471,1095,1319,65535,65535},
{456,472,1096,1320,65535,65535},
{457,473,1097,1321,65535,65535},
{458,474,1098,1322,65535,65535},
{459,475,1099,1323,65535,65535},
{460,476,1100,1324,65535,65535},
{461,477,1101,1325,65535,65535},
{462,478,1102,1326,65535,65535},
{463,479,1103,1327,65535,65535}
};

static_assert(LUTA_N == 2240 && LUTB_N == 384, "table sizes vs the MISC map");
__device__ __forceinline__ int t5_bucket(int n) {
    if (n < 16) return n < 0 ? 0 : n;
    int b = 16;
    b += n >= 22; b += n >= 30; b += n >= 40; b += n >= 54; b += n >= 73; b += n >= 99; b += n >= 134; b += n >= 182; b += n >= 246; b += n >= 332; b += n >= 450; b += n >= 609; b += n >= 825; b += n >= 1117; b += n >= 1513;
    return b;
}
__device__ __forceinline__ void build_luts(const Params& p, int tid) {
    float* misc = (float*)(p.ws + WS_MISC); const float* rb = p.in[13];
    for (int i = blockIdx.x * NTHR + tid; i < 2 * D * 8; i += gridDim.x * NTHR) { const int l = i >> 13, d = (i >> 3) & 1023, e = i & 7; misc[MI_WF + i] = e < 6 ? p.in[6][(size_t)l * D * NIN + (size_t)d * NIN + 6144 + e] : 0.f; }
    for (int i = blockIdx.x * NTHR + tid; i < 8 * LUTA_N + 18 * LUTB_N; i += gridDim.x * NTHR) {
        if (i < 8 * LUTA_N) { const int hm = i / LUTA_N, j = i % LUTA_N, d = 2047 - j; misc[MI_LUTA + i] = d >= 0 ? rb[t5_bucket(d) * 26 + hm] * LOG2E : -INFINITY; }
        else { const int k = i - 8 * LUTA_N, gh = k / LUTB_N, j = k % LUTB_N, ii = 255 - j, g = gh / 6; misc[MI_LUTB + k] = (ii >= 0 && ii <= 128) ? rb[t5_bucket(ii << (2 * g)) * 26 + 8 + gh] * LOG2E : -INFINITY; }
    }
}
__device__ __forceinline__ void norm_logf(const Params& p, int L, const float* x, const float* g, const float* sc, const float* sh, bf16_t* h, LAS unsigned char* lds, int tid, int lane, int wave) {
    LAS float* wf = (LAS float*)lds;
    const float* w_in = p.in[6] + (size_t)L * D * NIN;
    { const float* src = (const float*)(p.ws + WS_MISC) + MI_WF + L * D * 8; f32x4 tv[4];
#pragma unroll
      for (int k = 0; k < 4; ++k) tv[k] = *(const GAS f32x4*)(src + (tid + k * NTHR) * 4);
#pragma unroll
      for (int k = 0; k < 4; ++k) *(LAS f32x4*)(wf + (tid + k * NTHR) * 4) = tv[k]; }
    (void)w_in;
    __syncthreads();
    const int gw = blockIdx.x * NWAVES + wave, NGW = gridDim.x * NWAVES;
    float* logf = (float*)(p.ws + WS_MISC) + MI_LOGF;
    const float bfv = lane < 6 ? p.in[7][L * 6 + lane] : 0.f;
    f32x4 vn[4], vm[4];
    { const int tf = (gw < T) ? gw : 0, tg = (gw + NGW < T) ? gw + NGW : tf; const GAS f32x4* xn = (const GAS f32x4*)(x + (size_t)tf * D) + lane; const GAS f32x4* xm = (const GAS f32x4*)(x + (size_t)tg * D) + lane;
#pragma unroll
      for (int j = 0; j < 4; ++j) { vn[j] = xn[64 * j]; vm[j] = xm[64 * j]; } }
    constexpr int TEND = T;
    for (int t = gw; t < T; t += NGW) {
        const int b = t >> 11;
        f32x4 v[4]; float s = 0.f;
#pragma unroll
        for (int j = 0; j < 4; ++j) { v[j] = vn[j]; vn[j] = vm[j]; s += (v[j].x * v[j].x + v[j].y * v[j].y) + (v[j].z * v[j].z + v[j].w * v[j].w); }
        { const int tn = (t + 2 * NGW < TEND) ? t + 2 * NGW : t; const GAS f32x4* xn = (const GAS f32x4*)(x + (size_t)tn * D) + lane;
#pragma unroll
          for (int j = 0; j < 4; ++j) vm[j] = xn[64 * j]; }
        const float r = 1.0f / sqrtf(wave_sum(s) * (1.0f / D) + EPS);
        GAS v2u* o8 = (GAS v2u*)(h + (size_t)t * D) + lane;
        float lg[8];
#pragma unroll
        for (int e = 0; e < 8; ++e) lg[e] = 0.f;
#pragma unroll
        for (int j = 0; j < 4; ++j) { const int d = 4 * lane + 256 * j;
            const f32x4 g4 = *(const f32x4*)(g + d), c4 = *(const f32x4*)(sc + (size_t)b * 6 * D + d), h4 = *(const f32x4*)(sh + (size_t)b * 6 * D + d);
            const f32x4 o = v[j] * r * g4 * (c4 + 1.0f) + h4;
            v2u w; w.x = pk2(o.x, o.y); w.y = pk2(o.z, o.w); o8[64 * j] = w;
#pragma unroll
            for (int cc = 0; cc < 4; ++cc) { const f32x4 w0 = *(const LAS f32x4*)(wf + (d + cc) * 8), w1 = *(const LAS f32x4*)(wf + (d + cc) * 8 + 4); const float ov = o[cc];
                lg[0] += ov * w0.x; lg[1] += ov * w0.y; lg[2] += ov * w0.z; lg[3] += ov * w0.w; lg[4] += ov * w1.x; lg[5] += ov * w1.y; } }
        float mine = 0.f;
#pragma unroll
        for (int e = 0; e < 6; ++e) { const float sm = wave_sum(lg[e]); if (lane == e) mine = sm; }
        if (lane < 6) { const float z = mine + bfv; logf[(size_t)t * 8 + lane] = fminf(z, 0.f) - log1pf(__expf(-fabsf(z))); }
    }
}
__device__ __forceinline__ void negf_cumsum(const Params& p, int b, int hh, int lane) {
    const float* logf = (const float*)(p.ws + WS_MISC) + MI_LOGF + (size_t)b * S * 8 + hh;
    float* nf = (float*)(p.ws + WS_MISC) + MI_NEGF + (size_t)(b * 6 + hh) * S;
    float run = 0.f; float loc[32];
#pragma unroll
    for (int i = 0; i < 32; ++i) { run += logf[(size_t)(lane * 32 + i) * 8]; loc[i] = run; }
    float incl = run;
#pragma unroll
    for (int o = 1; o < 64; o <<= 1) { const float u = __shfl_up(incl, o); if (lane >= o) incl += u; }
    const float excl = incl - run;
#pragma unroll
    for (int i = 0; i < 32; ++i) nf[lane * 32 + i] = -(excl + loc[i]) * LOG2E;
}
__device__ __forceinline__ void merge_b(const Params& p, int lane, int wave) {
    bf16_t* proj = (bf16_t*)(p.ws + WS_QO); const float* lse = (const float*)(p.ws + WS_MISC) + MI_LSE;
    const int gw = blockIdx.x * NWAVES + wave, NGW = gridDim.x * NWAVES;
    if (lane < 48) {
        const int h = lane >> 3;
        for (int rb = gw; rb < CH_T; rb += 4 * NGW) {
            float l0[4], l1[4], l2[4]; v4u o0[4], o1[4], o2[4];
#pragma unroll
            for (int k = 0; k < 4; ++k) {
                const int r = (rb + k * NGW < CH_T) ? rb + k * NGW : gw;
                const int t = r & 2047, base = r & ~2047;
                const int r1 = base | ((t & 3) << 9) | (t >> 2), r2 = base | ((t & 15) << 7) | (t >> 4);
                l0[k] = lse[(size_t)r * 8 + h]; l1[k] = lse[(size_t)(CH_T + r1) * 8 + h]; l2[k] = lse[(size_t)(2 * CH_T + r2) * 8 + h];
                o0[k] = *(const GAS v4u*)(proj + (size_t)r * QP + 512 + lane * 8); o1[k] = *(const GAS v4u*)(proj + (size_t)r1 * QP + 512 + 384 + lane * 8); o2[k] = *(const GAS v4u*)(proj + (size_t)r2 * QP + 512 + 768 + lane * 8);
            }
#pragma unroll
            for (int k = 0; k < 4; ++k) {
                const int r = rb + k * NGW;
                const float mx = fmaxf(l0[k], fmaxf(l1[k], l2[k]));
                float a0 = __builtin_amdgcn_exp2f(l0[k] - mx), a1 = __builtin_amdgcn_exp2f(l1[k] - mx), a2 = __builtin_amdgcn_exp2f(l2[k] - mx);
                const float is = 1.0f / (a0 + a1 + a2); a0 *= is; a1 *= is; a2 *= is;
                const v4u x0 = o0[k], x1 = o1[k], x2 = o2[k];
                v4u w;
                w.x = pk2(a0 * pg8::bf_lo(x0.x) + a1 * pg8::bf_lo(x1.x) + a2 * pg8::bf_lo(x2.x), a0 * pg8::bf_hi(x0.x) + a1 * pg8::bf_hi(x1.x) + a2 * pg8::bf_hi(x2.x));
                w.y = pk2(a0 * pg8::bf_lo(x0.y) + a1 * pg8::bf_lo(x1.y) + a2 * pg8::bf_lo(x2.y), a0 * pg8::bf_hi(x0.y) + a1 * pg8::bf_hi(x1.y) + a2 * pg8::bf_hi(x2.y));
                w.z = pk2(a0 * pg8::bf_lo(x0.z) + a1 * pg8::bf_lo(x1.z) + a2 * pg8::bf_lo(x2.z), a0 * pg8::bf_hi(x0.z) + a1 * pg8::bf_hi(x1.z) + a2 * pg8::bf_hi(x2.z));
                w.w = pk2(a0 * pg8::bf_lo(x0.w) + a1 * pg8::bf_lo(x1.w) + a2 * pg8::bf_lo(x2.w), a0 * pg8::bf_hi(x0.w) + a1 * pg8::bf_hi(x1.w) + a2 * pg8::bf_hi(x2.w));
                if (r < CH_T) *(GAS v4u*)(proj + (size_t)r * QP + 512 + lane * 8) = w;
            }
        }
    }
}
__device__ __forceinline__ void attn_b_phase(const Params& p, LAS unsigned char* lds, int tid, int lane, int wave) {
    const float* misc = (const float*)(p.ws + WS_MISC);
    for (int L = blockIdx.x; L < CH_B * 3 * 6 * 8; L += gridDim.x) {
        const int blk = L & 7, h = (L >> 3) % 6; int g, b; if (L < 768) { g = (L / 48) & 1; b = L / 96; } else { g = 2; b = (L - 768) / 48; }
        AttnArgs a; a.q0 = blk * 256; a.q = (bf16_t*)(p.ws + WS_QO) + (size_t)(b * S) * QP + 512 + g * 384 + h * 64;
        a.k = (const bf16_t*)(p.ws + WS_KV) + KVB0 + (size_t)(((b * 3 + g) * 6 + h) * 2) * (2048 * 64); a.v = a.k + 2048 * 64;
        a.tab = misc + MI_LUTB + (g * 6 + h) * LUTB_N; a.seqM = S >> (2 * g); a.lse = (float*)(p.ws + WS_MISC) + MI_LSE + ((size_t)g * CH_T + (size_t)b * S) * 8 + h; a.lam = 0.f; a.osc = 0.f; a.subg = nullptr;
        attn_unit<2>(a, lds, tid, lane, wave);
    }
}
__device__ __forceinline__ void attn_ac_phase(const Params& p, int L, int c, LAS unsigned char* lds, int tid, int lane, int wave) {
    const float* misc = (const float*)(p.ws + WS_MISC);
    constexpr unsigned char CTYPE[24] = {0,0,0,0,0,0,1,0,1,0,0,1,0,1,0,1,0,0,1,0,1,0,1,0}, CQB[24] = {15,14,13,12,11,10,7,9,6,8,7,5,6,4,5,3,4,3,2,2,1,1,0,0};
    constexpr unsigned short CFIRST[25] = {0,32,64,96,128,160,192,240,272,320,352,384,432,464,512,544,592,624,656,704,736,784,816,864,896};
    const bool lpt = gridDim.x == 256;
#pragma unroll 1
    for (int i = 0; ; ++i) {
        int cls, k;
        if (lpt) { if (i >= 6) break; const unsigned e = SCHED_AC[blockIdx.x][i]; if (e == 0xFFFFu) break; cls = (int)(e >> 6); k = (int)(e & 63u); }
        else { const int j = i * (int)gridDim.x + (int)blockIdx.x; if (j >= 896) break; cls = 0; for (int q = 1; q < 24; ++q) if ((int)CFIRST[q] <= j) cls = q; k = j - (int)CFIRST[cls]; }
        cls = __builtin_amdgcn_readfirstlane(cls); k = __builtin_amdgcn_readfirstlane(k);
        if (CTYPE[cls] != 0) continue;
        const int qb = CQB[cls], b = k >> 2, h = k & 3;
        AttnArgs a; a.seqM = 0; a.lse = nullptr; a.q0 = qb * 128; a.q = (bf16_t*)(p.ws + WS_QO) + (size_t)(b * S) * QP + h * 128;
        a.k = (const bf16_t*)(p.ws + WS_KV) + (size_t)((b * 4 + h) * 2) * (2048 * 128); a.v = a.k + 2048 * 128;
        a.tab = misc + MI_LUTA + 2 * h * LUTA_N; a.lam = misc[MI_LAM + L]; a.osc = 1.0f - misc[MI_LAM + 8 + L]; a.subg = p.in[12] + L * 128;
        attn_unit<0>(a, lds, tid, lane, wave);
    }
#pragma unroll 1
    for (int i = 0; ; ++i) {
        int cls, k;
        if (lpt) { if (i >= 6) break; const unsigned e = SCHED_AC[blockIdx.x][i]; if (e == 0xFFFFu) break; cls = (int)(e >> 6); k = (int)(e & 63u); }
        else { const int j = i * (int)gridDim.x + (int)blockIdx.x; if (j >= 896) break; cls = 0; for (int q = 1; q < 24; ++q) if ((int)CFIRST[q] <= j) cls = q; k = j - (int)CFIRST[cls]; }
        cls = __builtin_amdgcn_readfirstlane(cls); k = __builtin_amdgcn_readfirstlane(k);
        if (CTYPE[cls] != 1) continue;
        const int qb = CQB[cls], b = k / 6, h = k % 6;
        AttnArgs a; a.seqM = 0; a.lse = nullptr; a.q0 = qb * 256; a.q = (bf16_t*)(p.ws + WS_QO) + (size_t)(b * S) * QP + 1664 + h * 64;
        a.k = (const bf16_t*)(p.ws + WS_KV) + KVC0 + (size_t)((b * 6 + h) * 2) * (2048 * 64); a.v = a.k + 2048 * 64;
        a.tab = misc + MI_NEGF + (size_t)((c * CH_B + b) * 6 + h) * S; a.lam = 0.f; a.osc = 0.f; a.subg = nullptr;
        attn_unit<1>(a, lds, tid, lane, wave);
    }
    merge_b(p, lane, wave);
}

constexpr int RT_WR = 0, RT_CNT = D * NE * 4, RT_REC = RT_CNT + 64, RT_RECW = 64;
__device__ __forceinline__ void norm_route(const Params& p, const float* g, const float* sc, const float* sh, bf16_t* h, LAS unsigned char* lds, int tid, int lane, int wave) {
    LAS float* wr = (LAS float*)(lds + RT_WR); LAS unsigned* lcnt = (LAS unsigned*)(lds + RT_CNT); LAS unsigned* lbase = lcnt + 8;
    LAS int* rec = (LAS int*)(lds + RT_REC) + wave * (RT_RECW * 8);
    { f32x4 tv[4];
#pragma unroll
      for (int k = 0; k < 4; ++k) tv[k] = *(const GAS f32x4*)(p.in[21] + (tid + k * NTHR) * 4);
#pragma unroll
      for (int k = 0; k < 4; ++k) *(LAS f32x4*)(wr + (tid + k * NTHR) * 4) = tv[k]; }
    if (tid < 16) lcnt[tid] = 0u;
    __syncthreads();
    const int gw = blockIdx.x * NWAVES + wave, NGW = gridDim.x * NWAVES;
    const float* x = p.out;
    int k = 0;
    f32x4 vn[4], vm[4];
    { const int tf = (gw < T) ? gw : 0, tg = (gw + NGW < T) ? gw + NGW : tf; const GAS f32x4* xn = (const GAS f32x4*)(x + (size_t)tf * D) + lane; const GAS f32x4* xm = (const GAS f32x4*)(x + (size_t)tg * D) + lane;
#pragma unroll
      for (int j = 0; j < 4; ++j) { vn[j] = xn[64 * j]; vm[j] = xm[64 * j]; } }
    constexpr int TEND = T;
    for (int t = gw; t < T && k < RT_RECW; t += NGW, ++k) {
        const int b = t >> 11;
        f32x4 v[4]; float s = 0.f;
#pragma unroll
        for (int j = 0; j < 4; ++j) { v[j] = vn[j]; vn[j] = vm[j]; s += (v[j].x * v[j].x + v[j].y * v[j].y) + (v[j].z * v[j].z + v[j].w * v[j].w); }
        { const int tn = (t + 2 * NGW < TEND) ? t + 2 * NGW : t; const GAS f32x4* xn = (const GAS f32x4*)(x + (size_t)tn * D) + lane;
#pragma unroll
          for (int j = 0; j < 4; ++j) vm[j] = xn[64 * j]; }
        const float r = 1.0f / sqrtf(wave_sum(s) * (1.0f / D) + EPS);
        GAS v2u* o8 = (GAS v2u*)(h + (size_t)t * D) + lane;
        float lg[NE];
#pragma unroll
        for (int e = 0; e < NE; ++e) lg[e] = 0.f;
#pragma unroll
        for (int j = 0; j < 4; ++j) { const int d = 4 * lane + 256 * j;
            const f32x4 g4 = *(const f32x4*)(g + d), c4 = *(const f32x4*)(sc + (size_t)b * 6 * D + d), h4 = *(const f32x4*)(sh + (size_t)b * 6 * D + d);
            const f32x4 o = v[j] * r * g4 * (c4 + 1.0f) + h4;
            v2u w; w.x = pk2(o.x, o.y); w.y = pk2(o.z, o.w); o8[64 * j] = w;
#pragma unroll
            for (int cc = 0; cc < 4; ++cc) { const f32x4 w0 = *(const LAS f32x4*)(wr + (d + cc) * NE), w1 = *(const LAS f32x4*)(wr + (d + cc) * NE + 4); const float ov = o[cc];
                lg[0] += ov * w0.x; lg[1] += ov * w0.y; lg[2] += ov * w0.z; lg[3] += ov * w0.w; lg[4] += ov * w1.x; lg[5] += ov * w1.y; lg[6] += ov * w1.z; lg[7] += ov * w1.w; } }
#pragma unroll
        for (int e = 0; e < NE; ++e) lg[e] = wave_sum(lg[e]);
        if (lane == 0) {
            int e0 = 0; float v0 = lg[0];
#pragma unroll
            for (int e = 1; e < NE; ++e) if (lg[e] > v0) { v0 = lg[e]; e0 = e; }
            int e1 = e0 == 0 ? 1 : 0; float v1 = lg[e1];
#pragma unroll
            for (int e = 0; e < NE; ++e) if (e != e0 && lg[e] > v1) { v1 = lg[e]; e1 = e; }
            const float w1 = 1.0f / (1.0f + __expf(v0 - v1)), w0 = 1.0f - w1;
            const unsigned lp0 = __hip_atomic_fetch_add(lcnt + e0, 1u, __ATOMIC_RELAXED, __HIP_MEMORY_SCOPE_WORKGROUP), lp1 = __hip_atomic_fetch_add(lcnt + e1, 1u, __ATOMIC_RELAXED, __HIP_MEMORY_SCOPE_WORKGROUP);
            LAS int* rc = rec + k * 8; rc[0] = t; rc[1] = e0; rc[2] = e1; rc[3] = (int)lp0; rc[4] = (int)lp1; rc[5] = (int)__float_as_uint(w0); rc[6] = (int)__float_as_uint(w1);
        }
    }
    __syncthreads();
    unsigned* ctl = (unsigned*)(p.ws + WS_CTL);
    if (tid < NE) lbase[tid] = __hip_atomic_fetch_add(ctl + CW_CNT + tid, lcnt[tid], __ATOMIC_RELAXED, __HIP_MEMORY_SCOPE_AGENT);
    __syncthreads();
    unsigned* misc = (unsigned*)(p.ws + WS_MISC);
    if (lane < k) { const LAS int* rc = rec + lane * 8; const int t = rc[0], e0 = rc[1], e1 = rc[2];
        misc[MI_TOK_E + 2 * t] = (unsigned)e0; misc[MI_TOK_E + 2 * t + 1] = (unsigned)e1;
        misc[MI_TOK_POS + 2 * t] = lbase[e0] + (unsigned)rc[3]; misc[MI_TOK_POS + 2 * t + 1] = lbase[e1] + (unsigned)rc[4];
        misc[MI_TOK_W + 2 * t] = (unsigned)rc[5]; misc[MI_TOK_W + 2 * t + 1] = (unsigned)rc[6]; }
}
__device__ __forceinline__ void moe_scan_gather(const Params& p, LAS unsigned char* lds, int tid, int lane, int wave) {
    LAS unsigned* sseg = (LAS unsigned*)lds;
    unsigned* ctl = (unsigned*)(p.ws + WS_CTL); unsigned* misc = (unsigned*)(p.ws + WS_MISC);
    if (tid == 0) { unsigned a = 0u;
        for (int e = 0; e < NE; ++e) { const unsigned c = __hip_atomic_load(ctl + CW_CNT + e, __ATOMIC_RELAXED, __HIP_MEMORY_SCOPE_AGENT); sseg[e] = a; sseg[16 + e] = c; a += (c + 255u) & ~255u; }
        sseg[8] = a; }
    __syncthreads();
    const unsigned ntile = sseg[8] >> 8;
    if (blockIdx.x == 0) {
        if (tid < MOE_MAXT) { unsigned e = 0u; for (int q = 1; q < NE; ++q) if (sseg[q] <= 256u * (unsigned)tid) e = (unsigned)q; misc[MI_TILE_E + tid] = e; }
        if (tid == 0) misc[MI_TILE_E + 500] = ntile;
    }
    const bf16_t* h = (const bf16_t*)(p.ws + WS_H); bf16_t* hs = (bf16_t*)(p.ws + WS_HS);
    const int gw = blockIdx.x * NWAVES + wave, NGW = gridDim.x * NWAVES;
    const int nk = (T - gw + NGW - 1) / NGW;
    unsigned mr0 = 0u, mr1 = 0u;
    if (lane < nk) { const int t = gw + lane * NGW;
        const v2u ee = *(const GAS v2u*)(misc + MI_TOK_E + 2 * t), pp = *(const GAS v2u*)(misc + MI_TOK_POS + 2 * t), ww = *(const GAS v2u*)(misc + MI_TOK_W + 2 * t);
        mr0 = sseg[ee.x] + pp.x; mr1 = sseg[ee.y] + pp.y;
        misc[MI_ROW_W + mr0] = ww.x; misc[MI_ROW_W + mr1] = ww.y;
        v2u rr; rr.x = mr0; rr.y = mr1; *(GAS v2u*)(misc + MI_TOK_POS + 2 * t) = rr; }
    for (int k0 = 0; k0 < nk; k0 += 8) {
        v4u a[8], c[8];
#pragma unroll
        for (int i = 0; i < 8; ++i) { const int k = k0 + i < nk ? k0 + i : nk - 1; const int t = gw + k * NGW;
            a[i] = *(const GAS v4u*)(h + (size_t)t * D + lane * 8); c[i] = *(const GAS v4u*)(h + (size_t)t * D + 512 + lane * 8); }
#pragma unroll
        for (int i = 0; i < 8; ++i) { if (k0 + i < nk) { const unsigned r0 = (unsigned)__shfl((int)mr0, k0 + i), r1 = (unsigned)__shfl((int)mr1, k0 + i);
            *(GAS v4u*)(hs + (size_t)r0 * D + lane * 8) = a[i]; *(GAS v4u*)(hs + (size_t)r0 * D + 512 + lane * 8) = c[i];
            *(GAS v4u*)(hs + (size_t)r1 * D + lane * 8) = a[i]; *(GAS v4u*)(hs + (size_t)r1 * D + 512 + lane * 8) = c[i]; } }
    }
    if (blockIdx.x < NE) {
        const unsigned e = blockIdx.x, p0 = sseg[e] + sseg[16 + e], p1 = sseg[e + 1];
        for (unsigned r = p0 + (unsigned)wave; r < p1; r += NWAVES) { const v4u z = {0u, 0u, 0u, 0u};
            *(GAS v4u*)(hs + (size_t)r * D + lane * 8) = z; *(GAS v4u*)(hs + (size_t)r * D + 512 + lane * 8) = z; if (lane == 0) misc[MI_ROW_W + r] = 0u; }
    }
}
struct GroupedOrder {
    const unsigned* tile_e; int t0, t1, nN, G, c, a_pm_off; size_t bstride;
    __device__ __forceinline__ bool next(int i, pg8::Unit& u) const {
        const long L = (long)i * G + c; if (L >= (long)(t1 - t0) * nN) return false;
        u.pm = t0 + (int)(L / nN); u.pn = (int)(L % nN); u.e = __builtin_amdgcn_readfirstlane((int)tile_e[u.pm]); u.aux = 0; return true;
    }
    __device__ __forceinline__ const char* a_ptr(const pg8::Gemm& g, const pg8::Unit& u) const { return (const char*)g.A + (size_t)(u.pm - a_pm_off) * (size_t)(pg8::BM * 2) * g.lda; }
    __device__ __forceinline__ const char* b_ptr(const pg8::Gemm& g, const pg8::Unit& u) const { return (const char*)g.Bt + ((size_t)u.e * bstride + (size_t)u.pn * pg8::BM * g.K) * 2; }
    __device__ __forceinline__ int kt(const pg8::Gemm& g, const pg8::Unit&) const { return g.K / pg8::BK; }
    __device__ __forceinline__ bool last_seg(const pg8::Unit&) const { return true; }
    __device__ __forceinline__ void a_ready(const pg8::Unit&) const {}
    __device__ __forceinline__ void done(const pg8::Unit&) const {}
};
__device__ __forceinline__ void moe_combine_final(const Params& p, const float* g2, int lane, int wave) {
    const unsigned* misc = (const unsigned*)(p.ws + WS_MISC); const bf16_t* y = (const bf16_t*)(p.ws + WS_HS);
    const int gw = blockIdx.x * NWAVES + wave, NGW = gridDim.x * NWAVES;
    const int nk = (T - gw + NGW - 1) / NGW;
    unsigned mr0 = 0u, mr1 = 0u;
    if (lane < nk) { const v2u rr = *(const GAS v2u*)(misc + MI_TOK_POS + 2 * (gw + lane * NGW)); mr0 = rr.x; mr1 = rr.y; }
    f32x4 xv[4]; v2u ya[4], yc[4];
#define CMB_LOAD(k_) do { const int t_ = gw + (k_) * NGW; const unsigned r0_ = (unsigned)__shfl((int)mr0, (k_)), r1_ = (unsigned)__shfl((int)mr1, (k_)); \
        _Pragma("unroll") for (int j = 0; j < 4; ++j) { const int d = 4 * lane + 256 * j; xv[j] = *(const GAS f32x4*)(p.out + (size_t)t_ * D + d); \
            ya[j] = *(const GAS v2u*)(y + (size_t)r0_ * D + d); yc[j] = *(const GAS v2u*)(y + (size_t)r1_ * D + d); } } while (0)
    if (nk > 0) CMB_LOAD(0);
    for (int k = 0; k < nk; ++k) {
        const int t = gw + k * NGW, b = t >> 11;
        GAS f32x4* xr = (GAS f32x4*)(p.out + (size_t)t * D) + lane;
        f32x4 v[4]; float s = 0.f;
#pragma unroll
        for (int j = 0; j < 4; ++j) { const int d = 4 * lane + 256 * j; const v2u a = ya[j], c = yc[j];
            f32x4 fa, fc; fa.x = __uint_as_float(a.x << 16); fa.y = __uint_as_float(a.x & 0xffff0000u); fa.z = __uint_as_float(a.y << 16); fa.w = __uint_as_float(a.y & 0xffff0000u);
            fc.x = __uint_as_float(c.x << 16); fc.y = __uint_as_float(c.x & 0xffff0000u); fc.z = __uint_as_float(c.y << 16); fc.w = __uint_as_float(c.y & 0xffff0000u);
            const f32x4 g4 = *(const f32x4*)(g2 + (size_t)b * 6 * D + d);
            v[j] = xv[j] + g4 * (fa + fc); s += (v[j].x * v[j].x + v[j].y * v[j].y) + (v[j].z * v[j].z + v[j].w * v[j].w); }
        if (k + 1 < nk) CMB_LOAD(k + 1);
        const float r = 1.0f / sqrtf(wave_sum(s) * (1.0f / D) + EPS);
#pragma unroll
        for (int j = 0; j < 4; ++j) { const f32x4 f4 = *(const f32x4*)(p.in[25] + 4 * lane + 256 * j); xr[64 * j] = v[j] * r * f4; }
    }
#undef CMB_LOAD
}

#ifdef PROBE_CATS
#ifndef PROBE_MULT
#define PROBE_MULT 4
#endif
struct Probe { int unused; };
__device__ __forceinline__ int step_cat(int id) {
    if (id == 0) return 0;
    const int l = (id - 1) / LSTEPS, o = (id - 1) % LSTEPS;
    if (o == 0) return 1; if (o <= 10) return 2 + (o - 1) % 5; if (o == 11) return l == 0 ? 7 : 10;
    if (l == 0) return o == 12 ? 8 : 9;
    if (o == 12) return 11; if (o == 21) return 14; return (o & 1) ? 12 : 13;
}
__device__ __forceinline__ bool probe_tick_lds(LAS unsigned char* lds, int id) {
    int t_ = threadIdx.x; asm volatile("" : "+v"(t_));
    if (blockIdx.x == 0 && t_ == 0) {
        volatile LAS unsigned long long* q = (volatile LAS unsigned long long*)(lds + LDSCTL_OFF + 64);
        const unsigned long long now = __builtin_amdgcn_s_memrealtime();
        if (q[2]) q[1] += now - q[0];
        q[0] = now; q[2] = ((id >= 0) && ((PROBE_CATS >> step_cat(id)) & 1)) ? 1ull : 0ull;
    }
    return true;
}
#define probe_tick(pr, id) probe_tick_lds(lds, (id))
#else
struct Probe { int unused; };
__device__ __forceinline__ bool probe_tick(Probe&, int) { return true; }
#endif
#define STEP(id) if (p0.lo <= (id) && (id) < p0.hi && (first ? (first = false, true) : (xcd_barrier(bar), true)) && probe_tick(pr, (id)))
#define STEP_S(id) if (p0.lo <= (id) && (id) < p0.hi && (first ? (first = false, true) : (xcd_barrier_steal(bar, lds), true)) && probe_tick(pr, (id)))
#define IDS const Params p = load_params(); int tid = threadIdx.x; asm volatile("" : "+v"(tid)); const int lane = tid & 63, wave = __builtin_amdgcn_readfirstlane(tid >> 6); (void)lane; (void)wave; const int G = gridDim.x, NGW = G * NWAVES; (void)NGW; unsigned char* ws = p.ws; const float* mod_ = (const float*)(ws + WS_MOD); (void)mod_;
template <int L, int c> __device__ __forceinline__ void chunk_steps(const Params& p0, LAS unsigned char* lds, const XcdBarrier& bar, bool& first, Probe& pr) {
    constexpr int sb = ST_L0 + L * LSTEPS;
        constexpr int cs = sb + SO_CHUNK + CSTEPS * c;
#define CHP bf16_t* hc = (bf16_t*)(ws + WS_H) + (size_t)c * CH_T * D; bf16_t* proj = (bf16_t*)(ws + WS_PROJ); (void)hc; (void)proj;
        STEP(cs + 0) { IDS CHP
            if (blockIdx.x < CH_B * 6 && wave == 0) negf_cumsum(p, c * CH_B + (int)blockIdx.x / 6, (int)blockIdx.x % 6, lane);
            if constexpr (c == 1) {
                pg8::Gemm g{(const bf16_t*)(ws + WS_H), (const bf16_t*)(ws + WS_WOUT) + (size_t)L * D * D, CH_T, D, D, D, D}; pg8::StaticOrder S; S.init(CH_T, D, G, (int)blockIdx.x);
                pg8::EpiResid E{L == 0 ? p.in[0] : p.out, p.out, (mod_ + (size_t)L * NB * 6 * D) + 2 * D, 0};
                pg8::gemm_phase<pg8::EpiResid, pg8::StaticOrder, true, true>(lds, g, S, E);
            }
            pg8::Gemm g{hc, (const bf16_t*)(ws + WS_WIN) + (size_t)L * NP * D, CH_T, NP, D, D, D}; pg8::StaticOrder S; S.init(CH_T, NP, G, (int)blockIdx.x);
            pg8::EpiInProj E{(bf16_t*)(ws + WS_QO), (bf16_t*)(ws + WS_KV), (bf16_t*)(ws + WS_GATE)};
            pg8::gemm_phase<pg8::EpiInProj, pg8::StaticOrder, true, true>(lds, g, S, E);
        }
        STEP(cs + 1) { IDS attn_b_phase(p, lds, tid, lane, wave); }
        STEP_S(cs + 2) { IDS attn_ac_phase(p, L, c, lds, tid, lane, wave); }
        STEP_S(cs + 3) { IDS CHP
            const bf16_t* wbr = (const bf16_t*)(ws + WS_WBR) + (size_t)L * 1280 * D;
            pg8::SegOrder S; S.init(CH_T, D, G, (int)blockIdx.x);
            pg8::Gemm g{(const bf16_t*)(ws + WS_QO), wbr, CH_T, D, 1280, 2048, 1280}; pg8::EpiMergeS E{(const bf16_t*)(ws + WS_GATE), hc, 3072};
            pg8::gemm_phase<pg8::EpiMergeS, pg8::SegOrder, true, true>(lds, g, S, E);
        }
        if constexpr (c == 1) STEP(cs + 4) { IDS CHP
            pg8::Gemm g{hc, (const bf16_t*)(ws + WS_WOUT) + (size_t)L * D * D, CH_T, D, D, D, D}; pg8::StaticOrder S; S.init(CH_T, D, G, (int)blockIdx.x);
            pg8::EpiResid E{L == 0 ? p.in[0] : p.out, p.out, (mod_ + (size_t)L * NB * 6 * D) + 2 * D, c * CH_T};
            pg8::gemm_phase<pg8::EpiResid, pg8::StaticOrder, true, true>(lds, g, S, E);
        }
    }
template <int L> __device__ __forceinline__ void layer_steps(const Params& p0, LAS unsigned char* lds, const XcdBarrier& bar, bool& first, Probe& pr) {
    constexpr int sb = ST_L0 + L * LSTEPS;
    STEP(sb + SO_NORM1) { IDS norm_logf(p, L, L == 0 ? p.in[0] : p.out, p.in[2] + L * D, (mod_ + (size_t)L * NB * 6 * D) + D, (mod_ + (size_t)L * NB * 6 * D), (bf16_t*)(ws + WS_H), lds, tid, lane, wave); }
    chunk_steps<L, 0>(p0, lds, bar, first, pr);
    chunk_steps<L, 1>(p0, lds, bar, first, pr);
    STEP(sb + SO_NORM2) { IDS
        if constexpr (L == 0) norm_rows(p.out, p.in[3] + L * D, (mod_ + (size_t)L * NB * 6 * D) + 4 * D, (mod_ + (size_t)L * NB * 6 * D) + 3 * D, (bf16_t*)(ws + WS_H), 0, T, (int)blockIdx.x * NWAVES + wave, NGW, lane);
        else norm_route(p, p.in[3] + L * D, (mod_ + (size_t)L * NB * 6 * D) + 4 * D, (mod_ + (size_t)L * NB * 6 * D) + 3 * D, (bf16_t*)(ws + WS_H), lds, tid, lane, wave);
    }
    if constexpr (L == 0) {
        STEP(sb + SO_FFN) { IDS
            pg8::Gemm g{(const bf16_t*)(ws + WS_H), (const bf16_t*)(ws + WS_WGU0), T, 2 * DFF, D, D, D}; pg8::StaticOrder S; S.init(T, 2 * DFF, G, (int)blockIdx.x);
            pg8::EpiSwiglu E{(bf16_t*)(ws + WS_PROJ), DFF, 0};
            pg8::gemm_phase<pg8::EpiSwiglu, pg8::StaticOrder, true, true>(lds, g, S, E);
        }
        STEP(sb + SO_FFN + 1) { IDS
            pg8::Gemm g{(const bf16_t*)(ws + WS_PROJ), (const bf16_t*)(ws + WS_WD0), T, D, DFF, DFF, DFF}; pg8::StaticOrder S; S.init(T, D, G, (int)blockIdx.x);
            pg8::EpiResid E{p.out, p.out, (mod_ + (size_t)L * NB * 6 * D) + 5 * D, 0};
            pg8::gemm_phase<pg8::EpiResid, pg8::StaticOrder, true, true>(lds, g, S, E);
        }
    } else {
        STEP(sb + SO_FFN) { IDS moe_scan_gather(p, lds, tid, lane, wave); __syncthreads(); expert_mopup(p, lds, lane, wave); }
#pragma unroll 1
        for (int ch = 0; ch < 4; ++ch) {
            STEP(sb + SO_FFN + 1 + 2 * ch) { IDS const unsigned* misc = (const unsigned*)(ws + WS_MISC);
                const int ntile = (int)misc[MI_TILE_E + 500], t0 = ch * MOE_CH, t1 = ch == 3 ? ntile : (ch + 1) * MOE_CH;
                pg8::Gemm g{(const bf16_t*)(ws + WS_HS), (const bf16_t*)(ws + WS_WGU1), MOE_ROWS, 2 * DFE, D, D, D};
                GroupedOrder S{misc + MI_TILE_E, t0, t1, 2 * DFE / 256, G, (int)blockIdx.x, 0, (size_t)2 * DFE * D};
                pg8::EpiSwiglu E{(bf16_t*)(ws + WS_ACT1), DFE, t0};
                pg8::gemm_phase<pg8::EpiSwiglu, GroupedOrder, true, true>(lds, g, S, E);
            }
            STEP(sb + SO_FFN + 2 + 2 * ch) { IDS const unsigned* misc = (const unsigned*)(ws + WS_MISC);
                const int ntile = (int)misc[MI_TILE_E + 500], t0 = ch * MOE_CH, t1 = ch == 3 ? ntile : (ch + 1) * MOE_CH;
                pg8::Gemm g{(const bf16_t*)(ws + WS_ACT1), (const bf16_t*)(ws + WS_WD1), MOE_ROWS, D, DFE, DFE, DFE};
                GroupedOrder S{misc + MI_TILE_E, t0, t1, D / 256, G, (int)blockIdx.x, t0, (size_t)D * DFE};
                pg8::EpiMoeDown E{(bf16_t*)(ws + WS_HS), (const float*)(misc + MI_ROW_W)};
                pg8::gemm_phase<pg8::EpiMoeDown, GroupedOrder, true, true>(lds, g, S, E);
            }
        }
        STEP(sb + SO_FFN + 9) { IDS moe_combine_final(p, (mod_ + (size_t)L * NB * 6 * D) + 5 * D, lane, wave); }
    }
}

__global__ void __launch_bounds__(NTHR, 2) mk_fwd(Params p0) {
    extern __shared__ __attribute__((aligned(16))) unsigned char lds_raw[];
    LAS unsigned char* lds = (LAS unsigned char*)lds_raw;
    for (int u = threadIdx.x; u < (LDS_BYTES - LDSCTL_OFF) / 4; u += NTHR) ((LAS unsigned*)(lds + LDSCTL_OFF))[u] = 0u;
    __syncthreads();
    const XcdBarrier bar = xcd_barrier_post((unsigned*)(p0.ws + WS_CTL) + CW_BAR + p0.li * XCD_BAR_WORDS, (volatile LAS unsigned*)(lds + MISC_OFF) + 8);
    bool first = true; Probe pr{};
    STEP(ST_PRO) { IDS prologue(p, lds, tid, lane, wave); }
    layer_steps<0>(p0, lds, bar, first, pr);
    layer_steps<1>(p0, lds, bar, first, pr);
#ifdef PROBE_CATS
    probe_tick(pr, -1);
    int t_ = threadIdx.x; asm volatile("" : "+v"(t_));
    if (blockIdx.x == 0 && t_ == 0) { const unsigned long long t1 = __builtin_amdgcn_s_memrealtime(), want = ((volatile LAS unsigned long long*)(lds + LDSCTL_OFF + 64))[1] * PROBE_MULT; while (__builtin_amdgcn_s_memrealtime() - t1 < want) __builtin_amdgcn_s_sleep(32); }
#endif
}
#undef STEP
#undef STEP_S
}

extern "C" void kernel_launch(void* const* d_in, const int* in_sizes, int n_in, void* d_out, int out_size, void* d_ws, size_t ws_size, hipStream_t stream) {
    static int grid = 0;
    if (grid == 0) {
        int dev = 0, cus = 0;
        (void)hipGetDevice(&dev); (void)hipDeviceGetAttribute(&cus, hipDeviceAttributeMultiprocessorCount, dev);
        if (hipFuncSetAttribute((const void*)mk::mk_fwd, hipFuncAttributeMaxDynamicSharedMemorySize, mk::LDS_BYTES) != hipSuccess) fprintf(stderr, "kernel_launch: hipFuncSetAttribute failed\n");
        (void)hipGetLastError();
        grid = cus > 0 ? cus : 256;
        if (ws_size < mk::WS_END) fprintf(stderr, "kernel_launch: workspace too small: %zu < %zu\n", ws_size, (size_t)mk::WS_END);
    }
    (void)in_sizes; (void)n_in; (void)out_size;
    (void)hipMemsetAsync((char*)d_ws + mk::WS_CTL, 0, mk::CTL_ZERO, stream);
    mk::Params p{};
    for (int i = 0; i < 26; ++i) p.in[i] = (const float*)d_in[i];
    p.out = (float*)d_out; p.ws = (unsigned char*)d_ws; p.lo = 0; p.hi = mk::ST_END; p.li = 0; p.pad = 0;
    hipLaunchKernelGGL(mk::mk_fwd, dim3(grid), dim3(mk::NTHR), mk::LDS_BYTES, stream, p);
}
```

```cpp
#include <hip/hip_runtime.h>
#include <cstdint>
#include <cstdio>

namespace pg8 {
#define PG8_LAS __attribute__((address_space(3)))
typedef unsigned short bf16_t;
typedef short bf16x8 __attribute__((ext_vector_type(8)));
typedef float f32x4 __attribute__((ext_vector_type(4)));
typedef unsigned u32x4 __attribute__((ext_vector_type(4)));
constexpr int BM = 256, BK = 64, HALF = 128, HTB = HALF * BK * 2  , STAGE_BYTES = 8 * HTB, NXCD = 8, WGM = 8;

__host__ __device__ __forceinline__ int lds_byte(int r, int c) { const int st = (r >> 4) * 2 + (c >> 5), rr = r & 15, cc = c & 31, ob = rr * 64 + cc * 2; return st * 1024 + (ob ^ (((ob >> 9) & 1) << 5)); }
__host__ __device__ __forceinline__ void stage_rc(int b, int& R, int& C) { const int st = b / 1024, sb = b % 1024, swz = sb ^ (((sb >> 9) & 1) << 5); R = (st >> 1) * 16 + swz / 64; C = (st & 1) * 32 + (swz % 64) / 2; }
__host__ __device__ __forceinline__ int perm32(int rho) { const int n = rho >> 4, i = rho & 15; return 8 * (i >> 2) + 4 * n + (i & 3); }

struct Unit { int pm, pn, e, aux; };
struct Gemm { const bf16_t* A; const bf16_t* Bt; int M, N, K, lda, ldb; };

struct StaticOrder {
    int nM, nN, nwg, G, c;
    __host__ __device__ void init(int M, int N, int G_, int c_) { nM = M / BM; nN = N / BM; nwg = nM * nN; G = G_; c = c_; }
    __host__ __device__ bool next(int i, Unit& u) const {
        const long L = (long)i * G + c; if (L >= nwg) return false;
        int wgid = (int)L; { const int q = nwg / NXCD, r = nwg % NXCD, xcd = wgid % NXCD, off = wgid / NXCD; wgid = (xcd < r ? xcd * (q + 1) : r * (q + 1) + (xcd - r) * q) + off; }
        const int nig = WGM * nN, gid = wgid / nig, fm = gid * WGM, gsz = (nM - fm) < WGM ? (nM - fm) : WGM;
        u.pm = fm + ((wgid % nig) % gsz); u.pn = (wgid % nig) / gsz; u.e = 0; u.aux = 0; return true;
    }
    __device__ __forceinline__ const char* a_ptr(const Gemm& g, const Unit& u) const { return (const char*)g.A + (size_t)u.pm * (size_t)(BM * 2) * g.lda; }
    __device__ __forceinline__ const char* b_ptr(const Gemm& g, const Unit& u) const { return (const char*)g.Bt + (size_t)u.pn * (size_t)(BM * 2) * g.ldb; }
    __device__ __forceinline__ int kt(const Gemm& g, const Unit&) const { return g.K / BK; }
    __device__ __forceinline__ bool last_seg(const Unit&) const { return true; }
    __device__ __forceinline__ void a_ready(const Unit&) const {}
    __device__ __forceinline__ void done(const Unit&) const {}
};

__device__ __forceinline__ unsigned cvt_pk_bf16(float lo, float hi) { unsigned r; asm volatile("v_cvt_pk_bf16_f32 %0, %1, %2" : "=v"(r) : "v"(lo), "v"(hi)); return r; }
typedef float f32x2 __attribute__((ext_vector_type(2)));
__device__ __forceinline__ float silu_f(float z) { return z * __builtin_amdgcn_rcpf(1.0f + __builtin_amdgcn_exp2f(-1.4426950408889634f * z)); }
__device__ __forceinline__ float sigm_f(float z) { return __builtin_amdgcn_rcpf(1.0f + __builtin_amdgcn_exp2f(-1.4426950408889634f * z)); }
struct EpiSwiglu {
    static constexpr bool PERM = true, AFTER_DRAIN = false, SEGMENTED = false;
    bf16_t* O; int ldc; int pm_off;
    __device__ __forceinline__ void operator()(const f32x4 (&acc)[2][2][4][2], const Unit& u, int wr, int wc, int fr, int fq) const {
        const int row0 = (u.pm - pm_off) * BM + wr * 64 + fr, col0 = u.pn * HALF + wc * 32 + 8 * fq;
#pragma unroll
        for (int ai = 0; ai < 2; ++ai)
#pragma unroll
            for (int m = 0; m < 4; ++m) { bf16_t* rowp = O + (size_t)(row0 + ai * HALF + m * 16) * ldc + col0;
                const f32x4 g0 = acc[ai][0][m][0], g1 = acc[ai][0][m][1], u0 = acc[ai][1][m][0], u1 = acc[ai][1][m][1];
                u32x4 w; w.x = cvt_pk_bf16(silu_f(g0[0]) * u0[0], silu_f(g0[1]) * u0[1]); w.y = cvt_pk_bf16(silu_f(g0[2]) * u0[2], silu_f(g0[3]) * u0[3]);
                w.z = cvt_pk_bf16(silu_f(g1[0]) * u1[0], silu_f(g1[1]) * u1[1]); w.w = cvt_pk_bf16(silu_f(g1[2]) * u1[2], silu_f(g1[3]) * u1[3]);
                *(u32x4*)rowp = w; }
    }
};
struct EpiResid {
    static constexpr bool PERM = false, AFTER_DRAIN = false, SEGMENTED = false;
    const float* src; float* dst; const float* gv; int row_off;
    __device__ __forceinline__ void operator()(const f32x4 (&acc)[2][2][4][2], const Unit& u, int wr, int wc, int fr, int fq) const {
        const int rowt = row_off + u.pm * BM, row0 = rowt + wr * 64 + fr, col0 = u.pn * BM + wc * 32 + 4 * fq;
        const float* gp = gv + (size_t)(rowt >> 11) * 6144 + col0;
        f32x4 gg[2][2];
#pragma unroll
        for (int bj = 0; bj < 2; ++bj)
#pragma unroll
            for (int n = 0; n < 2; ++n) gg[bj][n] = *(const f32x4*)(gp + bj * HALF + n * 16);
#pragma unroll
        for (int ai = 0; ai < 2; ++ai) {
            f32x4 sv[4][2][2];
#pragma unroll
            for (int m = 0; m < 4; ++m) { const size_t off = (size_t)(row0 + ai * HALF + m * 16) * 1024 + col0;
#pragma unroll
                for (int bj = 0; bj < 2; ++bj)
#pragma unroll
                    for (int n = 0; n < 2; ++n) sv[m][bj][n] = *(const f32x4*)(src + off + bj * HALF + n * 16); }
            asm volatile("" ::: "memory");
#pragma unroll
            for (int m = 0; m < 4; ++m) { const size_t off = (size_t)(row0 + ai * HALF + m * 16) * 1024 + col0;
#pragma unroll
                for (int bj = 0; bj < 2; ++bj)
#pragma unroll
                    for (int n = 0; n < 2; ++n) *(f32x4*)(dst + off + bj * HALF + n * 16) = sv[m][bj][n] + gg[bj][n] * acc[ai][bj][m][n]; }
            asm volatile("" ::: "memory");
        }
    }
};
struct EpiMoeDown {
    static constexpr bool PERM = true, AFTER_DRAIN = false, SEGMENTED = false;
    bf16_t* O; const float* row_w;
    __device__ __forceinline__ void operator()(const f32x4 (&acc)[2][2][4][2], const Unit& u, int wr, int wc, int fr, int fq) const {
        const int row0 = u.pm * BM + wr * 64 + fr, col0 = u.pn * BM + wc * 32 + 8 * fq;
        float w[2][4];
#pragma unroll
        for (int ai = 0; ai < 2; ++ai)
#pragma unroll
            for (int m = 0; m < 4; ++m) w[ai][m] = row_w[row0 + ai * HALF + m * 16];
#pragma unroll
        for (int ai = 0; ai < 2; ++ai)
#pragma unroll
            for (int m = 0; m < 4; ++m) { bf16_t* rowp = O + (size_t)(row0 + ai * HALF + m * 16) * 1024 + col0; const float ww = w[ai][m];
#pragma unroll
                for (int bj = 0; bj < 2; ++bj) { const f32x4 v0 = acc[ai][bj][m][0] * ww, v1 = acc[ai][bj][m][1] * ww;
                    u32x4 o; o.x = cvt_pk_bf16(v0[0], v0[1]); o.y = cvt_pk_bf16(v0[2], v0[3]); o.z = cvt_pk_bf16(v1[0], v1[1]); o.w = cvt_pk_bf16(v1[2], v1[3]);
                    *(u32x4*)(rowp + bj * HALF) = o; } }
    }
};
struct EpiInProj {
    static constexpr bool PERM = true, AFTER_DRAIN = false, SEGMENTED = false;
    bf16_t* QO; bf16_t* KV; bf16_t* GT;
    __device__ __forceinline__ void operator()(const f32x4 (&acc)[2][2][4][2], const Unit& u, int wr, int wc, int fr, int fq) const {
        const int rowl0 = u.pm * BM + wr * 64 + fr, b = (u.pm * BM) >> 11;
        constexpr float C2 = 0.125f * 1.4426950408889634f;
        constexpr size_t KVB0 = (size_t)8 * 4 * 2 * 2048 * 128, KVC0 = KVB0 + (size_t)8 * 18 * 2 * 2048 * 64;
#pragma unroll
        for (int bj = 0; bj < 2; ++bj) {
            const int hh = 2 * u.pn + bj, c = 32 * wc + 8 * fq; float sc = 1.0f; int s = 0, pitch = 2048; bool sig = false, tokmajor = true; bf16_t* dst;
            if (hh < 4) { dst = QO + 128 * hh + c; sc = C2; }
            else if (hh < 12) { const int kv = hh >= 8, h = hh - (kv ? 8 : 4); dst = KV + (size_t)((b * 4 + h) * 2 + kv) * (2048 * 128) + c; pitch = 128; tokmajor = false; }
            else if (hh < 21) { const int g = (hh - 12) / 3, j = (hh - 12) % 3; dst = QO + 512 + g * 384 + j * 128 + c; s = 2 * g; sc = C2; }
            else if (hh < 39) { const int kv = hh >= 30, x = hh - (kv ? 30 : 21), g = x / 3, j = x % 3, hd = 2 * j + (c >> 6);
                dst = KV + KVB0 + (size_t)(((b * 3 + g) * 6 + hd) * 2 + kv) * (2048 * 64) + (c & 63); pitch = 64; s = 2 * g; tokmajor = false; }
            else if (hh < 42) { dst = QO + 1664 + (hh - 39) * 128 + c; sc = C2; }
            else if (hh < 48) { const int kv = hh >= 45, j = hh - (kv ? 45 : 42), hd = 2 * j + (c >> 6); dst = KV + KVC0 + (size_t)((b * 6 + hd) * 2 + kv) * (2048 * 64) + (c & 63); pitch = 64; tokmajor = false; }
            else { dst = GT + (hh - 48) * 128 + c; pitch = 3072; sig = true; }
#pragma unroll
            for (int ai = 0; ai < 2; ++ai)
#pragma unroll
                for (int m = 0; m < 4; ++m) { const int r = rowl0 + ai * HALF + m * 16, t = r & 2047, tp = ((t & ((1 << s) - 1)) << (11 - s)) | (t >> s), ro = (tokmajor ? (r & ~2047) : 0) | tp;
                    f32x4 v0 = acc[ai][bj][m][0], v1 = acc[ai][bj][m][1];
                    if (sig) { v0[0] = sigm_f(v0[0]); v0[1] = sigm_f(v0[1]); v0[2] = sigm_f(v0[2]); v0[3] = sigm_f(v0[3]); v1[0] = sigm_f(v1[0]); v1[1] = sigm_f(v1[1]); v1[2] = sigm_f(v1[2]); v1[3] = sigm_f(v1[3]); }
                    else { v0 = v0 * sc; v1 = v1 * sc; }
                    u32x4 w; w.x = cvt_pk_bf16(v0[0], v0[1]); w.y = cvt_pk_bf16(v0[2], v0[3]); w.z = cvt_pk_bf16(v1[0], v1[1]); w.w = cvt_pk_bf16(v1[2], v1[3]);
                    *(u32x4*)(dst + (size_t)ro * pitch) = w; }
        }
    }
};
__device__ __forceinline__ float bf_lo(unsigned u) { return __builtin_bit_cast(float, u << 16); }
__device__ __forceinline__ float bf_hi(unsigned u) { return __builtin_bit_cast(float, u & 0xffff0000u); }
template <int BR> struct EpiMerge {
    static constexpr bool PERM = true, AFTER_DRAIN = false, SEGMENTED = false;
    const bf16_t* proj; bf16_t* mg; int ldp;
    __device__ __forceinline__ void operator()(const f32x4 (&acc)[2][2][4][2], const Unit& u, int wr, int wc, int fr, int fq) const {
        const int row0 = u.pm * BM + wr * 64 + fr, col0 = u.pn * BM + wc * 32 + 8 * fq;
#pragma unroll
        for (int ai = 0; ai < 2; ++ai)
#pragma unroll
        for (int mp = 0; mp < 4; ++mp) {
            u32x4 gt[1][2], od[1][2];
#pragma unroll
            for (int mm = 0; mm < 1; ++mm)
#pragma unroll
                for (int bj = 0; bj < 2; ++bj) { const size_t r = (size_t)(row0 + ai * HALF + (mp + mm) * 16);
                    gt[mm][bj] = *(const u32x4*)(proj + r * ldp + 6144 + 1024 * BR + col0 + bj * HALF);
                    if (BR) od[mm][bj] = *(const u32x4*)(mg + r * 1024 + col0 + bj * HALF); else od[mm][bj] = (u32x4){0u, 0u, 0u, 0u}; }
            asm volatile("" ::: "memory");
#pragma unroll
            for (int mm = 0; mm < 1; ++mm)
#pragma unroll
                for (int bj = 0; bj < 2; ++bj) { const int m = mp + mm; const size_t r = (size_t)(row0 + ai * HALF + m * 16); const u32x4 g = gt[mm][bj], o = od[mm][bj]; const f32x4 v0 = acc[ai][bj][m][0], v1 = acc[ai][bj][m][1];
                    u32x4 w; w.x = cvt_pk_bf16(bf_lo(o.x) + bf_lo(g.x) * v0[0], bf_hi(o.x) + bf_hi(g.x) * v0[1]); w.y = cvt_pk_bf16(bf_lo(o.y) + bf_lo(g.y) * v0[2], bf_hi(o.y) + bf_hi(g.y) * v0[3]);
                    w.z = cvt_pk_bf16(bf_lo(o.z) + bf_lo(g.z) * v1[0], bf_hi(o.z) + bf_hi(g.z) * v1[1]); w.w = cvt_pk_bf16(bf_lo(o.w) + bf_lo(g.w) * v1[2], bf_hi(o.w) + bf_hi(g.w) * v1[3]);
                    *(u32x4*)(mg + r * 1024 + col0 + bj * HALF) = w; }
            asm volatile("" ::: "memory");
        }
    }
};
struct EpiMergeS {
    static constexpr bool PERM = true, AFTER_DRAIN = false, SEGMENTED = false;
    const bf16_t* proj; bf16_t* mg; int ldp;
    __device__ __forceinline__ void operator()(const f32x4 (&acc)[2][2][4][2], const Unit& u, int wr, int wc, int fr, int fq) const {
        const int row0 = u.pm * BM + wr * 64 + fr, col0 = u.pn * BM + wc * 32 + 8 * fq; const int s = u.e;
#pragma unroll
        for (int ai = 0; ai < 2; ++ai) {
            u32x4 gt[4][2], od[4][2];
#pragma unroll
            for (int m = 0; m < 4; ++m)
#pragma unroll
                for (int bj = 0; bj < 2; ++bj) { const size_t r = (size_t)(row0 + ai * HALF + m * 16);
                    gt[m][bj] = *(const u32x4*)(proj + r * ldp + 1024 * s + col0 + bj * HALF);     od[m][bj] = *(const u32x4*)(mg + r * 1024 + col0 + bj * HALF); }
            asm volatile("" ::: "memory");
#pragma unroll
            for (int m = 0; m < 4; ++m)
#pragma unroll
                for (int bj = 0; bj < 2; ++bj) { const size_t r = (size_t)(row0 + ai * HALF + m * 16); const u32x4 g = gt[m][bj]; u32x4 o = od[m][bj]; if (s == 0) o = (u32x4){0u, 0u, 0u, 0u};
                    const f32x4 v0 = acc[ai][bj][m][0], v1 = acc[ai][bj][m][1];
                    u32x4 w; w.x = cvt_pk_bf16(bf_lo(o.x) + bf_lo(g.x) * v0[0], bf_hi(o.x) + bf_hi(g.x) * v0[1]); w.y = cvt_pk_bf16(bf_lo(o.y) + bf_lo(g.y) * v0[2], bf_hi(o.y) + bf_hi(g.y) * v0[3]);
                    w.z = cvt_pk_bf16(bf_lo(o.z) + bf_lo(g.z) * v1[0], bf_hi(o.z) + bf_hi(g.z) * v1[1]); w.w = cvt_pk_bf16(bf_lo(o.w) + bf_lo(g.w) * v1[2], bf_hi(o.w) + bf_hi(g.w) * v1[3]);
                    *(u32x4*)(mg + r * 1024 + col0 + bj * HALF) = w; }
            asm volatile("" ::: "memory");
        }
    }
};
struct SegOrder : StaticOrder {
    __device__ __forceinline__ bool next(int i, Unit& u) const { const int ti = i / 3, sg = i - 3 * ti; if (!StaticOrder::next(ti, u)) return false; u.e = sg; return true; }
    __device__ __forceinline__ const char* a_ptr(const Gemm& g, const Unit& u) const { return (const char*)g.A + (size_t)u.pm * (size_t)(BM * 2) * g.lda + (u.e == 0 ? 0 : (u.e == 1 ? 512 * 2 : 1664 * 2)); }
    __device__ __forceinline__ const char* b_ptr(const Gemm& g, const Unit& u) const { return (const char*)g.Bt + (size_t)u.pn * (size_t)(BM * 2) * g.ldb + (u.e == 0 ? 0 : (u.e == 1 ? 512 * 2 : 896 * 2)); }
    __device__ __forceinline__ int kt(const Gemm&, const Unit& u) const { return u.e == 0 ? 8 : 6; }
    __device__ __forceinline__ bool last_seg(const Unit& u) const { return u.e == 2; }
};
template <class Epi, class Sched, bool ALIGN_EPI = false, bool SP2 = false>
__device__ __forceinline__ void gemm_phase(PG8_LAS unsigned char* lds, const Gemm g, const Sched& S, const Epi& E) {
    int tid = threadIdx.x; asm volatile("" : "+v"(tid));
    const int wid = __builtin_amdgcn_readfirstlane(tid >> 6), lane = tid & 63, wr = wid >> 2, wc = wid & 3, fr = lane & 15, fq = lane >> 4;
    const int K = g.K;
    unsigned voffA[2], voffB[2];
#pragma unroll
    for (int i = 0; i < 2; ++i) { int R, C; stage_rc(tid * 16 + i * 8192, R, C); const int Rb = Epi::PERM ? ((R & ~31) + perm32(R & 31)) : R;
        voffA[i] = (unsigned)(R * g.lda + C) * 2u; voffB[i] = (unsigned)(Rb * g.ldb + C) * 2u; }
    const size_t kstep = (size_t)(BK * 2);
    const size_t hstepA = (size_t)HALF * g.lda * 2, hstepB = (size_t)HALF * g.ldb * 2;
    const unsigned ldsw = (unsigned)wid * 1024u;
    const int aoff = lds_byte(wr * 64 + fr, fq * 8), boff = lds_byte(wc * 32 + fr, fq * 8);
#define PG8_SA(b, h) (((b) * 2 + (h)) * HTB)
#define PG8_SB(b, h) ((4 + (b) * 2 + (h)) * HTB)
#define PG8_STAGE(bufoff, gbase, voff) do { _Pragma("unroll") for (int _i = 0; _i < 2; ++_i) \
        __builtin_amdgcn_global_load_lds((const unsigned*)((const char*)(gbase) + (voff)[_i]), (PG8_LAS unsigned*)(lds + (bufoff) + ldsw + _i * 8192), 16, 0, 0); } while (0)
#define PG8_LDA(dst, b, h) do { _Pragma("unroll") for (int m = 0; m < 4; ++m) _Pragma("unroll") for (int k = 0; k < 2; ++k) dst[m][k] = *(const PG8_LAS bf16x8*)(lds + PG8_SA(b, h) + aoff + m * 2048 + k * 1024); } while (0)
#define PG8_LDB(dst, b, h) do { _Pragma("unroll") for (int n = 0; n < 2; ++n) _Pragma("unroll") for (int k = 0; k < 2; ++k) dst[n][k] = *(const PG8_LAS bf16x8*)(lds + PG8_SB(b, h) + boff + n * 2048 + k * 1024); } while (0)
#define PG8_MMA(ai, bj, At, Bt) do { __builtin_amdgcn_s_setprio(1); _Pragma("unroll") for (int m = 0; m < 4; ++m) _Pragma("unroll") for (int n = 0; n < 2; ++n) _Pragma("unroll") for (int k = 0; k < 2; ++k) \
        acc[ai][bj][m][n] = __builtin_amdgcn_mfma_f32_16x16x32_bf16(Bt[n][k], At[m][k], acc[ai][bj][m][n], 0, 0, 0); __builtin_amdgcn_s_setprio(0); } while (0)
#define PG8_WAIT_V(n) asm volatile("s_waitcnt vmcnt(" #n ")" ::: "memory")
#define PG8_WAIT_L(n) asm volatile("s_waitcnt lgkmcnt(" #n ")" ::: "memory")
#define PG8_BAR __builtin_amdgcn_s_barrier()
#define PG8_SCHED __builtin_amdgcn_sched_barrier(0)
    Unit cur, nxt; int ui = 0;
    if (!S.next(0, cur)) return;
    int nt = S.kt(g, cur);
    f32x4 acc[2][2][4][2];
#pragma unroll
    for (int a = 0; a < 2; ++a)
#pragma unroll
        for (int b = 0; b < 2; ++b)
#pragma unroll
            for (int m = 0; m < 4; ++m)
#pragma unroll
                for (int n = 0; n < 2; ++n) acc[a][b][m][n] = (f32x4){0.f, 0.f, 0.f, 0.f};
    bf16x8 At[4][2], B0[2][2], B1[2][2];
    const char* cA = S.a_ptr(g, cur); const char* cB = S.b_ptr(g, cur);
    S.a_ready(cur);
    if constexpr (SP2) {
        PG8_STAGE(PG8_SB(0, 0), cB, voffB); PG8_STAGE(PG8_SB(0, 1), cB + hstepB, voffB); PG8_STAGE(PG8_SA(0, 0), cA, voffA); PG8_STAGE(PG8_SA(0, 1), cA + hstepA, voffA);
        if (wr == 1) PG8_BAR;
        PG8_WAIT_V(2); PG8_BAR;
        PG8_STAGE(PG8_SB(1, 0), cB + kstep, voffB); PG8_STAGE(PG8_SA(1, 0), cA + kstep, voffA); PG8_STAGE(PG8_SB(1, 1), cB + hstepB + kstep, voffB);
        PG8_WAIT_V(6); PG8_BAR;
    } else {
        PG8_STAGE(PG8_SB(0, 0), cB, voffB); PG8_STAGE(PG8_SA(0, 0), cA, voffA); PG8_STAGE(PG8_SB(0, 1), cB + hstepB, voffB); PG8_STAGE(PG8_SA(0, 1), cA + hstepA, voffA);
        if (wr == 1) PG8_BAR;
        PG8_WAIT_V(4); PG8_BAR;
        PG8_STAGE(PG8_SB(1, 0), cB + kstep, voffB); PG8_STAGE(PG8_SA(1, 0), cA + kstep, voffA); PG8_STAGE(PG8_SB(1, 1), cB + hstepB + kstep, voffB);
        PG8_WAIT_V(6); PG8_BAR;
    }
    for (;;) {
        const bool has_next = S.next(ui + 1, nxt);
        const char* nA = has_next ? S.a_ptr(g, nxt) : cA; const char* nB = has_next ? S.b_ptr(g, nxt) : cB;
        for (int t = 0; t < nt; t += 2) {
            const bool last = (t == nt - 2);
            const char* a1 = cA + (size_t)(t + 1) * kstep;
            const char* a2 = last ? nA : cA + (size_t)(t + 2) * kstep; const char* b2 = last ? nB : cB + (size_t)(t + 2) * kstep;
            const char* a3 = a2 + kstep; const char* b3 = b2 + kstep;
            if (last && has_next) S.a_ready(nxt);
            if constexpr (SP2) {
            PG8_LDB(B0, 0, 0); PG8_LDB(B1, 0, 1); PG8_SCHED; PG8_LDA(At, 0, 0); PG8_STAGE(PG8_SA(1, 1), a1 + hstepA, voffA);
            PG8_WAIT_V(8); PG8_WAIT_L(0); PG8_BAR; PG8_MMA(0, 0, At, B0); PG8_MMA(0, 1, At, B1); PG8_BAR; PG8_SCHED;
            PG8_LDA(At, 0, 1); PG8_STAGE(PG8_SB(0, 0), b2, voffB); PG8_STAGE(PG8_SB(0, 1), b2 + hstepB, voffB); PG8_STAGE(PG8_SA(0, 0), a2, voffA);
            PG8_WAIT_V(8); PG8_WAIT_L(0); PG8_BAR; PG8_MMA(1, 0, At, B0); PG8_MMA(1, 1, At, B1); PG8_BAR; PG8_SCHED;
            PG8_LDB(B0, 1, 0); PG8_LDB(B1, 1, 1); PG8_SCHED; PG8_LDA(At, 1, 0); PG8_STAGE(PG8_SA(0, 1), a2 + hstepA, voffA);
            PG8_WAIT_V(8); PG8_WAIT_L(0); PG8_BAR; PG8_MMA(0, 0, At, B0); PG8_MMA(0, 1, At, B1); PG8_BAR; PG8_SCHED;
            PG8_LDA(At, 1, 1); PG8_STAGE(PG8_SB(1, 0), b3, voffB); PG8_STAGE(PG8_SB(1, 1), b3 + hstepB, voffB); PG8_STAGE(PG8_SA(1, 0), a3, voffA);
            PG8_WAIT_V(8); PG8_WAIT_L(0); PG8_BAR; PG8_MMA(1, 0, At, B0); PG8_MMA(1, 1, At, B1); PG8_BAR; PG8_SCHED;
            } else {
            PG8_LDB(B0, 0, 0); PG8_SCHED; PG8_LDA(At, 0, 0); PG8_STAGE(PG8_SA(1, 1), a1 + hstepA, voffA);
            PG8_WAIT_L(8); PG8_BAR; PG8_WAIT_L(0); PG8_MMA(0, 0, At, B0); PG8_BAR; PG8_SCHED;
            PG8_LDB(B1, 0, 1); PG8_STAGE(PG8_SB(0, 0), b2, voffB);
            PG8_BAR; PG8_WAIT_L(0); PG8_MMA(0, 1, At, B1); PG8_BAR;
            PG8_LDA(At, 0, 1); PG8_STAGE(PG8_SA(0, 0), a2, voffA);
            PG8_BAR; PG8_WAIT_L(0); PG8_MMA(1, 0, At, B0); PG8_BAR; PG8_SCHED;
            PG8_STAGE(PG8_SB(0, 1), b2 + hstepB, voffB);
            PG8_WAIT_V(6); PG8_BAR; PG8_MMA(1, 1, At, B1); PG8_BAR;
            PG8_LDB(B0, 1, 0); PG8_SCHED; PG8_LDA(At, 1, 0); PG8_STAGE(PG8_SA(0, 1), a2 + hstepA, voffA);
            PG8_WAIT_L(8); PG8_BAR; PG8_WAIT_L(0); PG8_MMA(0, 0, At, B0); PG8_BAR; PG8_SCHED;
            PG8_LDB(B1, 1, 1); PG8_STAGE(PG8_SB(1, 0), b3, voffB);
            PG8_BAR; PG8_WAIT_L(0); PG8_MMA(0, 1, At, B1); PG8_BAR;
            PG8_LDA(At, 1, 1); PG8_STAGE(PG8_SA(1, 0), a3, voffA);
            PG8_BAR; PG8_WAIT_L(0); PG8_MMA(1, 0, At, B0); PG8_BAR; PG8_SCHED;
            PG8_STAGE(PG8_SB(1, 1), b3 + hstepB, voffB);
            PG8_WAIT_V(6); PG8_BAR; PG8_MMA(1, 1, At, B1); PG8_BAR;
            }
        }
        if constexpr (ALIGN_EPI) { if (wr == 0) PG8_BAR; }
        if constexpr (!Epi::AFTER_DRAIN) { E(acc, cur, wr, wc, fr, fq); S.done(cur); }
        if (!has_next) break;
#pragma unroll
        for (int a = 0; a < 2; ++a)
#pragma unroll
            for (int b = 0; b < 2; ++b)
#pragma unroll
                for (int m = 0; m < 4; ++m)
#pragma unroll
                    for (int n = 0; n < 2; ++n) acc[a][b][m][n] = (f32x4){0.f, 0.f, 0.f, 0.f};
        cur = nxt; cA = nA; cB = nB; ++ui; nt = S.kt(g, cur);
        if constexpr (ALIGN_EPI) { if (wr == 1) PG8_BAR; }
    }
    PG8_WAIT_V(0);
    if constexpr (!ALIGN_EPI) { if (wr == 0) PG8_BAR; }
    PG8_BAR;
    if constexpr (Epi::AFTER_DRAIN) { E.fused(acc, cur, wr, wc, fr, fq, lds, wid, lane); S.done(cur); }
#undef PG8_SA
#undef PG8_SB
#undef PG8_STAGE
#undef PG8_LDA
#undef PG8_LDB
#undef PG8_MMA
#undef PG8_WAIT_V
#undef PG8_WAIT_L
#undef PG8_BAR
#undef PG8_SCHED
}
}

#define LAS __attribute__((address_space(3)))
#define XB_TMO      128
#define XB_XCNT(j)  (256  + 64 * (j))
#define XB_XSUB(j)  (1280 + 64 * (j))
#define XB_XGEN(j)  (2304 + 64 * (j))
#define XB_TOP      3328
#define XB_TOPGEN   3392
#define XCD_BAR_WORDS 3456
#define XB_SPIN_CAP (1u << 18)

__device__ __forceinline__ unsigned xb_ld(unsigned* p)              { return __hip_atomic_load(p, __ATOMIC_RELAXED, __HIP_MEMORY_SCOPE_AGENT); }
__device__ __forceinline__ unsigned xb_add(unsigned* p, unsigned v) { return __hip_atomic_fetch_add(p, v, __ATOMIC_RELAXED, __HIP_MEMORY_SCOPE_AGENT); }
__device__ __forceinline__ unsigned xb_xcc_id() { return (unsigned)__builtin_amdgcn_s_getreg((3 << 11) | 20) & 0xFu; }
#define XB_SPIN(cond, bar) do { unsigned _sp = 0; while (cond) { __builtin_amdgcn_s_sleep(1); \
    if ((++_sp & 255u) == 0u) { if (xb_ld(&(bar)[XB_TMO])) break; if (_sp > XB_SPIN_CAP) { atomicAdd(&(bar)[XB_TMO], 1u); break; } } } } while (0)

struct XcdBarrier {
    unsigned* bar; unsigned x;
    volatile LAS unsigned* st;
};

__device__ __forceinline__ XcdBarrier xcd_barrier_post(unsigned* bar, volatile LAS unsigned* st) {
    XcdBarrier b; b.bar = bar; b.x = xb_xcc_id(); b.st = st;
    if (threadIdx.x == 0) (void)xb_add(&bar[XB_XCNT(b.x)], 1u);
    return b;
}
__device__ __forceinline__ void xcd_barrier_complete(unsigned* bar, unsigned x, unsigned& nloc, unsigned& nx) {
    const unsigned G = gridDim.x * gridDim.y * gridDim.z;
    unsigned sum, cnt, mine, sp = 0u;
    for (;;) {
        sum = 0u; cnt = 0u; mine = 0u;
#pragma unroll
        for (unsigned j = 0; j < 16; ++j) { const unsigned c = xb_ld(&bar[XB_XCNT(j)]); sum += c; cnt += (c > 0u) ? 1u : 0u; mine = (j == x) ? c : mine; }
        if (sum == G) break;
        __builtin_amdgcn_s_sleep(1);
        if ((++sp & 255u) == 0u) { if (xb_ld(&bar[XB_TMO])) break; if (sp > XB_SPIN_CAP) { atomicAdd(&bar[XB_TMO], 1u); break; } }
    }
    nloc = mine > 0u ? mine : 1u; nx = cnt > 0u ? cnt : 1u;
}

__device__ __forceinline__ void xcd_barrier(const XcdBarrier& b) {
    asm volatile("s_waitcnt vmcnt(0)" ::: "memory");
    __syncthreads();
    if (threadIdx.x == 0) {
        unsigned* bar = b.bar;
        __builtin_amdgcn_s_waitcnt(0);
        unsigned nloc = b.st[0], nx = b.st[1];
        if (nloc == 0u) { xcd_barrier_complete(bar, b.x, nloc, nx); b.st[0] = nloc; b.st[1] = nx; }
        const unsigned old = xb_add(&bar[XB_XSUB(b.x)], 1u);
        const unsigned gen = old / nloc;
        if (old + 1u == (gen + 1u) * nloc) {
            __builtin_amdgcn_fence(__ATOMIC_RELEASE, "agent");
            asm volatile("s_waitcnt vmcnt(0)" ::: "memory");
            const unsigned og = xb_add(&bar[XB_TOP], 1u);
            const unsigned tg = og / nx;
            if (og + 1u == (tg + 1u) * nx) xb_add(&bar[XB_TOPGEN], 1u);
            else XB_SPIN(xb_ld(&bar[XB_TOPGEN]) == tg, bar);
            __builtin_amdgcn_fence(__ATOMIC_ACQUIRE, "agent");
            xb_add(&bar[XB_XGEN(b.x)], 1u);
            asm volatile("s_waitcnt vmcnt(0)" ::: "memory");
        } else {
            XB_SPIN(xb_ld(&bar[XB_XGEN(b.x)]) == gen, bar);
            __builtin_amdgcn_fence(__ATOMIC_ACQUIRE, "agent");
            asm volatile("s_waitcnt vmcnt(0)" ::: "memory");
        }
    }
    __syncthreads();
}

namespace mk {
using pg8::bf16_t;
constexpr int NWAVES = 8, NTHR = 512;
constexpr int D = 1024, NB = 16, S = 2048, T = NB * S, NIN = 9222, NP = 9216;
constexpr int DFF = 2816, NE = 8, DFE = 3584;
constexpr float EPS = 1e-6f, LOG2E = 1.4426950408889634f;
constexpr int CH_B = 8, CH_T = CH_B * S;

constexpr size_t WS_CTL = 0, CTL_BYTES = 1u << 20, CTL_ZERO = 64u << 10;
constexpr size_t WS_MOD = WS_CTL + CTL_BYTES;
constexpr size_t WS_MISC = WS_MOD + (size_t)2 * NB * 6 * D * 4;
constexpr size_t WS_WIN = WS_MISC + (8u << 20);
constexpr size_t WS_WBR = WS_WIN + (size_t)2 * NP * D * 2;
constexpr size_t WS_WOUT = WS_WBR + (size_t)2 * 1280 * D * 2;
constexpr size_t WS_WGU0 = WS_WOUT + (size_t)2 * D * D * 2;
constexpr size_t WS_WD0 = WS_WGU0 + (size_t)2 * DFF * D * 2;
constexpr size_t WS_WGU1 = WS_WD0 + (size_t)D * DFF * 2;
constexpr size_t WS_WD1 = WS_WGU1 + (size_t)NE * 2 * DFE * D * 2;
constexpr size_t WS_H = WS_WD1 + (size_t)NE * D * DFE * 2;
constexpr size_t WS_PROJ = WS_H + (size_t)T * D * 2;
constexpr size_t WS_END = WS_PROJ + (size_t)CH_T * NP * 2;
constexpr size_t WS_QO = WS_PROJ;
constexpr size_t WS_KV = WS_QO + (size_t)CH_T * 2048 * 2;
constexpr size_t WS_GATE = WS_KV + (size_t)CH_T * 4096 * 2;
constexpr size_t KVB0 = (size_t)8 * 4 * 2 * 2048 * 128, KVC0 = KVB0 + (size_t)8 * 18 * 2 * 2048 * 64;
static_assert(WS_GATE + (size_t)CH_T * 3072 * 2 == WS_END, "projection buffers");
static_assert(WS_END <= 640000000ull, "d_ws map");
constexpr int MI_LAM = 0;
constexpr int MOE_MAXT = 264, MOE_ROWS = MOE_MAXT * 256;
constexpr int MI_TILE_E = 1024;
constexpr int MI_TOK_E = 4096;
constexpr int MI_TOK_POS = MI_TOK_E + 2 * T;
constexpr int MI_TOK_W = MI_TOK_POS + 2 * T;
constexpr int MI_ROW_W = MI_TOK_W + 2 * T;
constexpr int MI_LOGF = MI_ROW_W + MOE_ROWS;
constexpr int MI_NEGF = MI_LOGF + 8 * T;
constexpr int MI_LSE = MI_NEGF + NB * 6 * S;
constexpr int MI_LUTA = MI_LSE + 3 * CH_T * 8;
constexpr int MI_LUTB = MI_LUTA + 8 * 2240;
constexpr int MI_WF = MI_LUTB + 18 * 384;
constexpr int MI_END = MI_WF + 2 * 1024 * 8;
static_assert(MI_END * 4 <= (8 << 20), "MISC map");
constexpr size_t WS_HS = WS_PROJ;
constexpr size_t WS_ACT1 = WS_PROJ + (size_t)MOE_ROWS * D * 2;
constexpr int MOE_CH = 64;
static_assert(WS_ACT1 + (size_t)72 * 256 * DFE * 2 <= WS_END, "MoE buffers inside the PROJ region");
constexpr int CW_CNT = 64;
constexpr int CW_BAR = 4096;

constexpr int RING_BYTES = 131072, LDS_BYTES = 147456, LDSCTL_OFF = LDS_BYTES - 1024, MISC_OFF = LDSCTL_OFF + 320;

#define GAS __attribute__((address_space(1)))
typedef unsigned v4u __attribute__((ext_vector_type(4)));
typedef unsigned v2u __attribute__((ext_vector_type(2)));
typedef float f32x4 __attribute__((ext_vector_type(4)));
#define LDS_WAIT() asm volatile("s_waitcnt lgkmcnt(0)" ::: "memory")
__device__ __forceinline__ unsigned f2bf(float f) { unsigned u = __builtin_bit_cast(unsigned, f); return (u + 0x7fffu + ((u >> 16) & 1u)) >> 16; }
__device__ __forceinline__ unsigned pk2(float lo, float hi) { return f2bf(lo) | (f2bf(hi) << 16); }
__device__ __forceinline__ float wave_sum(float v) {
#pragma unroll
    for (int o = 1; o < 64; o <<= 1) v += __shfl_xor(v, o);
    return v;
}

struct Params { const float* in[26]; float* out; unsigned char* ws; int lo, hi, li, pad; };

typedef const __attribute__((address_space(4))) Params* CParams;
__device__ __forceinline__ Params load_params() {
#if defined(__HIP_DEVICE_COMPILE__)
    CParams pp = (CParams)__builtin_amdgcn_kernarg_segment_ptr(); asm volatile("" : "+s"(pp));
    Params q;
#pragma unroll
    for (int i = 0; i < 26; ++i) q.in[i] = pp->in[i];
    q.out = pp->out; q.ws = pp->ws; q.lo = pp->lo; q.hi = pp->hi; q.li = pp->li; q.pad = 0; return q;
#else
    return Params{};
#endif
}
constexpr int ST_PRO = 0, LSTEPS = 23, ST_L0 = 1;
constexpr int SO_NORM1 = 0, SO_CHUNK = 1, CSTEPS = 5, SO_NORM2 = 11, SO_FFN = 12;
constexpr int ST_END = ST_L0 + 2 * LSTEPS;

template <bool NT = false> __device__ __forceinline__ void transpose_item(const float* W, int ldw, int K  , bf16_t* WT, int k0, int n0, int drow0, LAS float* scr, int lane) {
    float tv[32];
#pragma unroll
    for (int i = 0; i < 32; ++i) { const float* s_ = W + (size_t)(k0 + 2 * i + (lane >> 5)) * ldw + n0 + (lane & 31); tv[i] = NT ? __builtin_nontemporal_load(s_) : *s_; }
#pragma unroll
    for (int i = 0; i < 32; ++i) scr[(2 * i + (lane >> 5)) * 33 + (lane & 31)] = tv[i];
    LDS_WAIT(); asm volatile("" ::: "memory");
    const int c = lane & 7;
#pragma unroll
    for (int j = 0; j < 4; ++j) { const int n = (lane >> 3) + 8 * j; const LAS float* s = scr + (8 * c) * 33 + n;
        v4u o; o.x = pk2(s[0 * 33], s[1 * 33]); o.y = pk2(s[2 * 33], s[3 * 33]); o.z = pk2(s[4 * 33], s[5 * 33]); o.w = pk2(s[6 * 33], s[7 * 33]);
        if (NT) __builtin_nontemporal_store(o, (GAS v4u*)(WT + (size_t)(drow0 + n) * K + k0 + 8 * c)); else *(GAS v4u*)(WT + (size_t)(drow0 + n) * K + k0 + 8 * c) = o; }
    LDS_WAIT(); asm volatile("" ::: "memory");
}
struct Job { const float* W; bf16_t* WT; int ldw, K, nblk, mode, drow, first, kp, pad; };
constexpr int NJOBS = 2 * 6 + 3 + 3 * NE;
__device__ __forceinline__ void job_set(LAS Job* J, int& nj, int& items, const float* W, int ldw, int K, int ncols, int mode, int drow, bf16_t* WT, int kp = 0) {
    J[nj].kp = kp ? kp : K; J[nj].W = W; J[nj].WT = WT; J[nj].ldw = ldw; J[nj].K = K; J[nj].nblk = ncols / 32; J[nj].mode = mode; J[nj].drow = drow; J[nj].first = items; ++nj; items += (K / 64) * (ncols / 32);
}
constexpr int PRO_SCR = 0, PRO_SC = 8 * 64 * 33 * 4  , PRO_JOB = PRO_SC + NB * D * 4  , PRO_JN = PRO_JOB + 48 * 48;
static_assert(PRO_JN + 64 <= LDSCTL_OFF && sizeof(Job) == 48 && NJOBS <= 48, "prologue LDS map");

__device__ __forceinline__ void build_luts(const Params& p, int tid);
__device__ __forceinline__ void prologue(const Params& p, LAS unsigned char* lds, int tid, int lane, int wave) {
    unsigned char* ws = p.ws;
    LAS Job* J = (LAS Job*)(lds + PRO_JOB);
    LAS int* JN = (LAS int*)(lds + PRO_JN);
    if (tid == 0) {
        int nj = 0, items = 0;
        for (int l = 0; l < 2; ++l) {
            bf16_t* win = (bf16_t*)(ws + WS_WIN) + (size_t)l * NP * D; const float* w_in = p.in[6] + (size_t)l * D * NIN;
            job_set(J, nj, items, w_in, NIN, D, 6144, 0, 0, win);
            job_set(J, nj, items, w_in + 6150, NIN, D, 3072, 0, 6144, win);
            bf16_t* wbr = (bf16_t*)(ws + WS_WBR) + (size_t)l * 1280 * D;
            job_set(J, nj, items, p.in[14] + (size_t)l * 512 * D, D, 512, D, 0, 0, wbr, 1280);
            job_set(J, nj, items, p.in[15] + (size_t)l * 384 * D, D, 384, D, 0, 0, wbr + 512, 1280);
            job_set(J, nj, items, p.in[16] + (size_t)l * 384 * D, D, 384, D, 0, 0, wbr + 896, 1280);
            job_set(J, nj, items, p.in[17] + (size_t)l * D * D, D, D, D, 0, 0, (bf16_t*)(ws + WS_WOUT) + (size_t)l * D * D);
        }
        job_set(J, nj, items, p.in[18], DFF, D, DFF, 1, 0, (bf16_t*)(ws + WS_WGU0));
        job_set(J, nj, items, p.in[19], DFF, D, DFF, 1, 128, (bf16_t*)(ws + WS_WGU0));
        job_set(J, nj, items, p.in[20], D, DFF, D, 0, 0, (bf16_t*)(ws + WS_WD0));
        JN[0] = nj; JN[1] = items;
    }
    LAS float* sc = (LAS float*)(lds + PRO_SC);
    const bool modblk = blockIdx.x < 192;
    if (modblk) for (int i = tid; i < NB * D; i += NTHR) { const float c = p.in[1][i]; sc[i] = c / (1.0f + __expf(-c)); }
    __syncthreads();
    float* misc = (float*)(ws + WS_MISC);
    if (blockIdx.x == 192 && wave < 2) {
        const int l = wave; const float a = wave_sum(p.in[8][l * 64 + lane] * p.in[9][l * 64 + lane]), b = wave_sum(p.in[10][l * 64 + lane] * p.in[11][l * 64 + lane]);
        const float lam_init = 0.8f - 0.6f * __expf(-0.3f * (float)l);
        if (lane == 0) { misc[MI_LAM + l] = __expf(a) - __expf(b) + lam_init; misc[MI_LAM + 8 + l] = lam_init; }
    }
    if (modblk) {
        const int l = blockIdx.x / 96, j = (blockIdx.x % 96) * 64 + lane;
        const float* w = p.in[4] + (size_t)l * D * 6 * D + (size_t)(wave * 128) * 6 * D + j;
        const LAS float* scw = sc + wave * 128;
        float acc[NB];
#pragma unroll
        for (int b = 0; b < NB; ++b) acc[b] = 0.f;
        for (int k0 = 0; k0 < 128; k0 += 16) {
            float wv[16];
#pragma unroll
            for (int i = 0; i < 16; ++i) wv[i] = w[(size_t)(k0 + i) * 6 * D];
#pragma unroll
            for (int i = 0; i < 16; ++i)
#pragma unroll
                for (int b = 0; b < NB; ++b) acc[b] += scw[b * D + k0 + i] * wv[i];
        }
        LAS float* part = (LAS float*)(lds + PRO_SCR) + wave * (64 * 33);
#pragma unroll
        for (int b = 0; b < NB; ++b) part[b * 64 + lane] = acc[b];
    }
    __syncthreads();
    if (modblk) {
        const int l = blockIdx.x / 96, j0 = (blockIdx.x % 96) * 64;
        float* mod = (float*)(ws + WS_MOD) + (size_t)l * NB * 6 * D;
        for (int o = tid; o < NB * 64; o += NTHR) { const int b = o >> 6, jj = o & 63; float sum = p.in[5][l * 6 * D + j0 + jj];
#pragma unroll
            for (int w8 = 0; w8 < NWAVES; ++w8) sum += ((const LAS float*)(lds + PRO_SCR) + w8 * (64 * 33))[b * 64 + jj];
            mod[(size_t)b * 6 * D + j0 + jj] = sum; }
    }
    __syncthreads();
    build_luts(p, tid);
    LAS float* scr = (LAS float*)(lds + PRO_SCR) + wave * (64 * 33);
    const int nj = JN[0], nitems = JN[1];
    const int gw = blockIdx.x * NWAVES + wave, NGW = gridDim.x * NWAVES;
    for (int it = gw; it < nitems; it += NGW) {
        int ji = 0;
        for (int q = 1; q < nj; ++q) if (J[q].first <= it) ji = q;
        const float* jW = J[ji].W; bf16_t* jWT = J[ji].WT; const int jldw = J[ji].ldw, jK = J[ji].kp, jnblk = J[ji].nblk, jmode = J[ji].mode, jdrow = J[ji].drow;
        const int r = it - J[ji].first, kb = r / jnblk, nb = r - kb * jnblk, n0 = 32 * nb;
        const int drow0 = jmode ? jdrow + 256 * (n0 >> 7) + (n0 & 127) : jdrow + n0;
        transpose_item(jW + n0, jldw, jK, jWT, 64 * kb, 0, drow0, scr, lane);
    }
}

constexpr int XI_MAT = 16 * (DFE / 32), XI_EXP = 3 * XI_MAT, XI_ALL = NE * XI_EXP;
static_assert(XI_MAT == (DFE / 64) * (D / 32), "expert item count");
__device__ __forceinline__ void expert_item(const Params& p, int it, LAS float* scr, int lane) {
    const int e = it / XI_EXP, r0 = it - e * XI_EXP, m = r0 / XI_MAT, r = r0 - m * XI_MAT;
    const bool dn = m == 2;
    const int nblk = dn ? D / 32 : DFE / 32, kb = r / nblk, n0 = 32 * (r - kb * nblk);
    const float* wg_ = p.in[22]; const float* wu_ = p.in[23]; const float* wd_ = p.in[24]; asm volatile("" : "+s"(wg_), "+s"(wu_), "+s"(wd_));
    const float* W = (dn ? wd_ : (m == 0 ? wg_ : wu_)) + (size_t)e * D * DFE + n0;
    bf16_t* WT = dn ? (bf16_t*)(p.ws + WS_WD1) + (size_t)e * D * DFE : (bf16_t*)(p.ws + WS_WGU1) + (size_t)e * 2 * DFE * D;
    const int drow0 = dn ? n0 : 128 * m + 256 * (n0 >> 7) + (n0 & 127);
    transpose_item<true>(W, dn ? D : DFE, dn ? DFE : D, WT, 64 * kb, 0, drow0, scr, lane);
}
constexpr int XQ_N = 64, XQ_ITEMS = XI_ALL / XQ_N, XQ_BATCH = 4, XQ_LDS = LDSCTL_OFF + 512;
constexpr size_t XQ_OFF = 32768;
static_assert(XI_ALL % XQ_N == 0 && XQ_ITEMS % XQ_BATCH == 0 && XQ_OFF + XQ_N * 512 <= CTL_ZERO && XQ_LDS + 8 * 16 <= LDS_BYTES, "expert queues");
__device__ __forceinline__ bool expert_steal_one(const Params& p, LAS unsigned char* lds, int lane, int wave) {
    volatile LAS int* st = (volatile LAS int*)(lds + XQ_LDS) + 4 * wave;
    int cur = __builtin_amdgcn_readfirstlane(st[0]); const int end = __builtin_amdgcn_readfirstlane(st[1]);
    if (cur == end) {
        if (__builtin_amdgcn_readfirstlane(st[2])) return false;
        unsigned* qb = (unsigned*)(p.ws + WS_CTL + XQ_OFF);
        const unsigned long long m = __ballot(xb_ld(qb + 128 * lane) < (unsigned)XQ_ITEMS);
        if (m == 0ull) { st[2] = 1; return false; }
        const int h = (int)(blockIdx.x * NWAVES + wave) & (XQ_N - 1);
        const unsigned long long r = h ? ((m >> h) | (m << (64 - h))) : m;
        const int k = (h + (int)__builtin_ctzll(r)) & (XQ_N - 1);
        unsigned v = 0; if (lane == 0) v = xb_add(qb + 128 * k, (unsigned)XQ_BATCH);
        v = (unsigned)__builtin_amdgcn_readfirstlane((int)v);
        if (v >= (unsigned)XQ_ITEMS) return true;
        cur = k * XQ_ITEMS + (int)v; st[1] = cur + XQ_BATCH;
    }
    expert_item(p, cur, (LAS float*)(lds + PRO_SCR) + wave * (64 * 33), lane);
    st[0] = cur + 1;
    return true;
}
__device__ __forceinline__ void expert_mopup(const Params& p, LAS unsigned char* lds, int lane, int wave) {
    while (expert_steal_one(p, lds, lane, wave)) {}
}
__device__ __forceinline__ void xcd_barrier_steal(const XcdBarrier& b, LAS unsigned char* lds) {
    asm volatile("s_waitcnt vmcnt(0)" ::: "memory");
    __syncthreads();
    volatile LAS unsigned* rel = (volatile LAS unsigned*)(lds + MISC_OFF + 48);
    int tid = threadIdx.x; asm volatile("" : "+v"(tid));
    if (tid < 64) {
        if (tid == 0) {
            unsigned* bar = b.bar;
            __builtin_amdgcn_s_waitcnt(0);
            unsigned nloc = b.st[0], nx = b.st[1];
            if (nloc == 0u) { xcd_barrier_complete(bar, b.x, nloc, nx); b.st[0] = nloc; b.st[1] = nx; }
            const unsigned old = xb_add(&bar[XB_XSUB(b.x)], 1u);
            const unsigned gen = old / nloc;
            if (old + 1u == (gen + 1u) * nloc) {
                rel[0] = 2u;
                __builtin_amdgcn_fence(__ATOMIC_RELEASE, "agent");
                asm volatile("s_waitcnt vmcnt(0)" ::: "memory");
                const unsigned og = xb_add(&bar[XB_TOP], 1u);
                const unsigned tg = og / nx;
                if (og + 1u == (tg + 1u) * nx) xb_add(&bar[XB_TOPGEN], 1u);
                else XB_SPIN(xb_ld(&bar[XB_TOPGEN]) == tg, bar);
                __builtin_amdgcn_fence(__ATOMIC_ACQUIRE, "agent");
                xb_add(&bar[XB_XGEN(b.x)], 1u);
                asm volatile("s_waitcnt vmcnt(0)" ::: "memory");
            } else {
                const unsigned stopat = (gen + 1u) * nloc - (nloc >> 3) - 1u;
                bool go = old + 1u < stopat;
                rel[0] = go ? 1u : 2u;
                unsigned sp = 0;
                while (xb_ld(&bar[XB_XGEN(b.x)]) == gen) {
                    if (go && xb_ld(&bar[XB_XSUB(b.x)]) >= stopat) { rel[0] = 2u; go = false; }
                    __builtin_amdgcn_s_sleep(1);
                    if ((++sp & 255u) == 0u) { if (xb_ld(&bar[XB_TMO])) break; if (sp > XB_SPIN_CAP) { atomicAdd(&bar[XB_TMO], 1u); break; } }
                }
                rel[0] = 2u;
                __builtin_amdgcn_fence(__ATOMIC_ACQUIRE, "agent");
                asm volatile("s_waitcnt vmcnt(0)" ::: "memory");
            }
        }
    } else {
        const Params p = load_params();
        const int lane = tid & 63, wave = __builtin_amdgcn_readfirstlane(tid >> 6);
        while (rel[0] == 0u) __builtin_amdgcn_s_sleep(1);
        while (rel[0] == 1u) { if (!expert_steal_one(p, lds, lane, wave)) break; }
        asm volatile("s_waitcnt vmcnt(0)" ::: "memory");
    }
    __syncthreads();
    if (tid == 0) rel[0] = 0u;
}

__device__ __forceinline__ void norm_rows(const float* x, const float* g, const float* sc, const float* sh, bf16_t* h, int t0, int t1, int gw, int NGW, int lane) {
    f32x4 vn[4], vm[4];
    { const int tf = (t0 + gw < t1) ? t0 + gw : 0, tg = (t0 + gw + NGW < t1) ? t0 + gw + NGW : tf; const GAS f32x4* xn = (const GAS f32x4*)(x + (size_t)tf * D) + lane; const GAS f32x4* xm = (const GAS f32x4*)(x + (size_t)tg * D) + lane;
#pragma unroll
      for (int j = 0; j < 4; ++j) { vn[j] = xn[64 * j]; vm[j] = xm[64 * j]; } }
    const int TEND = t1;
    for (int t = t0 + gw; t < t1; t += NGW) {
        const int b = t >> 11;
        f32x4 v[4]; float s = 0.f;
#pragma unroll
        for (int j = 0; j < 4; ++j) { v[j] = vn[j]; vn[j] = vm[j]; s += (v[j].x * v[j].x + v[j].y * v[j].y) + (v[j].z * v[j].z + v[j].w * v[j].w); }
        { const int tn = (t + 2 * NGW < TEND) ? t + 2 * NGW : t; const GAS f32x4* xn = (const GAS f32x4*)(x + (size_t)tn * D) + lane;
#pragma unroll
          for (int j = 0; j < 4; ++j) vm[j] = xn[64 * j]; }
        const float r = 1.0f / sqrtf(wave_sum(s) * (1.0f / D) + EPS);
        GAS v2u* o8 = (GAS v2u*)(h + (size_t)t * D) + lane;
#pragma unroll
        for (int j = 0; j < 4; ++j) { const int d = 4 * lane + 256 * j;
            const f32x4 g4 = *(const f32x4*)(g + d), c4 = *(const f32x4*)(sc + (size_t)b * 6 * D + d), h4 = *(const f32x4*)(sh + (size_t)b * 6 * D + d);
            const f32x4 o = v[j] * r * g4 * (c4 + 1.0f) + h4;
            v2u w; w.x = pk2(o.x, o.y); w.y = pk2(o.z, o.w); o8[64 * j] = w; }
    }
}


typedef float f32x16 __attribute__((ext_vector_type(16)));
typedef short bf16x8 __attribute__((ext_vector_type(8)));
typedef short s16x4 __attribute__((ext_vector_type(4)));
typedef float f32x2_t __attribute__((ext_vector_type(2))); typedef __bf16 bf16x2_t __attribute__((ext_vector_type(2)));
constexpr int QP = 2048;
constexpr int AL_K = 0, AL_V = 49152, AL_LUT = 114688, AL_OST = 65536, AL_XCH = 0;
static_assert(AL_LUT + 2 * 2240 * 4 <= LDSCTL_OFF && AL_OST + 34816 <= AL_LUT && 6 * 8192 <= AL_V && AL_V + 6 * 8192 <= AL_LUT, "attention LDS map");
constexpr int LUTA_N = 2240, LUTB_N = 384;
constexpr float NEG_BIG = -1.0e30f;
__device__ __forceinline__ unsigned cvtpk_s(float lo, float hi) { f32x2_t v = {lo, hi}; bf16x2_t b = __builtin_convertvector(v, bf16x2_t); return __builtin_bit_cast(unsigned, b); }
__device__ __forceinline__ s16x4 vtr(const LAS unsigned char* p) { typedef short v4i16_t __attribute__((ext_vector_type(4))); return __builtin_bit_cast(s16x4, __builtin_amdgcn_ds_read_tr16_b64_v4i16((LAS v4i16_t*)p)); }
__device__ __forceinline__ float xhalf_max(float v) { auto rr = __builtin_amdgcn_permlane32_swap(__float_as_uint(v), __float_as_uint(v), false, false); return fmaxf(__uint_as_float(rr[0]), __uint_as_float(rr[1])); }
__device__ __forceinline__ float xhalf_sum(float v) { auto rr = __builtin_amdgcn_permlane32_swap(__float_as_uint(v), __float_as_uint(v), false, false); return __uint_as_float(rr[0]) + __uint_as_float(rr[1]); }

struct AttnArgs {
    bf16_t* q;
    const bf16_t* k;
    const bf16_t* v;
    int q0;
    const float* tab;
    int seqM;
    float* lse;
    float lam, osc;
    const float* subg;
};
template <int MODE> __device__ __forceinline__ void attn_unit(const AttnArgs& a, LAS unsigned char* lds, int tid_in, int lane_in, int wave) {
    int tid = tid_in; asm volatile("" : "+v"(tid)); const int lane = tid & 63; (void)lane_in;
    constexpr int DV = MODE == 0 ? 128 : 64, NDB = DV / 32, NKL = MODE == 0 ? 2 : 1, NVL = MODE == 0 ? 2 : 1;
    const int r32 = lane & 31, hi = lane >> 5;
    const int map = MODE == 0 ? (wave >> 2) : 0, wq = MODE == 0 ? (wave & 3) : wave;
    const int qrow = a.q0 + 32 * wq;
    constexpr int KP = MODE == 0 ? 128 : 64, VP = KP;
    LAS float* lut = (LAS float*)(lds + AL_LUT);
    { constexpr int NT = MODE == 0 ? 2 * LUTA_N : (MODE == 1 ? 2048 : LUTB_N), NIT = (NT + NTHR - 1) / NTHR;
      const int need = MODE == 1 ? (a.q0 + 256) : NT;
      float tv[NIT];
#pragma unroll
      for (int k = 0; k < NIT; ++k) { const int i = tid + k * NTHR; tv[k] = i < need ? a.tab[i] : 0.f; }
#pragma unroll
      for (int k = 0; k < NIT; ++k) { const int i = tid + k * NTHR; if (i < need) lut[i] = tv[k]; } }
    bf16x8 qr[4];
    { const bf16_t* Qw = a.q + (size_t)(qrow + r32) * QP + map * 64 + hi * 8;
#pragma unroll
      for (int d0 = 0; d0 < 4; ++d0) qr[d0] = *(const bf16x8*)(Qw + d0 * 16); }
    int tlo, thi;
    if (MODE == 0) { tlo = 0; thi = (a.q0 + 128) / 64 - 1; }
    else if (MODE == 1) { tlo = 0; thi = (a.q0 + 256) / 64 - 1; }
    else { const int lo = a.q0 - 128; tlo = lo > 0 ? lo / 64 : 0; thi = (a.q0 + 256) / 64 - 1; }
    const bf16_t* gK = a.k + (size_t)(tid & 63) * KP + (tid >> 6) * 8;
    const bf16_t* gV = a.v + (size_t)(16 * (wave & 3) + (lane >> 2)) * VP + (wave >> 2) * 32 + (lane & 3) * 8;
#define AT_DMA(t_) do { const size_t ro = (size_t)(t_) * 64 * KP; const int ks_ = (MODE == 2 ? ((t_) - tlo) * 8192 : ((t_) % 3) * 16384) + wave * 1024, vs_ = (MODE == 2 ? ((t_) - tlo) * 8192 : ((t_) & 3) * 16384) + wave * 1024; \
        _Pragma("unroll") for (int i_ = 0; i_ < NKL; ++i_) __builtin_amdgcn_global_load_lds((const unsigned*)(gK + ro + i_ * 64), (LAS unsigned*)(lds + AL_K + ks_ + i_ * 8192), 16, 0, 0); \
        _Pragma("unroll") for (int i_ = 0; i_ < NVL; ++i_) __builtin_amdgcn_global_load_lds((const unsigned*)(gV + ro + i_ * 64), (LAS unsigned*)(lds + AL_V + vs_ + i_ * 8192), 16, 0, 0); } while (0)
#define AT_WAITBAR(n_) asm volatile("s_waitcnt vmcnt(" #n_ ") lgkmcnt(0)\n\ts_barrier" ::: "memory")
    constexpr float THR = 6.0f;
    float m_run = 0.f, l_run = 0.f;
    f32x16 negm = f32x16{};
    f32x16 o[NDB];
#pragma unroll
    for (int i = 0; i < NDB; ++i) o[i] = f32x16{};
    const int e0 = qrow + r32 - 4 * hi;
    int imax = 0, seq0 = 0;
    if (MODE == 2) { seq0 = qrow & ~(a.seqM - 1); const int dq = qrow + r32 - seq0; imax = dq < 128 ? dq : 128; }
    bf16x8 pw[4];
    bool pend = false; int pend_vs = 0;
#define AT_PV() do { const unsigned vb = (unsigned)(size_t)(lds + AL_V + pend_vs) + ((lane >> 4) & 1) * 32 + (lane & 3) * 8 + (4 * hi + ((lane & 15) >> 2)) * 64; \
        _Pragma("unroll") for (int dp = 0; dp < NDB; dp += 2) { s16x4 lo_[2][4], hh_[2][4];          \
            _Pragma("unroll") for (int dd = 0; dd < 2; ++dd) _Pragma("unroll") for (int ks = 0; ks < 4; ++ks) { \
                asm volatile("ds_read_b64_tr_b16 %0, %1 offset:%c2" : "=&v"(lo_[dd][ks]) : "v"(vb), "i"((dp + dd) * 4096 + ks * 1024) : "memory"); \
                asm volatile("ds_read_b64_tr_b16 %0, %1 offset:%c2" : "=&v"(hh_[dd][ks]) : "v"(vb), "i"((dp + dd) * 4096 + ks * 1024 + 512) : "memory"); } \
            asm volatile("s_waitcnt lgkmcnt(0)" ::: "memory"); __builtin_amdgcn_sched_barrier(0);     \
            _Pragma("unroll") for (int ks = 0; ks < 4; ++ks) _Pragma("unroll") for (int dd = 0; dd < 2; ++dd) { const bf16x8 vf = __builtin_shufflevector(lo_[dd][ks], hh_[dd][ks], 0, 1, 2, 3, 4, 5, 6, 7); \
                o[dp + dd] = __builtin_amdgcn_mfma_f32_32x32x16_bf16(vf, pw[ks], o[dp + dd], 0, 0, 0); } } } while (0)
#define MX3(a_, b_, c_) __builtin_fmaxf(__builtin_fmaxf((a_), (b_)), (c_))
#define AT_STEP(MASKED, t) do { \
        const int E = e0 - 64 * (t); \
        f32x16 p0, p1; \
        { const LAS unsigned char* kb = lds + AL_K + (MODE == 2 ? ((t) - tlo) * 8192 : ((t) % 3) * 16384) + map * 8192 + hi * 1024 + r32 * 16; bf16x8 kf[8]; \
          _Pragma("unroll") for (int d0 = 0; d0 < 4; ++d0) { kf[2 * d0] = *(const LAS bf16x8*)(kb + d0 * 2048); kf[2 * d0 + 1] = *(const LAS bf16x8*)(kb + d0 * 2048 + 512); }     \
          p0 = __builtin_amdgcn_mfma_f32_32x32x16_bf16(kf[0], qr[0], negm, 0, 0, 0); p1 = __builtin_amdgcn_mfma_f32_32x32x16_bf16(kf[1], qr[0], negm, 0, 0, 0); \
          _Pragma("unroll") for (int d0 = 1; d0 < 4; ++d0) { p0 = __builtin_amdgcn_mfma_f32_32x32x16_bf16(kf[2 * d0], qr[d0], p0, 0, 0, 0); p1 = __builtin_amdgcn_mfma_f32_32x32x16_bf16(kf[2 * d0 + 1], qr[d0], p1, 0, 0, 0); } } \
        if (pend) AT_PV(); \
        if (MODE == 0) __builtin_amdgcn_sched_barrier(0); \
        _Pragma("unroll") for (int hf = 0; hf < 2; ++hf) { f32x16 bb; \
            if (MODE == 1) { const LAS float* nf = lut + 64 * (t) + 4 * hi + 32 * hf; \
                _Pragma("unroll") for (int g = 0; g < 4; ++g) { const f32x4 a0 = *(const LAS f32x4*)(nf + 8 * g); bb[4 * g] = a0.x; bb[4 * g + 1] = a0.y; bb[4 * g + 2] = a0.z; bb[4 * g + 3] = a0.w; } \
            } else { const LAS float* lb = lut + (MODE == 0 ? map * LUTA_N + 2047 - E : 255 - E) + 32 * hf; \
                _Pragma("unroll") for (int r = 0; r < 16; ++r) bb[r] = lb[(r & 3) + 8 * (r >> 2)]; } \
            if (hf == 0) p0 += bb; else p1 += bb; \
            if (MODE == 0) __builtin_amdgcn_sched_barrier(0); } \
        if (MASKED) {   \
            if (MODE == 2) { if (qrow - seq0 < 128) { const int lim = E - imax; _Pragma("unroll") for (int r = 0; r < 16; ++r) { const int c0 = (r & 3) + 8 * (r >> 2), c1 = c0 + 32; \
                if (c0 < lim) p0[r] = -INFINITY; if (c1 < lim) p1[r] = -INFINITY; } } } \
            else if (MODE == 1) { _Pragma("unroll") for (int r = 0; r < 16; ++r) { const int c0 = (r & 3) + 8 * (r >> 2), c1 = c0 + 32; if (c0 > E) p0[r] = -INFINITY; if (c1 > E) p1[r] = -INFINITY; } } } \
        float ta = MX3(p0[0], p0[1], p1[0]), tb = MX3(p0[2], p0[3], p1[1]); ta = MX3(ta, p1[2], p1[3]); \
        _Pragma("unroll") for (int r = 4; r < 16; r += 4) { ta = MX3(ta, p0[r], p0[r + 1]); tb = MX3(tb, p0[r + 2], p0[r + 3]); ta = MX3(ta, p1[r], p1[r + 1]); tb = MX3(tb, p1[r + 2], p1[r + 3]); } \
        const float tm = xhalf_max(__builtin_fmaxf(ta, tb)); \
        bool resc = false; float al = 1.0f; \
        if (__any(tm > THR)) { const float dl = __builtin_fmaxf(tm, 0.f); m_run += dl; al = __builtin_amdgcn_exp2f(-dl); l_run *= al; resc = true; \
            _Pragma("unroll") for (int r = 0; r < 16; ++r) { p0[r] -= dl; p1[r] -= dl; negm[r] -= dl; } } \
        float rs0 = 0.f, rs1 = 0.f; \
        _Pragma("unroll") for (int r = 0; r < 16; ++r) { p0[r] = __builtin_amdgcn_exp2f(p0[r]); p1[r] = __builtin_amdgcn_exp2f(p1[r]); rs0 += p0[r]; rs1 += p1[r]; } \
        l_run += rs0 + rs1; \
        _Pragma("unroll") for (int ks = 0; ks < 4; ++ks) { v4u w; \
            if (ks < 2) { w.x = cvtpk_s(p0[8 * ks], p0[8 * ks + 1]); w.y = cvtpk_s(p0[8 * ks + 2], p0[8 * ks + 3]); w.z = cvtpk_s(p0[8 * ks + 4], p0[8 * ks + 5]); w.w = cvtpk_s(p0[8 * ks + 6], p0[8 * ks + 7]); } \
            else { const int k2 = ks - 2; w.x = cvtpk_s(p1[8 * k2], p1[8 * k2 + 1]); w.y = cvtpk_s(p1[8 * k2 + 2], p1[8 * k2 + 3]); w.z = cvtpk_s(p1[8 * k2 + 4], p1[8 * k2 + 5]); w.w = cvtpk_s(p1[8 * k2 + 6], p1[8 * k2 + 7]); } \
            pw[ks] = __builtin_bit_cast(bf16x8, w); } \
        if (resc) { _Pragma("unroll") for (int i = 0; i < NDB; ++i) _Pragma("unroll") for (int r = 0; r < 16; ++r) o[i][r] *= al; } \
        pend = true; pend_vs = MODE == 2 ? ((t) - tlo) * 8192 : ((t) & 3) * 16384; } while (0)
    constexpr int NPT = NKL + NVL;
#ifdef PROBE_ATT
    unsigned long long pt0_ = 0; const bool pr_ = ((PROBE_ATT >> MODE) & 1) && blockIdx.x == 0 && tid == 0; if (pr_) pt0_ = __builtin_amdgcn_s_memrealtime();
#endif
    asm volatile("s_waitcnt vmcnt(0) lgkmcnt(0)" ::: "memory");
    if (MODE == 2) {
        for (int t = tlo; t <= thi; ++t) AT_DMA(t);
        AT_WAITBAR(0);
        for (int t = tlo; t <= thi; ++t) {
            const int klo = qrow - 128 > seq0 ? qrow - 128 : seq0;
            const bool active = (64 * t <= qrow + 31) && (64 * t + 63 >= klo);
            if (active) AT_STEP(true, t);
        }
    } else {
    AT_DMA(tlo); if (tlo < thi) AT_DMA(tlo + 1);
    if (tlo < thi) { if (NPT == 4) AT_WAITBAR(4); else AT_WAITBAR(2); } else AT_WAITBAR(0);
    const int tband = thi - (MODE == 0 ? 1 : 3);
    int t = tlo;
    for (; t < tband; ++t) {
        AT_DMA(t + 2);
        AT_STEP(false, t);
        if (NPT == 4) AT_WAITBAR(4); else AT_WAITBAR(2);
    }
    for (; t <= thi; ++t) {
        if (t + 2 <= thi) AT_DMA(t + 2);
        const bool active = 64 * t <= qrow + 31;
        if (active) AT_STEP(true, t);
        else if (pend) { AT_PV(); pend = false; }
        if (t + 2 <= thi) { if (NPT == 4) AT_WAITBAR(4); else AT_WAITBAR(2); } else AT_WAITBAR(0);
    }
    }
    if (pend) AT_PV();
#ifdef PROBE_ATT
    if (pr_) { volatile LAS unsigned long long* q_ = (volatile LAS unsigned long long*)(lds + LDSCTL_OFF + 64); q_[1] += __builtin_amdgcn_s_memrealtime() - pt0_; }
#endif
    asm volatile("s_waitcnt lgkmcnt(0)\n\ts_barrier" ::: "memory");
#undef AT_STEP
#undef MX3
#undef AT_PV
#undef AT_DMA
#undef AT_WAITBAR
    const float lt = xhalf_sum(l_run), inv = 1.0f / lt;
#pragma unroll
    for (int i = 0; i < NDB; ++i)
#pragma unroll
        for (int r = 0; r < 16; ++r) o[i][r] *= inv;
    if (MODE == 2) { if (hi == 0) a.lse[(size_t)(qrow + r32) * 8] = m_run + __builtin_amdgcn_logf(lt); }
    bool store = true;
    if (MODE == 0) {
        LAS float* xch = (LAS float*)(lds + AL_XCH) + wq * 4096;
        if (map == 1) {
#pragma unroll
            for (int i = 0; i < NDB; ++i)
#pragma unroll
                for (int r = 0; r < 16; ++r) xch[(i * 16 + r) * 64 + lane] = o[i][r];
        }
        __syncthreads();
        if (map == 0) {
            float ss = 0.f;
#pragma unroll
            for (int i = 0; i < NDB; ++i)
#pragma unroll
                for (int r = 0; r < 16; ++r) { const float v = o[i][r] - a.lam * xch[(i * 16 + r) * 64 + lane]; o[i][r] = v; ss += v * v; }
            ss = xhalf_sum(ss);
            const float rn = (1.0f / sqrtf(ss * (1.0f / 128.0f) + EPS)) * a.osc;
#pragma unroll
            for (int i = 0; i < NDB; ++i)
#pragma unroll
                for (int g = 0; g < 4; ++g) { const f32x4 sg = *(const f32x4*)(a.subg + 32 * i + 8 * g + 4 * hi);
                    o[i][4 * g] *= rn * sg.x; o[i][4 * g + 1] *= rn * sg.y; o[i][4 * g + 2] *= rn * sg.z; o[i][4 * g + 3] *= rn * sg.w; }
        }
        store = map == 0;
    }
    if (store) {
        constexpr int RS = DV * 2 + 16;
        LAS unsigned char* ost = lds + AL_OST + wq * (32 * RS);
#pragma unroll
        for (int i = 0; i < NDB; ++i)
#pragma unroll
            for (int g = 0; g < 4; ++g) { v2u w; w.x = cvtpk_s(o[i][4 * g], o[i][4 * g + 1]); w.y = cvtpk_s(o[i][4 * g + 2], o[i][4 * g + 3]);
                *(LAS v2u*)(ost + r32 * RS + (32 * i + 8 * g + 4 * hi) * 2) = w; }
        LDS_WAIT();
        bf16_t* Ow = a.q + (size_t)qrow * QP;
        constexpr int CPR = DV / 8, RPI = 64 / CPR;
#pragma unroll
        for (int i = 0; i < 32 / RPI; ++i) { const int row = i * RPI + lane / CPR, ch = lane % CPR;
            const v4u v = *(const LAS v4u*)(ost + row * RS + ch * 16); *(GAS v4u*)(Ow + (size_t)row * QP + ch * 8) = v; }
    }
    __syncthreads();
}
__device__ const unsigned short SCHED_AC[256][6] = {
{0,848,1280,65535,65535,65535},
{1,849,1281,65535,65535,65535},
{2,850,1282,65535,65535,65535},
{3,851,1283,65535,65535,65535},
{4,852,1284,65535,65535,65535},
{5,853,1285,65535,65535,65535},
{6,854,1286,65535,65535,65535},
{7,855,1287,65535,65535,65535},
{8,856,1288,65535,65535,65535},
{9,857,1289,65535,65535,65535},
{10,858,1290,65535,65535,65535},
{11,859,1291,65535,65535,65535},
{12,860,1292,65535,65535,65535},
{13,861,1293,65535,65535,65535},
{14,862,1294,65535,65535,65535},
{15,863,1295,65535,65535,65535},
{16,864,1296,65535,65535,65535},
{17,865,1297,65535,65535,65535},
{18,866,1298,65535,65535,65535},
{19,867,1299,65535,65535,65535},
{20,868,1300,65535,65535,65535},
{21,869,1301,65535,65535,65535},
{22,870,1302,65535,65535,65535},
{23,871,1303,65535,65535,65535},
{24,872,1304,65535,65535,65535},
{25,873,1305,65535,65535,65535},
{26,874,1306,65535,65535,65535},
{27,875,1307,65535,65535,65535},
{28,876,1308,65535,65535,65535},
{29,877,1309,65535,65535,65535},
{30,878,1310,65535,65535,65535},
{31,879,1311,65535,65535,65535},
{64,784,1216,1344,65535,65535},
{65,785,1217,1345,65535,65535},
{66,786,1218,1346,65535,65535},
{67,787,1219,1347,65535,65535},
{68,788,1220,1348,65535,65535},
{69,789,1221,1349,65535,65535},
{70,790,1222,1350,65535,65535},
{71,791,1223,1351,65535,65535},
{72,792,1224,1352,65535,65535},
{73,793,1225,1353,65535,65535},
{74,794,1226,1354,65535,65535},
{75,795,1227,1355,65535,65535},
{76,796,1228,1356,65535,65535},
{77,797,1229,1357,65535,65535},
{78,798,1230,1358,65535,65535},
{79,799,1231,1359,65535,65535},
{80,832,1184,65535,65535,65535},
{81,833,1185,65535,65535,65535},
{82,834,1186,65535,65535,65535},
{83,835,1187,65535,65535,65535},
{84,836,1188,65535,65535,65535},
{85,837,1189,65535,65535,65535},
{86,838,1190,65535,65535,65535},
{87,839,1191,65535,65535,65535},
{88,840,1192,65535,65535,65535},
{89,841,1193,65535,65535,65535},
{90,842,1194,65535,65535,65535},
{91,843,1195,65535,65535,65535},
{92,844,1196,65535,65535,65535},
{93,845,1197,65535,65535,65535},
{94,846,1198,65535,65535,65535},
{95,847,1199,65535,65535,65535},
{128,736,1232,1360,65535,65535},
{129,737,1233,1361,65535,65535},
{130,738,1234,1362,65535,65535},
{131,739,1235,1363,65535,65535},
{132,740,1236,1364,65535,65535},
{133,741,1237,1365,65535,65535},
{134,742,1238,1366,65535,65535},
{135,743,1239,1367,65535,65535},
{136,744,1240,1368,65535,65535},
{137,745,1241,1369,65535,65535},
{138,746,1242,1370,65535,65535},
{139,747,1243,1371,65535,65535},
{140,748,1244,1372,65535,65535},
{141,749,1245,1373,65535,65535},
{142,750,1246,1374,65535,65535},
{143,751,1247,1375,65535,65535},
{144,768,1104,1408,65535,65535},
{145,769,1105,1409,65535,65535},
{146,770,1106,1410,65535,65535},
{147,771,1107,1411,65535,65535},
{148,772,1108,1412,65535,65535},
{149,773,1109,1413,65535,65535},
{150,774,1110,1414,65535,65535},
{151,775,1111,1415,65535,65535},
{152,776,1112,1416,65535,65535},
{153,777,1113,1417,65535,65535},
{154,778,1114,1418,65535,65535},
{155,779,1115,1419,65535,65535},
{156,780,1116,1420,65535,65535},
{157,781,1117,1421,65535,65535},
{158,782,1118,1422,65535,65535},
{159,783,1119,1423,65535,65535},
{192,704,1152,1424,65535,65535},
{193,705,1153,1425,65535,65535},
{194,706,1154,1426,65535,65535},
{195,707,1155,1427,65535,65535},
{196,708,1156,1428,65535,65535},
{197,709,1157,1429,65535,65535},
{198,710,1158,1430,65535,65535},
{199,711,1159,1431,65535,65535},
{200,712,1160,1432,65535,65535},
{201,713,1161,1433,65535,65535},
{202,714,1162,1434,65535,65535},
{203,715,1163,1435,65535,65535},
{204,716,1164,1436,65535,65535},
{205,717,1165,1437,65535,65535},
{206,718,1166,1438,65535,65535},
{207,719,1167,1439,65535,65535},
{208,720,1168,1440,65535,65535},
{209,721,1169,1441,65535,65535},
{210,722,1170,1442,65535,65535},
{211,723,1171,1443,65535,65535},
{212,724,1172,1444,65535,65535},
{213,725,1173,1445,65535,65535},
{214,726,1174,1446,65535,65535},
{215,727,1175,1447,65535,65535},
{216,728,1176,1448,65535,65535},
{217,729,1177,1449,65535,65535},
{218,730,1178,1450,65535,65535},
{219,731,1179,1451,65535,65535},
{220,732,1180,1452,65535,65535},
{221,733,1181,1453,65535,65535},
{222,734,1182,1454,65535,65535},
{223,735,1183,1455,65535,65535},
{256,640,896,65535,65535,65535},
{257,641,897,65535,65535,65535},
{258,642,898,65535,65535,65535},
{259,643,899,65535,65535,65535},
{260,644,900,65535,65535,65535},
{261,645,901,65535,65535,65535},
{262,646,902,65535,65535,65535},
{263,647,903,65535,65535,65535},
{264,648,904,65535,65535,65535},
{265,649,905,65535,65535,65535},
{266,650,906,65535,65535,65535},
{267,651,907,65535,65535,65535},
{268,652,908,65535,65535,65535},
{269,653,909,65535,65535,65535},
{270,654,910,65535,65535,65535},
{271,655,911,65535,65535,65535},
{272,656,912,65535,65535,65535},
{273,657,913,65535,65535,65535},
{274,658,914,65535,65535,65535},
{275,659,915,65535,65535,65535},
{276,660,916,65535,65535,65535},
{277,661,917,65535,65535,65535},
{278,662,918,65535,65535,65535},
{279,663,919,65535,65535,65535},
{280,664,920,65535,65535,65535},
{281,665,921,65535,65535,65535},
{282,666,922,65535,65535,65535},
{283,667,923,65535,65535,65535},
{284,668,924,65535,65535,65535},
{285,669,925,65535,65535,65535},
{286,670,926,65535,65535,65535},
{287,671,927,65535,65535,65535},
{320,576,960,65535,65535,65535},
{321,577,961,65535,65535,65535},
{322,578,962,65535,65535,65535},
{323,579,963,65535,65535,65535},
{324,580,964,65535,65535,65535},
{325,581,965,65535,65535,65535},
{326,582,966,65535,65535,65535},
{327,583,967,65535,65535,65535},
{328,584,968,65535,65535,65535},
{329,585,969,65535,65535,65535},
{330,586,970,65535,65535,65535},
{331,587,971,65535,65535,65535},
{332,588,972,65535,65535,65535},
{333,589,973,65535,65535,65535},
{334,590,974,65535,65535,65535},
{335,591,975,65535,65535,65535},
{336,592,976,65535,65535,65535},
{337,593,977,65535,65535,65535},
{338,594,978,65535,65535,65535},
{339,595,979,65535,65535,65535},
{340,596,980,65535,65535,65535},
{341,597,981,65535,65535,65535},
{342,598,982,65535,65535,65535},
{343,599,983,65535,65535,65535},
{344,600,984,65535,65535,65535},
{345,601,985,65535,65535,65535},
{346,602,986,65535,65535,65535},
{347,603,987,65535,65535,65535},
{348,604,988,65535,65535,65535},
{349,605,989,65535,65535,65535},
{350,606,990,65535,65535,65535},
{351,607,991,65535,65535,65535},
{384,512,992,65535,65535,65535},
{385,513,993,65535,65535,65535},
{386,514,994,65535,65535,65535},
{387,515,995,65535,65535,65535},
{388,516,996,65535,65535,65535},
{389,517,997,65535,65535,65535},
{390,518,998,65535,65535,65535},
{391,519,999,65535,65535,65535},
{392,520,1000,65535,65535,65535},
{393,521,1001,65535,65535,65535},
{394,522,1002,65535,65535,65535},
{395,523,1003,65535,65535,65535},
{396,524,1004,65535,65535,65535},
{397,525,1005,65535,65535,65535},
{398,526,1006,65535,65535,65535},
{399,527,1007,65535,65535,65535},
{400,528,1024,1472,65535,65535},
{401,529,1025,1473,65535,65535},
{402,530,1026,1474,65535,65535},
{403,531,1027,1475,65535,65535},
{404,532,1028,1476,65535,65535},
{405,533,1029,1477,65535,65535},
{406,534,1030,1478,65535,65535},
{407,535,1031,1479,65535,65535},
{408,536,1032,1480,65535,65535},
{409,537,1033,1481,65535,65535},
{410,538,1034,1482,65535,65535},
{411,539,1035,1483,65535,65535},
{412,540,1036,1484,65535,65535},
{413,541,1037,1485,65535,65535},
{414,542,1038,1486,65535,65535},
{415,543,1039,1487,65535,65535},
{416,544,1040,1488,65535,65535},
{417,545,1041,1489,65535,65535},
{418,546,1042,1490,65535,65535},
{419,547,1043,1491,65535,65535},
{420,548,1044,1492,65535,65535},
{421,549,1045,1493,65535,65535},
{422,550,1046,1494,65535,65535},
{423,551,1047,1495,65535,65535},
{424,552,1048,1496,65535,65535},
{425,553,1049,1497,65535,65535},
{426,554,1050,1498,65535,65535},
{427,555,1051,1499,65535,65535},
{428,556,1052,1500,65535,65535},
{429,557,1053,1501,65535,65535},
{430,558,1054,1502,65535,65535},
{431,559,1055,1503,65535,65535},
{448,464,1088,1312,65535,65535},
{449,465,1089,1313,65535,65535},
{450,466,1090,1314,65535,65535},
{451,467,1091,1315,65535,65535},
{452,468,1092,1316,65535,65535},
{453,469,1093,1317,65535,65535},
{454,470,1094,1318,65535,65535},
{455,471,1095,1319,65535,65535},
{456,472,1096,1320,65535,65535},
{457,473,1097,1321,65535,65535},
{458,474,1098,1322,65535,65535},
{459,475,1099,1323,65535,65535},
{460,476,1100,1324,65535,65535},
{461,477,1101,1325,65535,65535},
{462,478,1102,1326,65535,65535},
{463,479,1103,1327,65535,65535}
};

static_assert(LUTA_N == 2240 && LUTB_N == 384, "table sizes vs the MISC map");
__device__ __forceinline__ int t5_bucket(int n) {
    if (n < 16) return n < 0 ? 0 : n;
    int b = 16;
    b += n >= 22; b += n >= 30; b += n >= 40; b += n >= 54; b += n >= 73; b += n >= 99; b += n >= 134; b += n >= 182; b += n >= 246; b += n >= 332; b += n >= 450; b += n >= 609; b += n >= 825; b += n >= 1117; b += n >= 1513;
    return b;
}
__device__ __forceinline__ void build_luts(const Params& p, int tid) {
    float* misc = (float*)(p.ws + WS_MISC); const float* rb = p.in[13];
    for (int i = blockIdx.x * NTHR + tid; i < 2 * D * 8; i += gridDim.x * NTHR) { const int l = i >> 13, d = (i >> 3) & 1023, e = i & 7; misc[MI_WF + i] = e < 6 ? p.in[6][(size_t)l * D * NIN + (size_t)d * NIN + 6144 + e] : 0.f; }
    for (int i = blockIdx.x * NTHR + tid; i < 8 * LUTA_N + 18 * LUTB_N; i += gridDim.x * NTHR) {
        if (i < 8 * LUTA_N) { const int hm = i / LUTA_N, j = i % LUTA_N, d = 2047 - j; misc[MI_LUTA + i] = d >= 0 ? rb[t5_bucket(d) * 26 + hm] * LOG2E : -INFINITY; }
        else { const int k = i - 8 * LUTA_N, gh = k / LUTB_N, j = k % LUTB_N, ii = 255 - j, g = gh / 6; misc[MI_LUTB + k] = (ii >= 0 && ii <= 128) ? rb[t5_bucket(ii << (2 * g)) * 26 + 8 + gh] * LOG2E : -INFINITY; }
    }
}
__device__ __forceinline__ void norm_logf(const Params& p, int L, const float* x, const float* g, const float* sc, const float* sh, bf16_t* h, LAS unsigned char* lds, int tid, int lane, int wave) {
    LAS float* wf = (LAS float*)lds;
    const float* w_in = p.in[6] + (size_t)L * D * NIN;
    { const float* src = (const float*)(p.ws + WS_MISC) + MI_WF + L * D * 8; f32x4 tv[4];
#pragma unroll
      for (int k = 0; k < 4; ++k) tv[k] = *(const GAS f32x4*)(src + (tid + k * NTHR) * 4);
#pragma unroll
      for (int k = 0; k < 4; ++k) *(LAS f32x4*)(wf + (tid + k * NTHR) * 4) = tv[k]; }
    (void)w_in;
    __syncthreads();
    const int gw = blockIdx.x * NWAVES + wave, NGW = gridDim.x * NWAVES;
    float* logf = (float*)(p.ws + WS_MISC) + MI_LOGF;
    const float bfv = lane < 6 ? p.in[7][L * 6 + lane] : 0.f;
    f32x4 vn[4], vm[4];
    { const int tf = (gw < T) ? gw : 0, tg = (gw + NGW < T) ? gw + NGW : tf; const GAS f32x4* xn = (const GAS f32x4*)(x + (size_t)tf * D) + lane; const GAS f32x4* xm = (const GAS f32x4*)(x + (size_t)tg * D) + lane;
#pragma unroll
      for (int j = 0; j < 4; ++j) { vn[j] = xn[64 * j]; vm[j] = xm[64 * j]; } }
    constexpr int TEND = T;
    for (int t = gw; t < T; t += NGW) {
        const int b = t >> 11;
        f32x4 v[4]; float s = 0.f;
#pragma unroll
        for (int j = 0; j < 4; ++j) { v[j] = vn[j]; vn[j] = vm[j]; s += (v[j].x * v[j].x + v[j].y * v[j].y) + (v[j].z * v[j].z + v[j].w * v[j].w); }
        { const int tn = (t + 2 * NGW < TEND) ? t + 2 * NGW : t; const GAS f32x4* xn = (const GAS f32x4*)(x + (size_t)tn * D) + lane;
#pragma unroll
          for (int j = 0; j < 4; ++j) vm[j] = xn[64 * j]; }
        const float r = 1.0f / sqrtf(wave_sum(s) * (1.0f / D) + EPS);
        GAS v2u* o8 = (GAS v2u*)(h + (size_t)t * D) + lane;
        float lg[8];
#pragma unroll
        for (int e = 0; e < 8; ++e) lg[e] = 0.f;
#pragma unroll
        for (int j = 0; j < 4; ++j) { const int d = 4 * lane + 256 * j;
            const f32x4 g4 = *(const f32x4*)(g + d), c4 = *(const f32x4*)(sc + (size_t)b * 6 * D + d), h4 = *(const f32x4*)(sh + (size_t)b * 6 * D + d);
            const f32x4 o = v[j] * r * g4 * (c4 + 1.0f) + h4;
            v2u w; w.x = pk2(o.x, o.y); w.y = pk2(o.z, o.w); o8[64 * j] = w;
#pragma unroll
            for (int cc = 0; cc < 4; ++cc) { const f32x4 w0 = *(const LAS f32x4*)(wf + (d + cc) * 8), w1 = *(const LAS f32x4*)(wf + (d + cc) * 8 + 4); const float ov = o[cc];
                lg[0] += ov * w0.x; lg[1] += ov * w0.y; lg[2] += ov * w0.z; lg[3] += ov * w0.w; lg[4] += ov * w1.x; lg[5] += ov * w1.y; } }
        float mine = 0.f;
#pragma unroll
        for (int e = 0; e < 6; ++e) { const float sm = wave_sum(lg[e]); if (lane == e) mine = sm; }
        if (lane < 6) { const float z = mine + bfv; logf[(size_t)t * 8 + lane] = fminf(z, 0.f) - log1pf(__expf(-fabsf(z))); }
    }
}
__device__ __forceinline__ void negf_cumsum(const Params& p, int b, int hh, int lane) {
    const float* logf = (const float*)(p.ws + WS_MISC) + MI_LOGF + (size_t)b * S * 8 + hh;
    float* nf = (float*)(p.ws + WS_MISC) + MI_NEGF + (size_t)(b * 6 + hh) * S;
    float run = 0.f; float loc[32];
#pragma unroll
    for (int i = 0; i < 32; ++i) { run += logf[(size_t)(lane * 32 + i) * 8]; loc[i] = run; }
    float incl = run;
#pragma unroll
    for (int o = 1; o < 64; o <<= 1) { const float u = __shfl_up(incl, o); if (lane >= o) incl += u; }
    const float excl = incl - run;
#pragma unroll
    for (int i = 0; i < 32; ++i) nf[lane * 32 + i] = -(excl + loc[i]) * LOG2E;
}
__device__ __forceinline__ void merge_b(const Params& p, int lane, int wave) {
    bf16_t* proj = (bf16_t*)(p.ws + WS_QO); const float* lse = (const float*)(p.ws + WS_MISC) + MI_LSE;
    const int gw = blockIdx.x * NWAVES + wave, NGW = gridDim.x * NWAVES;
    if (lane < 48) {
        const int h = lane >> 3;
        for (int rb = gw; rb < CH_T; rb += 4 * NGW) {
            float l0[4], l1[4], l2[4]; v4u o0[4], o1[4], o2[4];
#pragma unroll
            for (int k = 0; k < 4; ++k) {
                const int r = (rb + k * NGW < CH_T) ? rb + k * NGW : gw;
                const int t = r & 2047, base = r & ~2047;
                const int r1 = base | ((t & 3) << 9) | (t >> 2), r2 = base | ((t & 15) << 7) | (t >> 4);
                l0[k] = lse[(size_t)r * 8 + h]; l1[k] = lse[(size_t)(CH_T + r1) * 8 + h]; l2[k] = lse[(size_t)(2 * CH_T + r2) * 8 + h];
                o0[k] = *(const GAS v4u*)(proj + (size_t)r * QP + 512 + lane * 8); o1[k] = *(const GAS v4u*)(proj + (size_t)r1 * QP + 512 + 384 + lane * 8); o2[k] = *(const GAS v4u*)(proj + (size_t)r2 * QP + 512 + 768 + lane * 8);
            }
#pragma unroll
            for (int k = 0; k < 4; ++k) {
                const int r = rb + k * NGW;
                const float mx = fmaxf(l0[k], fmaxf(l1[k], l2[k]));
                float a0 = __builtin_amdgcn_exp2f(l0[k] - mx), a1 = __builtin_amdgcn_exp2f(l1[k] - mx), a2 = __builtin_amdgcn_exp2f(l2[k] - mx);
                const float is = 1.0f / (a0 + a1 + a2); a0 *= is; a1 *= is; a2 *= is;
                const v4u x0 = o0[k], x1 = o1[k], x2 = o2[k];
                v4u w;
                w.x = pk2(a0 * pg8::bf_lo(x0.x) + a1 * pg8::bf_lo(x1.x) + a2 * pg8::bf_lo(x2.x), a0 * pg8::bf_hi(x0.x) + a1 * pg8::bf_hi(x1.x) + a2 * pg8::bf_hi(x2.x));
                w.y = pk2(a0 * pg8::bf_lo(x0.y) + a1 * pg8::bf_lo(x1.y) + a2 * pg8::bf_lo(x2.y), a0 * pg8::bf_hi(x0.y) + a1 * pg8::bf_hi(x1.y) + a2 * pg8::bf_hi(x2.y));
                w.z = pk2(a0 * pg8::bf_lo(x0.z) + a1 * pg8::bf_lo(x1.z) + a2 * pg8::bf_lo(x2.z), a0 * pg8::bf_hi(x0.z) + a1 * pg8::bf_hi(x1.z) + a2 * pg8::bf_hi(x2.z));
                w.w = pk2(a0 * pg8::bf_lo(x0.w) + a1 * pg8::bf_lo(x1.w) + a2 * pg8::bf_lo(x2.w), a0 * pg8::bf_hi(x0.w) + a1 * pg8::bf_hi(x1.w) + a2 * pg8::bf_hi(x2.w));
                if (r < CH_T) *(GAS v4u*)(proj + (size_t)r * QP + 512 + lane * 8) = w;
            }
        }
    }
}
__device__ __forceinline__ void attn_b_phase(const Params& p, LAS unsigned char* lds, int tid, int lane, int wave) {
    const float* misc = (const float*)(p.ws + WS_MISC);
    for (int L = blockIdx.x; L < CH_B * 3 * 6 * 8; L += gridDim.x) {
        const int blk = L & 7, h = (L >> 3) % 6; int g, b; if (L < 768) { g = (L / 48) & 1; b = L / 96; } else { g = 2; b = (L - 768) / 48; }
        AttnArgs a; a.q0 = blk * 256; a.q = (bf16_t*)(p.ws + WS_QO) + (size_t)(b * S) * QP + 512 + g * 384 + h * 64;
        a.k = (const bf16_t*)(p.ws + WS_KV) + KVB0 + (size_t)(((b * 3 + g) * 6 + h) * 2) * (2048 * 64); a.v = a.k + 2048 * 64;
        a.tab = misc + MI_LUTB + (g * 6 + h) * LUTB_N; a.seqM = S >> (2 * g); a.lse = (float*)(p.ws + WS_MISC) + MI_LSE + ((size_t)g * CH_T + (size_t)b * S) * 8 + h; a.lam = 0.f; a.osc = 0.f; a.subg = nullptr;
        attn_unit<2>(a, lds, tid, lane, wave);
    }
}
__device__ __forceinline__ void attn_ac_phase(const Params& p, int L, int c, LAS unsigned char* lds, int tid, int lane, int wave) {
    const float* misc = (const float*)(p.ws + WS_MISC);
    constexpr unsigned char CTYPE[24] = {0,0,0,0,0,0,1,0,1,0,0,1,0,1,0,1,0,0,1,0,1,0,1,0}, CQB[24] = {15,14,13,12,11,10,7,9,6,8,7,5,6,4,5,3,4,3,2,2,1,1,0,0};
    constexpr unsigned short CFIRST[25] = {0,32,64,96,128,160,192,240,272,320,352,384,432,464,512,544,592,624,656,704,736,784,816,864,896};
    const bool lpt = gridDim.x == 256;
#pragma unroll 1
    for (int i = 0; ; ++i) {
        int cls, k;
        if (lpt) { if (i >= 6) break; const unsigned e = SCHED_AC[blockIdx.x][i]; if (e == 0xFFFFu) break; cls = (int)(e >> 6); k = (int)(e & 63u); }
        else { const int j = i * (int)gridDim.x + (int)blockIdx.x; if (j >= 896) break; cls = 0; for (int q = 1; q < 24; ++q) if ((int)CFIRST[q] <= j) cls = q; k = j - (int)CFIRST[cls]; }
        cls = __builtin_amdgcn_readfirstlane(cls); k = __builtin_amdgcn_readfirstlane(k);
        if (CTYPE[cls] != 0) continue;
        const int qb = CQB[cls], b = k >> 2, h = k & 3;
        AttnArgs a; a.seqM = 0; a.lse = nullptr; a.q0 = qb * 128; a.q = (bf16_t*)(p.ws + WS_QO) + (size_t)(b * S) * QP + h * 128;
        a.k = (const bf16_t*)(p.ws + WS_KV) + (size_t)((b * 4 + h) * 2) * (2048 * 128); a.v = a.k + 2048 * 128;
        a.tab = misc + MI_LUTA + 2 * h * LUTA_N; a.lam = misc[MI_LAM + L]; a.osc = 1.0f - misc[MI_LAM + 8 + L]; a.subg = p.in[12] + L * 128;
        attn_unit<0>(a, lds, tid, lane, wave);
    }
#pragma unroll 1
    for (int i = 0; ; ++i) {
        int cls, k;
        if (lpt) { if (i >= 6) break; const unsigned e = SCHED_AC[blockIdx.x][i]; if (e == 0xFFFFu) break; cls = (int)(e >> 6); k = (int)(e & 63u); }
        else { const int j = i * (int)gridDim.x + (int)blockIdx.x; if (j >= 896) break; cls = 0; for (int q = 1; q < 24; ++q) if ((int)CFIRST[q] <= j) cls = q; k = j - (int)CFIRST[cls]; }
        cls = __builtin_amdgcn_readfirstlane(cls); k = __builtin_amdgcn_readfirstlane(k);
        if (CTYPE[cls] != 1) continue;
        const int qb = CQB[cls], b = k / 6, h = k % 6;
        AttnArgs a; a.seqM = 0; a.lse = nullptr; a.q0 = qb * 256; a.q = (bf16_t*)(p.ws + WS_QO) + (size_t)(b * S) * QP + 1664 + h * 64;
        a.k = (const bf16_t*)(p.ws + WS_KV) + KVC0 + (size_t)((b * 6 + h) * 2) * (2048 * 64); a.v = a.k + 2048 * 64;
        a.tab = misc + MI_NEGF + (size_t)((c * CH_B + b) * 6 + h) * S; a.lam = 0.f; a.osc = 0.f; a.subg = nullptr;
        attn_unit<1>(a, lds, tid, lane, wave);
    }
    merge_b(p, lane, wave);
}

constexpr int RT_WR = 0, RT_CNT = D * NE * 4, RT_REC = RT_CNT + 64, RT_RECW = 64;
__device__ __forceinline__ void norm_route(const Params& p, const float* g, const float* sc, const float* sh, bf16_t* h, LAS unsigned char* lds, int tid, int lane, int wave) {
    LAS float* wr = (LAS float*)(lds + RT_WR); LAS unsigned* lcnt = (LAS unsigned*)(lds + RT_CNT); LAS unsigned* lbase = lcnt + 8;
    LAS int* rec = (LAS int*)(lds + RT_REC) + wave * (RT_RECW * 8);
    { f32x4 tv[4];
#pragma unroll
      for (int k = 0; k < 4; ++k) tv[k] = *(const GAS f32x4*)(p.in[21] + (tid + k * NTHR) * 4);
#pragma unroll
      for (int k = 0; k < 4; ++k) *(LAS f32x4*)(wr + (tid + k * NTHR) * 4) = tv[k]; }
    if (tid < 16) lcnt[tid] = 0u;
    __syncthreads();
    const int gw = blockIdx.x * NWAVES + wave, NGW = gridDim.x * NWAVES;
    const float* x = p.out;
    int k = 0;
    f32x4 vn[4], vm[4];
    { const int tf = (gw < T) ? gw : 0, tg = (gw + NGW < T) ? gw + NGW : tf; const GAS f32x4* xn = (const GAS f32x4*)(x + (size_t)tf * D) + lane; const GAS f32x4* xm = (const GAS f32x4*)(x + (size_t)tg * D) + lane;
#pragma unroll
      for (int j = 0; j < 4; ++j) { vn[j] = xn[64 * j]; vm[j] = xm[64 * j]; } }
    constexpr int TEND = T;
    for (int t = gw; t < T && k < RT_RECW; t += NGW, ++k) {
        const int b = t >> 11;
        f32x4 v[4]; float s = 0.f;
#pragma unroll
        for (int j = 0; j < 4; ++j) { v[j] = vn[j]; vn[j] = vm[j]; s += (v[j].x * v[j].x + v[j].y * v[j].y) + (v[j].z * v[j].z + v[j].w * v[j].w); }
        { const int tn = (t + 2 * NGW < TEND) ? t + 2 * NGW : t; const GAS f32x4* xn = (const GAS f32x4*)(x + (size_t)tn * D) + lane;
#pragma unroll
          for (int j = 0; j < 4; ++j) vm[j] = xn[64 * j]; }
        const float r = 1.0f / sqrtf(wave_sum(s) * (1.0f / D) + EPS);
        GAS v2u* o8 = (GAS v2u*)(h + (size_t)t * D) + lane;
        float lg[NE];
#pragma unroll
        for (int e = 0; e < NE; ++e) lg[e] = 0.f;
#pragma unroll
        for (int j = 0; j < 4; ++j) { const int d = 4 * lane + 256 * j;
            const f32x4 g4 = *(const f32x4*)(g + d), c4 = *(const f32x4*)(sc + (size_t)b * 6 * D + d), h4 = *(const f32x4*)(sh + (size_t)b * 6 * D + d);
            const f32x4 o = v[j] * r * g4 * (c4 + 1.0f) + h4;
            v2u w; w.x = pk2(o.x, o.y); w.y = pk2(o.z, o.w); o8[64 * j] = w;
#pragma unroll
            for (int cc = 0; cc < 4; ++cc) { const f32x4 w0 = *(const LAS f32x4*)(wr + (d + cc) * NE), w1 = *(const LAS f32x4*)(wr + (d + cc) * NE + 4); const float ov = o[cc];
                lg[0] += ov * w0.x; lg[1] += ov * w0.y; lg[2] += ov * w0.z; lg[3] += ov * w0.w; lg[4] += ov * w1.x; lg[5] += ov * w1.y; lg[6] += ov * w1.z; lg[7] += ov * w1.w; } }
#pragma unroll
        for (int e = 0; e < NE; ++e) lg[e] = wave_sum(lg[e]);
        if (lane == 0) {
            int e0 = 0; float v0 = lg[0];
#pragma unroll
            for (int e = 1; e < NE; ++e) if (lg[e] > v0) { v0 = lg[e]; e0 = e; }
            int e1 = e0 == 0 ? 1 : 0; float v1 = lg[e1];
#pragma unroll
            for (int e = 0; e < NE; ++e) if (e != e0 && lg[e] > v1) { v1 = lg[e]; e1 = e; }
            const float w1 = 1.0f / (1.0f + __expf(v0 - v1)), w0 = 1.0f - w1;
            const unsigned lp0 = __hip_atomic_fetch_add(lcnt + e0, 1u, __ATOMIC_RELAXED, __HIP_MEMORY_SCOPE_WORKGROUP), lp1 = __hip_atomic_fetch_add(lcnt + e1, 1u, __ATOMIC_RELAXED, __HIP_MEMORY_SCOPE_WORKGROUP);
            LAS int* rc = rec + k * 8; rc[0] = t; rc[1] = e0; rc[2] = e1; rc[3] = (int)lp0; rc[4] = (int)lp1; rc[5] = (int)__float_as_uint(w0); rc[6] = (int)__float_as_uint(w1);
        }
    }
    __syncthreads();
    unsigned* ctl = (unsigned*)(p.ws + WS_CTL);
    if (tid < NE) lbase[tid] = __hip_atomic_fetch_add(ctl + CW_CNT + tid, lcnt[tid], __ATOMIC_RELAXED, __HIP_MEMORY_SCOPE_AGENT);
    __syncthreads();
    unsigned* misc = (unsigned*)(p.ws + WS_MISC);
    if (lane < k) { const LAS int* rc = rec + lane * 8; const int t = rc[0], e0 = rc[1], e1 = rc[2];
        misc[MI_TOK_E + 2 * t] = (unsigned)e0; misc[MI_TOK_E + 2 * t + 1] = (unsigned)e1;
        misc[MI_TOK_POS + 2 * t] = lbase[e0] + (unsigned)rc[3]; misc[MI_TOK_POS + 2 * t + 1] = lbase[e1] + (unsigned)rc[4];
        misc[MI_TOK_W + 2 * t] = (unsigned)rc[5]; misc[MI_TOK_W + 2 * t + 1] = (unsigned)rc[6]; }
}
__device__ __forceinline__ void moe_scan_gather(const Params& p, LAS unsigned char* lds, int tid, int lane, int wave) {
    LAS unsigned* sseg = (LAS unsigned*)lds;
    unsigned* ctl = (unsigned*)(p.ws + WS_CTL); unsigned* misc = (unsigned*)(p.ws + WS_MISC);
    if (tid == 0) { unsigned a = 0u;
        for (int e = 0; e < NE; ++e) { const unsigned c = __hip_atomic_load(ctl + CW_CNT + e, __ATOMIC_RELAXED, __HIP_MEMORY_SCOPE_AGENT); sseg[e] = a; sseg[16 + e] = c; a += (c + 255u) & ~255u; }
        sseg[8] = a; }
    __syncthreads();
    const unsigned ntile = sseg[8] >> 8;
    if (blockIdx.x == 0) {
        if (tid < MOE_MAXT) { unsigned e = 0u; for (int q = 1; q < NE; ++q) if (sseg[q] <= 256u * (unsigned)tid) e = (unsigned)q; misc[MI_TILE_E + tid] = e; }
        if (tid == 0) misc[MI_TILE_E + 500] = ntile;
    }
    const bf16_t* h = (const bf16_t*)(p.ws + WS_H); bf16_t* hs = (bf16_t*)(p.ws + WS_HS);
    const int gw = blockIdx.x * NWAVES + wave, NGW = gridDim.x * NWAVES;
    const int nk = (T - gw + NGW - 1) / NGW;
    unsigned mr0 = 0u, mr1 = 0u;
    if (lane < nk) { const int t = gw + lane * NGW;
        const v2u ee = *(const GAS v2u*)(misc + MI_TOK_E + 2 * t), pp = *(const GAS v2u*)(misc + MI_TOK_POS + 2 * t), ww = *(const GAS v2u*)(misc + MI_TOK_W + 2 * t);
        mr0 = sseg[ee.x] + pp.x; mr1 = sseg[ee.y] + pp.y;
        misc[MI_ROW_W + mr0] = ww.x; misc[MI_ROW_W + mr1] = ww.y;
        v2u rr; rr.x = mr0; rr.y = mr1; *(GAS v2u*)(misc + MI_TOK_POS + 2 * t) = rr; }
    for (int k0 = 0; k0 < nk; k0 += 8) {
        v4u a[8], c[8];
#pragma unroll
        for (int i = 0; i < 8; ++i) { const int k = k0 + i < nk ? k0 + i : nk - 1; const int t = gw + k * NGW;
            a[i] = *(const GAS v4u*)(h + (size_t)t * D + lane * 8); c[i] = *(const GAS v4u*)(h + (size_t)t * D + 512 + lane * 8); }
#pragma unroll
        for (int i = 0; i < 8; ++i) { if (k0 + i < nk) { const unsigned r0 = (unsigned)__shfl((int)mr0, k0 + i), r1 = (unsigned)__shfl((int)mr1, k0 + i);
            *(GAS v4u*)(hs + (size_t)r0 * D + lane * 8) = a[i]; *(GAS v4u*)(hs + (size_t)r0 * D + 512 + lane * 8) = c[i];
            *(GAS v4u*)(hs + (size_t)r1 * D + lane * 8) = a[i]; *(GAS v4u*)(hs + (size_t)r1 * D + 512 + lane * 8) = c[i]; } }
    }
    if (blockIdx.x < NE) {
        const unsigned e = blockIdx.x, p0 = sseg[e] + sseg[16 + e], p1 = sseg[e + 1];
        for (unsigned r = p0 + (unsigned)wave; r < p1; r += NWAVES) { const v4u z = {0u, 0u, 0u, 0u};
            *(GAS v4u*)(hs + (size_t)r * D + lane * 8) = z; *(GAS v4u*)(hs + (size_t)r * D + 512 + lane * 8) = z; if (lane == 0) misc[MI_ROW_W + r] = 0u; }
    }
}
struct GroupedOrder {
    const unsigned* tile_e; int t0, t1, nN, G, c, a_pm_off; size_t bstride;
    __device__ __forceinline__ bool next(int i, pg8::Unit& u) const {
        const long L = (long)i * G + c; if (L >= (long)(t1 - t0) * nN) return false;
        u.pm = t0 + (int)(L / nN); u.pn = (int)(L % nN); u.e = __builtin_amdgcn_readfirstlane((int)tile_e[u.pm]); u.aux = 0; return true;
    }
    __device__ __forceinline__ const char* a_ptr(const pg8::Gemm& g, const pg8::Unit& u) const { return (const char*)g.A + (size_t)(u.pm - a_pm_off) * (size_t)(pg8::BM * 2) * g.lda; }
    __device__ __forceinline__ const char* b_ptr(const pg8::Gemm& g, const pg8::Unit& u) const { return (const char*)g.Bt + ((size_t)u.e * bstride + (size_t)u.pn * pg8::BM * g.K) * 2; }
    __device__ __forceinline__ int kt(const pg8::Gemm& g, const pg8::Unit&) const { return g.K / pg8::BK; }
    __device__ __forceinline__ bool last_seg(const pg8::Unit&) const { return true; }
    __device__ __forceinline__ void a_ready(const pg8::Unit&) const {}
    __device__ __forceinline__ void done(const pg8::Unit&) const {}
};
constexpr int OVF_T0 = 256, OVF_KS = 7, OVF_KT = DFE / 64 / OVF_KS;
static_assert(OVF_KT * OVF_KS * 64 == DFE && OVF_KT % 2 == 0 && (size_t)(MOE_MAXT - OVF_T0) * 4 * OVF_KS * 65536 * 4 <= (size_t)T * D * 2, "overflow split-K map");
struct SplitKOrder {
    const unsigned* tile_e; int t0, t1, G, c, a_pm_off; size_t bstride;
    __device__ __forceinline__ bool next(int i, pg8::Unit& u) const {
        const long L = (long)i * G + c; if (L >= (long)(t1 - t0) * (4 * OVF_KS)) return false;
        const int r = (int)(L % (4 * OVF_KS)); u.pm = t0 + (int)(L / (4 * OVF_KS)); u.pn = r / OVF_KS; u.aux = r % OVF_KS; u.e = __builtin_amdgcn_readfirstlane((int)tile_e[u.pm]); return true;
    }
    __device__ __forceinline__ const char* a_ptr(const pg8::Gemm& g, const pg8::Unit& u) const { return (const char*)g.A + ((size_t)(u.pm - a_pm_off) * pg8::BM * g.lda + (size_t)u.aux * (OVF_KT * 64)) * 2; }
    __device__ __forceinline__ const char* b_ptr(const pg8::Gemm& g, const pg8::Unit& u) const { return (const char*)g.Bt + ((size_t)u.e * bstride + (size_t)u.pn * pg8::BM * g.ldb + (size_t)u.aux * (OVF_KT * 64)) * 2; }
    __device__ __forceinline__ int kt(const pg8::Gemm&, const pg8::Unit&) const { return OVF_KT; }
    __device__ __forceinline__ bool last_seg(const pg8::Unit&) const { return true; }
    __device__ __forceinline__ void a_ready(const pg8::Unit&) const {}
    __device__ __forceinline__ void done(const pg8::Unit&) const {}
};
struct EpiPartial {
    static constexpr bool PERM = false, AFTER_DRAIN = false, SEGMENTED = false;
    float* P;
    __device__ __forceinline__ void operator()(const pg8::f32x4 (&acc)[2][2][4][2], const pg8::Unit& u, int wr, int wc, int fr, int fq) const {
        float* base = P + ((size_t)(((u.pm - OVF_T0) * 4 + u.pn) * OVF_KS + u.aux) << 16) + (size_t)(wr * 64 + fr) * 256 + wc * 32 + 4 * fq;
#pragma unroll
        for (int ai = 0; ai < 2; ++ai)
#pragma unroll
            for (int m = 0; m < 4; ++m)
#pragma unroll
                for (int bj = 0; bj < 2; ++bj)
#pragma unroll
                    for (int n = 0; n < 2; ++n) *(pg8::f32x4*)(base + (size_t)(ai * pg8::HALF + m * 16) * 256 + bj * pg8::HALF + n * 16) = acc[ai][bj][m][n];
    }
};
__device__ __forceinline__ v2u ovf_y(const float* P, const float* row_w, unsigned r, int j, int lane) {
    const float* b = P + ((size_t)((((int)(r >> 8) - OVF_T0) * 4 + j) * OVF_KS) << 16) + (size_t)(r & 255u) * 256 + 4 * lane;
    f32x4 s = *(const GAS f32x4*)b;
#pragma unroll
    for (int q = 1; q < OVF_KS; ++q) s += *(const GAS f32x4*)(b + ((size_t)q << 16));
    const float w = row_w[r];
    v2u o; o.x = pk2(s.x * w, s.y * w); o.y = pk2(s.z * w, s.w * w); return o;
}
__device__ __forceinline__ void moe_combine_final(const Params& p, const float* g2, int lane, int wave) {
    const unsigned* misc = (const unsigned*)(p.ws + WS_MISC); const bf16_t* y = (const bf16_t*)(p.ws + WS_HS); const float* ovf = (const float*)(p.ws + WS_H);
    const int gw = blockIdx.x * NWAVES + wave, NGW = gridDim.x * NWAVES;
    const int nk = (T - gw + NGW - 1) / NGW;
    unsigned mr0 = 0u, mr1 = 0u;
    if (lane < nk) { const v2u rr = *(const GAS v2u*)(misc + MI_TOK_POS + 2 * (gw + lane * NGW)); mr0 = rr.x; mr1 = rr.y; }
    f32x4 xv[4]; v2u ya[4], yc[4];
#define CMB_LOAD(k_) do { const int t_ = gw + (k_) * NGW; const unsigned r0_ = (unsigned)__builtin_amdgcn_readfirstlane(__shfl((int)mr0, (k_))), r1_ = (unsigned)__builtin_amdgcn_readfirstlane(__shfl((int)mr1, (k_))); \
        _Pragma("unroll") for (int j = 0; j < 4; ++j) { const int d = 4 * lane + 256 * j; xv[j] = *(const GAS f32x4*)(p.out + (size_t)t_ * D + d); \
            ya[j] = *(const GAS v2u*)(y + (size_t)r0_ * D + d); yc[j] = *(const GAS v2u*)(y + (size_t)r1_ * D + d); } \
        if (r0_ >= (unsigned)(OVF_T0 * 256)) { _Pragma("unroll") for (int j = 0; j < 4; ++j) ya[j] = ovf_y(ovf, (const float*)(misc + MI_ROW_W), r0_, j, lane); } \
        if (r1_ >= (unsigned)(OVF_T0 * 256)) { _Pragma("unroll") for (int j = 0; j < 4; ++j) yc[j] = ovf_y(ovf, (const float*)(misc + MI_ROW_W), r1_, j, lane); } } while (0)
    if (nk > 0) CMB_LOAD(0);
    for (int k = 0; k < nk; ++k) {
        const int t = gw + k * NGW, b = t >> 11;
        GAS f32x4* xr = (GAS f32x4*)(p.out + (size_t)t * D) + lane;
        f32x4 v[4]; float s = 0.f;
#pragma unroll
        for (int j = 0; j < 4; ++j) { const int d = 4 * lane + 256 * j; const v2u a = ya[j], c = yc[j];
            f32x4 fa, fc; fa.x = __uint_as_float(a.x << 16); fa.y = __uint_as_float(a.x & 0xffff0000u); fa.z = __uint_as_float(a.y << 16); fa.w = __uint_as_float(a.y & 0xffff0000u);
            fc.x = __uint_as_float(c.x << 16); fc.y = __uint_as_float(c.x & 0xffff0000u); fc.z = __uint_as_float(c.y << 16); fc.w = __uint_as_float(c.y & 0xffff0000u);
            const f32x4 g4 = *(const f32x4*)(g2 + (size_t)b * 6 * D + d);
            v[j] = xv[j] + g4 * (fa + fc); s += (v[j].x * v[j].x + v[j].y * v[j].y) + (v[j].z * v[j].z + v[j].w * v[j].w); }
        if (k + 1 < nk) CMB_LOAD(k + 1);
        const float r = 1.0f / sqrtf(wave_sum(s) * (1.0f / D) + EPS);
#pragma unroll
        for (int j = 0; j < 4; ++j) { const f32x4 f4 = *(const f32x4*)(p.in[25] + 4 * lane + 256 * j); xr[64 * j] = v[j] * r * f4; }
    }
#undef CMB_LOAD
}

#ifdef PROBE_CATS
#ifndef PROBE_MULT
#define PROBE_MULT 4
#endif
struct Probe { int unused; };
__device__ __forceinline__ int step_cat(int id) {
    if (id == 0) return 0;
    const int l = (id - 1) / LSTEPS, o = (id - 1) % LSTEPS;
    if (o == 0) return 1; if (o <= 10) return 2 + (o - 1) % 5; if (o == 11) return l == 0 ? 7 : 10;
    if (l == 0) return o == 12 ? 8 : 9;
    if (o == 12) return 11; if (o == 21) return 14; return (o & 1) ? 12 : 13;
}
__device__ __forceinline__ bool probe_tick_lds(LAS unsigned char* lds, int id) {
    int t_ = threadIdx.x; asm volatile("" : "+v"(t_));
    if (blockIdx.x == 0 && t_ == 0) {
        volatile LAS unsigned long long* q = (volatile LAS unsigned long long*)(lds + LDSCTL_OFF + 64);
        const unsigned long long now = __builtin_amdgcn_s_memrealtime();
        if (q[2]) q[1] += now - q[0];
        q[0] = now; q[2] = ((id >= 0) && ((PROBE_CATS >> step_cat(id)) & 1)) ? 1ull : 0ull;
    }
    return true;
}
#define probe_tick(pr, id) probe_tick_lds(lds, (id))
#else
struct Probe { int unused; };
__device__ __forceinline__ bool probe_tick(Probe&, int) { return true; }
#endif
#define STEP(id) if (p0.lo <= (id) && (id) < p0.hi && (first ? (first = false, true) : (xcd_barrier(bar), true)) && probe_tick(pr, (id)))
#define STEP_S(id) if (p0.lo <= (id) && (id) < p0.hi && (first ? (first = false, true) : (xcd_barrier_steal(bar, lds), true)) && probe_tick(pr, (id)))
#define IDS const Params p = load_params(); int tid = threadIdx.x; asm volatile("" : "+v"(tid)); const int lane = tid & 63, wave = __builtin_amdgcn_readfirstlane(tid >> 6); (void)lane; (void)wave; const int G = gridDim.x, NGW = G * NWAVES; (void)NGW; unsigned char* ws = p.ws; const float* mod_ = (const float*)(ws + WS_MOD); (void)mod_;
template <int L, int c> __device__ __forceinline__ void chunk_steps(const Params& p0, LAS unsigned char* lds, const XcdBarrier& bar, bool& first, Probe& pr) {
    constexpr int sb = ST_L0 + L * LSTEPS;
        constexpr int cs = sb + SO_CHUNK + CSTEPS * c;
#define CHP bf16_t* hc = (bf16_t*)(ws + WS_H) + (size_t)c * CH_T * D; bf16_t* proj = (bf16_t*)(ws + WS_PROJ); (void)hc; (void)proj;
        STEP(cs + 0) { IDS CHP
            if (blockIdx.x < CH_B * 6 && wave == 0) negf_cumsum(p, c * CH_B + (int)blockIdx.x / 6, (int)blockIdx.x % 6, lane);
            if constexpr (c == 1) {
                pg8::Gemm g{(const bf16_t*)(ws + WS_H), (const bf16_t*)(ws + WS_WOUT) + (size_t)L * D * D, CH_T, D, D, D, D}; pg8::StaticOrder S; S.init(CH_T, D, G, (int)blockIdx.x);
                pg8::EpiResid E{L == 0 ? p.in[0] : p.out, p.out, (mod_ + (size_t)L * NB * 6 * D) + 2 * D, 0};
                pg8::gemm_phase<pg8::EpiResid, pg8::StaticOrder, true, true>(lds, g, S, E);
            }
            pg8::Gemm g{hc, (const bf16_t*)(ws + WS_WIN) + (size_t)L * NP * D, CH_T, NP, D, D, D}; pg8::StaticOrder S; S.init(CH_T, NP, G, (int)blockIdx.x);
            pg8::EpiInProj E{(bf16_t*)(ws + WS_QO), (bf16_t*)(ws + WS_KV), (bf16_t*)(ws + WS_GATE)};
            pg8::gemm_phase<pg8::EpiInProj, pg8::StaticOrder, true, true>(lds, g, S, E);
        }
        STEP(cs + 1) { IDS attn_b_phase(p, lds, tid, lane, wave); }
        STEP_S(cs + 2) { IDS attn_ac_phase(p, L, c, lds, tid, lane, wave); }
        STEP_S(cs + 3) { IDS CHP
            const bf16_t* wbr = (const bf16_t*)(ws + WS_WBR) + (size_t)L * 1280 * D;
            pg8::SegOrder S; S.init(CH_T, D, G, (int)blockIdx.x);
            pg8::Gemm g{(const bf16_t*)(ws + WS_QO), wbr, CH_T, D, 1280, 2048, 1280}; pg8::EpiMergeS E{(const bf16_t*)(ws + WS_GATE), hc, 3072};
            pg8::gemm_phase<pg8::EpiMergeS, pg8::SegOrder, true, true>(lds, g, S, E);
        }
        if constexpr (c == 1) STEP(cs + 4) { IDS CHP
            pg8::Gemm g{hc, (const bf16_t*)(ws + WS_WOUT) + (size_t)L * D * D, CH_T, D, D, D, D}; pg8::StaticOrder S; S.init(CH_T, D, G, (int)blockIdx.x);
            pg8::EpiResid E{L == 0 ? p.in[0] : p.out, p.out, (mod_ + (size_t)L * NB * 6 * D) + 2 * D, c * CH_T};
            pg8::gemm_phase<pg8::EpiResid, pg8::StaticOrder, true, true>(lds, g, S, E);
        }
    }
template <int L> __device__ __forceinline__ void layer_steps(const Params& p0, LAS unsigned char* lds, const XcdBarrier& bar, bool& first, Probe& pr) {
    constexpr int sb = ST_L0 + L * LSTEPS;
    STEP(sb + SO_NORM1) { IDS norm_logf(p, L, L == 0 ? p.in[0] : p.out, p.in[2] + L * D, (mod_ + (size_t)L * NB * 6 * D) + D, (mod_ + (size_t)L * NB * 6 * D), (bf16_t*)(ws + WS_H), lds, tid, lane, wave); }
    chunk_steps<L, 0>(p0, lds, bar, first, pr);
    chunk_steps<L, 1>(p0, lds, bar, first, pr);
    STEP(sb + SO_NORM2) { IDS
        if constexpr (L == 0) norm_rows(p.out, p.in[3] + L * D, (mod_ + (size_t)L * NB * 6 * D) + 4 * D, (mod_ + (size_t)L * NB * 6 * D) + 3 * D, (bf16_t*)(ws + WS_H), 0, T, (int)blockIdx.x * NWAVES + wave, NGW, lane);
        else norm_route(p, p.in[3] + L * D, (mod_ + (size_t)L * NB * 6 * D) + 4 * D, (mod_ + (size_t)L * NB * 6 * D) + 3 * D, (bf16_t*)(ws + WS_H), lds, tid, lane, wave);
    }
    if constexpr (L == 0) {
        STEP(sb + SO_FFN) { IDS
            pg8::Gemm g{(const bf16_t*)(ws + WS_H), (const bf16_t*)(ws + WS_WGU0), T, 2 * DFF, D, D, D}; pg8::StaticOrder S; S.init(T, 2 * DFF, G, (int)blockIdx.x);
            pg8::EpiSwiglu E{(bf16_t*)(ws + WS_PROJ), DFF, 0};
            pg8::gemm_phase<pg8::EpiSwiglu, pg8::StaticOrder, true, true>(lds, g, S, E);
        }
        STEP(sb + SO_FFN + 1) { IDS
            pg8::Gemm g{(const bf16_t*)(ws + WS_PROJ), (const bf16_t*)(ws + WS_WD0), T, D, DFF, DFF, DFF}; pg8::StaticOrder S; S.init(T, D, G, (int)blockIdx.x);
            pg8::EpiResid E{p.out, p.out, (mod_ + (size_t)L * NB * 6 * D) + 5 * D, 0};
            pg8::gemm_phase<pg8::EpiResid, pg8::StaticOrder, true, true>(lds, g, S, E);
        }
    } else {
        STEP(sb + SO_FFN) { IDS moe_scan_gather(p, lds, tid, lane, wave); __syncthreads(); expert_mopup(p, lds, lane, wave); }
#pragma unroll 1
        for (int ch = 0; ch < 4; ++ch) {
            STEP(sb + SO_FFN + 1 + 2 * ch) { IDS const unsigned* misc = (const unsigned*)(ws + WS_MISC);
                const int ntile = (int)misc[MI_TILE_E + 500], t0 = ch * MOE_CH, t1 = ch == 3 ? ntile : (ch + 1) * MOE_CH;
                pg8::Gemm g{(const bf16_t*)(ws + WS_HS), (const bf16_t*)(ws + WS_WGU1), MOE_ROWS, 2 * DFE, D, D, D};
                GroupedOrder S{misc + MI_TILE_E, t0, t1, 2 * DFE / 256, G, (int)blockIdx.x, 0, (size_t)2 * DFE * D};
                pg8::EpiSwiglu E{(bf16_t*)(ws + WS_ACT1), DFE, t0};
                pg8::gemm_phase<pg8::EpiSwiglu, GroupedOrder, true, true>(lds, g, S, E);
            }
            STEP(sb + SO_FFN + 2 + 2 * ch) { IDS const unsigned* misc = (const unsigned*)(ws + WS_MISC);
                const int ntile = (int)misc[MI_TILE_E + 500], t0 = ch * MOE_CH, t1 = ch == 3 ? (ntile < OVF_T0 ? ntile : OVF_T0) : (ch + 1) * MOE_CH;
                pg8::Gemm g{(const bf16_t*)(ws + WS_ACT1), (const bf16_t*)(ws + WS_WD1), MOE_ROWS, D, DFE, DFE, DFE};
                GroupedOrder S{misc + MI_TILE_E, t0, t1, D / 256, G, (int)blockIdx.x, t0, (size_t)D * DFE};
                pg8::EpiMoeDown E{(bf16_t*)(ws + WS_HS), (const float*)(misc + MI_ROW_W)};
                pg8::gemm_phase<pg8::EpiMoeDown, GroupedOrder, true, true>(lds, g, S, E);
            }
        }
        STEP(sb + SO_FFN + 9) { IDS const unsigned* misc = (const unsigned*)(ws + WS_MISC);
            const int ntile = (int)misc[MI_TILE_E + 500];
            pg8::Gemm g{(const bf16_t*)(ws + WS_ACT1), (const bf16_t*)(ws + WS_WD1), MOE_ROWS, D, DFE, DFE, DFE};
            SplitKOrder S{misc + MI_TILE_E, OVF_T0, ntile, G, (int)blockIdx.x, 3 * MOE_CH, (size_t)D * DFE};
            EpiPartial E{(float*)(ws + WS_H)};
            pg8::gemm_phase<EpiPartial, SplitKOrder, true, true>(lds, g, S, E);
        }
        STEP(sb + SO_FFN + 10) { IDS moe_combine_final(p, (mod_ + (size_t)L * NB * 6 * D) + 5 * D, lane, wave); }
    }
}

__global__ void __launch_bounds__(NTHR, 2) mk_fwd(Params p0) {
    extern __shared__ __attribute__((aligned(16))) unsigned char lds_raw[];
    LAS unsigned char* lds = (LAS unsigned char*)lds_raw;
    for (int u = threadIdx.x; u < (LDS_BYTES - LDSCTL_OFF) / 4; u += NTHR) ((LAS unsigned*)(lds + LDSCTL_OFF))[u] = 0u;
    __syncthreads();
    const XcdBarrier bar = xcd_barrier_post((unsigned*)(p0.ws + WS_CTL) + CW_BAR + p0.li * XCD_BAR_WORDS, (volatile LAS unsigned*)(lds + MISC_OFF) + 8);
    bool first = true; Probe pr{};
    STEP(ST_PRO) { IDS prologue(p, lds, tid, lane, wave); }
    layer_steps<0>(p0, lds, bar, first, pr);
    layer_steps<1>(p0, lds, bar, first, pr);
#ifdef PROBE_CATS
    probe_tick(pr, -1);
    int t_ = threadIdx.x; asm volatile("" : "+v"(t_));
    if (blockIdx.x == 0 && t_ == 0) { const unsigned long long t1 = __builtin_amdgcn_s_memrealtime(), want = ((volatile LAS unsigned long long*)(lds + LDSCTL_OFF + 64))[1] * PROBE_MULT; while (__builtin_amdgcn_s_memrealtime() - t1 < want) __builtin_amdgcn_s_sleep(32); }
#endif
}
#undef STEP
#undef STEP_S
}

extern "C" void kernel_launch(void* const* d_in, const int* in_sizes, int n_in, void* d_out, int out_size, void* d_ws, size_t ws_size, hipStream_t stream) {
    static int grid = 0;
    if (grid == 0) {
        int dev = 0, cus = 0;
        (void)hipGetDevice(&dev); (void)hipDeviceGetAttribute(&cus, hipDeviceAttributeMultiprocessorCount, dev);
        if (hipFuncSetAttribute((const void*)mk::mk_fwd, hipFuncAttributeMaxDynamicSharedMemorySize, mk::LDS_BYTES) != hipSuccess) fprintf(stderr, "kernel_launch: hipFuncSetAttribute failed\n");
        (void)hipGetLastError();
        grid = cus > 0 ? cus : 256;
        if (ws_size < mk::WS_END) fprintf(stderr, "kernel_launch: workspace too small: %zu < %zu\n", ws_size, (size_t)mk::WS_END);
    }
    (void)in_sizes; (void)n_in; (void)out_size;
    (void)hipMemsetAsync((char*)d_ws + mk::WS_CTL, 0, mk::CTL_ZERO, stream);
    mk::Params p{};
    for (int i = 0; i < 26; ++i) p.in[i] = (const float*)d_in[i];
    p.out = (float*)d_out; p.ws = (unsigned char*)d_ws; p.lo = 0; p.hi = mk::ST_END; p.li = 0; p.pad = 0;
    hipLaunchKernelGGL(mk::mk_fwd, dim3(grid), dim3(mk::NTHR), mk::LDS_BYTES, stream, p);
}
```
